# Optimizing an MI355X kernel written in HIP

```python
import math
import jax
import jax.numpy as jnp
from jax import lax
import numpy as np


D_MODEL = 1024
BATCH = 8
SEQ = 4096
DEPTH = 4

CHUNK = 64
N_MEM = 256
EPS = 1e-6

A_HEADS = 8
A_HEAD_DIM = 64
A_WIDTH = A_HEADS * A_HEAD_DIM
IDX_HEADS = 4
IDX_DIM = 64
TOPK_MAX = 256
Q_BLOCK = 128

S5_WIDTH = D_MODEL - A_WIDTH
S5_GROUP = 16
S5_GROUPS = S5_WIDTH // S5_GROUP
S5_STATE = 64

CONV_WIDTH = 3

X_HEADS = 4
X_HEAD_DIM = 128
X_WIDTH = X_HEADS * X_HEAD_DIM

D_FF = 2816

N_EVEN = (DEPTH + 1) // 2
N_ODD = DEPTH // 2

EVEN_SPLIT_SIZES = (A_WIDTH, A_HEAD_DIM, A_HEAD_DIM, IDX_HEADS * IDX_DIM, IDX_DIM, IDX_HEADS, S5_WIDTH)
EVEN_IN = A_WIDTH + 2 * A_HEAD_DIM + IDX_HEADS * IDX_DIM + IDX_DIM + IDX_HEADS + S5_WIDTH

kernel_name = "hybrid_dsa_s5_shortconv_trunk"


def rms_norm(x, g):
    xf = x.astype(jnp.float32)
    xf = xf * lax.rsqrt(jnp.mean(xf * xf, axis=-1, keepdims=True) + EPS)
    return (xf * g.astype(jnp.float32)).astype(x.dtype)


def causal_dwconv(z, w, b):
    T = z.shape[1]
    zp = jnp.pad(z, ((0, 0), (CONV_WIDTH - 1, 0), (0, 0)))
    y = w[0] * zp[:, 0:T] + w[1] * zp[:, 1:T + 1] + w[2] * zp[:, 2:T + 2]
    return y + b


def dsa_attention(q, k, v, iq, ik, iw):
    B, T = q.shape[0], q.shape[1]
    topk = min(TOPK_MAX, T // 4)
    nb = T // Q_BLOCK
    key_pos = jnp.arange(T)
    idx_scale = (IDX_DIM ** -0.5) * (IDX_HEADS ** -0.5)
    att_scale = A_HEAD_DIM ** -0.5

    def to_blocks(a):
        return jnp.moveaxis(a.reshape((B, nb, Q_BLOCK) + a.shape[2:]), 1, 0)

    def block(args):
        blk, qb, iqb, iwb = args
        t = blk * Q_BLOCK + jnp.arange(Q_BLOCK)
        limit = (t // CHUNK + 1) * CHUNK
        adm = key_pos[None, :] < limit[:, None]
        rel = jax.nn.relu(jnp.einsum('bqhd,bsd->bqhs', iqb, ik))
        score = jnp.einsum('bqh,bqhs->bqs', iwb, rel) * idx_scale
        score = jnp.where(adm[None], score.astype(jnp.float32), -jnp.inf)
        _, sel = lax.top_k(score, topk)
        valid = sel < limit[None, :, None]
        kg = jax.vmap(lambda kk, ii: kk[ii])(k, sel)
        vg = jax.vmap(lambda vv, ii: vv[ii])(v, sel)
        s = jnp.einsum('bqhd,bqkd->bhqk', qb, kg).astype(jnp.float32) * att_scale
        s = jnp.where(valid[:, None], s, -jnp.inf)
        p = jax.nn.softmax(s, axis=-1).astype(v.dtype)
        return jnp.einsum('bhqk,bqkd->bqhd', p, vg)

    out = lax.map(block, (jnp.arange(nb), to_blocks(q), to_blocks(iq), to_blocks(iw)))
    return jnp.moveaxis(out, 0, 1).reshape(B, T, A_WIDTH)


def s5_mixer(u, lam_re, lam_im, log_step, b_re, b_im, c_re, c_im, d, w_glu, b_glu):
    B, T, _ = u.shape
    f32 = jnp.float32
    uf = u.astype(f32).reshape(B, T, S5_GROUPS, S5_GROUP)
    lam = lax.complex(lam_re.astype(f32), lam_im.astype(f32))
    delta = jnp.exp(log_step.astype(f32))[:, None]
    lam_bar = jnp.exp(lam * delta)
    b_bar = ((lam_bar - 1.0) / lam)[..., None] * lax.complex(b_re.astype(f32), b_im.astype(f32))
    bu = jnp.einsum('gpc,btgc->btgp', b_bar, uf.astype(jnp.complex64))
    a = jnp.broadcast_to(lam_bar, (1, T) + lam_bar.shape)

    def combine(e1, e2):
        a1, b1 = e1
        a2, b2 = e2
        return a1 * a2, a2 * b1 + b2

    _, h = lax.associative_scan(combine, (a, bu), axis=1)
    c = lax.complex(c_re.astype(f32), c_im.astype(f32))
    y = jnp.einsum('gcp,btgp->btgc', c, h).real + d.astype(f32).reshape(S5_GROUPS, S5_GROUP) * uf
    y = jax.nn.gelu(y.reshape(B, T, S5_WIDTH)).astype(u.dtype)
    return y * jax.nn.sigmoid(y @ w_glu + b_glu)


def even_mixer(h, w_in, w_out, q_norm, k_norm, lam_re, lam_im, log_step, b_re, b_im, c_re, c_im, d, w_glu, b_glu):
    B, T, _ = h.shape
    split_pts = np.cumsum(EVEN_SPLIT_SIZES)[:-1].tolist()
    q, k, v, iq, ik, iw, u = jnp.split(h @ w_in, split_pts, axis=-1)
    q = rms_norm(q.reshape(B, T, A_HEADS, A_HEAD_DIM), q_norm)
    k = rms_norm(k, k_norm)
    ya = dsa_attention(q, k, v, iq.reshape(B, T, IDX_HEADS, IDX_DIM), ik, iw)
    yb = s5_mixer(u, lam_re, lam_im, log_step, b_re, b_im, c_re, c_im, d, w_glu, b_glu)
    return jnp.concatenate([ya, yb], axis=-1) @ w_out


def short_conv_mixer(h, w_in, conv_w, conv_b, w_out):
    gb, gc, z = jnp.split(h @ w_in, 3, axis=-1)
    return (gb * causal_dwconv(gc * z, conv_w, conv_b)) @ w_out


def memory_cross_attention(h, m, w_q, w_kv, w_o, q_norm, k_norm):
    B, T, _ = h.shape
    M = m.shape[1]
    q = rms_norm((h @ w_q).reshape(B, T, X_HEADS, X_HEAD_DIM), q_norm)
    k, v = jnp.split(m @ w_kv, 2, axis=-1)
    k = rms_norm(k.reshape(B, M, X_HEADS, X_HEAD_DIM), k_norm)
    v = v.reshape(B, M, X_HEADS, X_HEAD_DIM)
    s = jnp.einsum('bthd,bmhd->bhtm', q, k).astype(jnp.float32) * (X_HEAD_DIM ** -0.5)
    p = jax.nn.softmax(s, axis=-1).astype(v.dtype)
    o = jnp.einsum('bhtm,bmhd->bthd', p, v).reshape(B, T, X_WIDTH)
    return o @ w_o


def conv_glu_ffn(h, w_up, conv_w, conv_b, w_down):
    g, u = jnp.split(h @ w_up, 2, axis=-1)
    return (jax.nn.silu(causal_dwconv(g, conv_w, conv_b)) * u) @ w_down


def setup_inputs(seed: int = 0) -> dict:
    key = jax.random.key(seed)
    ks = iter(jax.random.split(key, 48))
    f32 = jnp.float32

    def nrm(shape, fan_in):
        return jax.random.normal(next(ks), shape, f32) * (fan_in ** -0.5)

    def gain(shape):
        return 1.0 + 0.05 * jax.random.normal(next(ks), shape, f32)

    def small(shape):
        return 0.01 * jax.random.normal(next(ks), shape, f32)

    D = D_MODEL
    lam_im_base = math.pi * jnp.arange(S5_STATE, dtype=f32)
    return {
        "x": jax.random.normal(next(ks), (BATCH, SEQ, D), f32),
        "mem": jax.random.normal(next(ks), (BATCH, N_MEM, D), f32),
        "norm_mix": gain((DEPTH, D)),
        "norm_x": gain((DEPTH, D)),
        "norm_mem": gain((DEPTH, D)),
        "norm_ffn": gain((DEPTH, D)),
        "even_w_in": nrm((N_EVEN, D, EVEN_IN), D),
        "even_w_out": nrm((N_EVEN, D, D), D),
        "a_q_norm": gain((N_EVEN, A_HEAD_DIM)),
        "a_k_norm": gain((N_EVEN, A_HEAD_DIM)),
        "s5_lam_re": -0.5 + small((N_EVEN, S5_GROUPS, S5_STATE)),
        "s5_lam_im": lam_im_base + small((N_EVEN, S5_GROUPS, S5_STATE)),
        "s5_log_step": jax.random.uniform(next(ks), (N_EVEN, S5_GROUPS), f32, math.log(1e-3), math.log(1e-1)),
        "s5_b_re": nrm((N_EVEN, S5_GROUPS, S5_STATE, S5_GROUP), 2 * S5_GROUP),
        "s5_b_im": nrm((N_EVEN, S5_GROUPS, S5_STATE, S5_GROUP), 2 * S5_GROUP),
        "s5_c_re": nrm((N_EVEN, S5_GROUPS, S5_GROUP, S5_STATE), S5_STATE),
        "s5_c_im": nrm((N_EVEN, S5_GROUPS, S5_GROUP, S5_STATE), S5_STATE),
        "s5_d": jax.random.normal(next(ks), (N_EVEN, S5_WIDTH), f32),
        "s5_w_glu": nrm((N_EVEN, S5_WIDTH, S5_WIDTH), S5_WIDTH),
        "s5_b_glu": small((N_EVEN, S5_WIDTH)),
        "odd_w_in": nrm((N_ODD, D, 3 * D), D),
        "odd_conv_w": nrm((N_ODD, CONV_WIDTH, D), CONV_WIDTH),
        "odd_conv_b": small((N_ODD, D)),
        "odd_w_out": nrm((N_ODD, D, D), D),
        "x_w_q": nrm((DEPTH, D, X_WIDTH), D),
        "x_w_kv": nrm((DEPTH, D, 2 * X_WIDTH), D),
        "x_w_o": nrm((DEPTH, X_WIDTH, D), X_WIDTH),
        "x_q_norm": gain((DEPTH, X_HEAD_DIM)),
        "x_k_norm": gain((DEPTH, X_HEAD_DIM)),
        "f_w_up": nrm((DEPTH, D, 2 * D_FF), D),
        "f_conv_w": nrm((DEPTH, CONV_WIDTH, D_FF), CONV_WIDTH),
        "f_conv_b": small((DEPTH, D_FF)),
        "f_w_down": nrm((DEPTH, D_FF, D), D_FF),
    }


def reference(x, mem, norm_mix, norm_x, norm_mem, norm_ffn, even_w_in, even_w_out, a_q_norm, a_k_norm,
              s5_lam_re, s5_lam_im, s5_log_step, s5_b_re, s5_b_im, s5_c_re, s5_c_im, s5_d, s5_w_glu, s5_b_glu,
              odd_w_in, odd_conv_w, odd_conv_b, odd_w_out, x_w_q, x_w_kv, x_w_o, x_q_norm, x_k_norm,
              f_w_up, f_conv_w, f_conv_b, f_w_down):
    for i in range(DEPTH):
        j = i // 2
        h = rms_norm(x, norm_mix[i])
        if i % 2 == 0:
            x = x + even_mixer(h, even_w_in[j], even_w_out[j], a_q_norm[j], a_k_norm[j],
                               s5_lam_re[j], s5_lam_im[j], s5_log_step[j], s5_b_re[j], s5_b_im[j],
                               s5_c_re[j], s5_c_im[j], s5_d[j], s5_w_glu[j], s5_b_glu[j])
        else:
            x = x + short_conv_mixer(h, odd_w_in[j], odd_conv_w[j], odd_conv_b[j], odd_w_out[j])
        x = x + memory_cross_attention(rms_norm(x, norm_x[i]), rms_norm(mem, norm_mem[i]),
                                       x_w_q[i], x_w_kv[i], x_w_o[i], x_q_norm[i], x_k_norm[i])
        x = x + conv_glu_ffn(rms_norm(x, norm_ffn[i]), f_w_up[i], f_conv_w[i], f_conv_b[i], f_w_down[i])
    return x
```

```cpp
#include <hip/hip_runtime.h>
#include <cstdio>
#include <cstdint>

#define LAS __attribute__((address_space(3)))
typedef unsigned short bf16_t;
typedef short bf16x8 __attribute__((ext_vector_type(8)));
typedef short s16x4 __attribute__((ext_vector_type(4)));
typedef float f32x4 __attribute__((ext_vector_type(4)));
typedef float f32x2 __attribute__((ext_vector_type(2)));
typedef unsigned u32x4 __attribute__((ext_vector_type(4)));
typedef unsigned u32x2 __attribute__((ext_vector_type(2)));

constexpr int DM = 1024, NBATCH = 8, SEQ = 4096, NTOK = NBATCH * SEQ, NMEM = 256, MEMTOK = NBATCH * NMEM, DFF = 2816;
constexpr float EPS = 1e-6f;
constexpr int NWAVES = 8, NTHREADS = 512;

constexpr size_t MiB = 1u << 20;
constexpr size_t WS_CTL = 0, CTL_ZERO_BYTES = 65536;
constexpr size_t WS_W = 1 * MiB;
constexpr size_t W_EIN = 0, W_EOUT = 6 * MiB, W_GLU = 10 * MiB, W_OIN = 11 * MiB, W_OOUT = 27 * MiB, W_XQ = 31 * MiB, W_XKV = 35 * MiB, W_XO = 43 * MiB, W_UP = 47 * MiB, W_DN = 91 * MiB;
constexpr size_t WS_XB = 115 * MiB, WS_SSQ = 179 * MiB, WS_MEMB = 180 * MiB, WS_MEMRS = 184 * MiB, WS_MEMKV = 185 * MiB, WS_S5OP = 201 * MiB, WS_HALO = 211 * MiB, WS_R = 224 * MiB, WS_END = 416 * MiB;
constexpr size_t S5OP_STRIDE = 160 * 1024, S5OP_PM = 16 * 1024, S5OP_QM = 80 * 1024, S5OP_A16 = 144 * 1024;
constexpr size_t HALO_FT = 0, HALO_FH = 3 * MiB, HALO_OT = 9 * MiB, HALO_OH = 10 * MiB;
constexpr size_t R_ACT = 0, R_Q = 0, R_KV = 32 * MiB, R_IK = 40 * MiB, R_IQ = 44 * MiB, R_IW = 60 * MiB, R_U = 61 * MiB, R_A2 = 93 * MiB, R_YG = 157 * MiB, R_MIX = 0, R_QX = 0, R_OX = 32 * MiB;
constexpr int CW_BAR = 4096;

constexpr int RING_BYTES = 131072, EPI_OFF = 131072, LDS_BYTES = 147456, LDSCTL_OFF = LDS_BYTES - 256;

__device__ __forceinline__ unsigned f2bf(float f) { unsigned u = __builtin_bit_cast(unsigned, f); return (u + 0x7fffu + ((u >> 16) & 1u)) >> 16; }
__device__ __forceinline__ unsigned pk2(float lo, float hi) { return f2bf(lo) | (f2bf(hi) << 16); }
__device__ __forceinline__ unsigned cvt_pk_bf16(float lo, float hi) { unsigned r; asm volatile("v_cvt_pk_bf16_f32 %0, %1, %2" : "=v"(r) : "v"(lo), "v"(hi)); return r; }
__device__ __forceinline__ float bf2f(unsigned short b) { return __builtin_bit_cast(float, (unsigned)b << 16); }
__device__ __forceinline__ float bflo(unsigned w) { return __builtin_bit_cast(float, w << 16); }
__device__ __forceinline__ float bfhi(unsigned w) { return __builtin_bit_cast(float, w & 0xffff0000u); }
__device__ __forceinline__ int fresh_tid() { int t = threadIdx.x; asm volatile("" : "+v"(t)); return t; }
#define LDS_WAIT() asm volatile("s_waitcnt lgkmcnt(0)" ::: "memory")
#define VM_WAIT() asm volatile("s_waitcnt vmcnt(0)" ::: "memory")
__device__ __forceinline__ float wave_sum(float v) {
#pragma unroll
    for (int o = 1; o < 64; o <<= 1) v += __shfl_xor(v, o);
    return v;
}
__device__ __forceinline__ int wave_sum_i(int v) {
#pragma unroll
    for (int o = 1; o < 64; o <<= 1) v += __shfl_xor(v, o);
    return v;
}
__device__ __forceinline__ float silu_f(float x) { return x / (1.f + __expf(-x)); }
__device__ __forceinline__ float sigmoid_f(float x) { return 1.f / (1.f + __expf(-x)); }
__device__ __forceinline__ float gelu_tanh_f(float y) { const float a = 0.7978845608f * (y + 0.044715f * y * y * y); const float t = 1.f - 2.f / (__expf(2.f * a) + 1.f); return 0.5f * y * (1.f + t); }
__device__ __forceinline__ float rs_from_ssq(const float* ssq, int row) { const f32x4 s = *(const f32x4*)(ssq + 4 * (size_t)row); return rsqrtf(((s.x + s.y) + (s.z + s.w)) * (1.f / DM) + EPS); }
__device__ __forceinline__ bf16x8 as_bf16x8(u32x4 v) { return __builtin_bit_cast(bf16x8, v); }

namespace pg8 {
constexpr int BM = 256, BK = 64, HALF = 128, HTB = HALF * BK * 2, STAGE_BYTES = 8 * HTB, NXCD = 8, WGM = 8;
__host__ __device__ __forceinline__ int lds_byte(int r, int c) { const int st = (r >> 4) * 2 + (c >> 5), rr = r & 15, cc = c & 31, ob = rr * 64 + cc * 2; return st * 1024 + (ob ^ (((ob >> 9) & 1) << 5)); }
__host__ __device__ __forceinline__ void stage_rc(int b, int& R, int& C) { const int st = b / 1024, sb = b % 1024, swz = sb ^ (((sb >> 9) & 1) << 5); R = (st >> 1) * 16 + swz / 64; C = (st & 1) * 32 + (swz % 64) / 2; }
struct Unit { int pm, pn; };
struct Gemm { const bf16_t* A; const bf16_t* Bt; int lda, ldb, K; };
struct StaticOrder {
    int nM, nN, nwg, G, c;
    __device__ __forceinline__ void init(int M, int N, int G_, int c_) { nM = M / BM; nN = N / BM; nwg = nM * nN; G = G_; c = c_; }
    __device__ __forceinline__ bool next(int i, Unit& u) const {
        const long L = (long)i * G + c; if (L >= nwg) return false;
        int wgid = (int)L; { const int q = nwg / NXCD, r = nwg % NXCD, xcd = wgid % NXCD, off = wgid / NXCD; wgid = (xcd < r ? xcd * (q + 1) : r * (q + 1) + (xcd - r) * q) + off; }
        const int nig = WGM * nN, gid = wgid / nig, fm = gid * WGM, gsz = (nM - fm) < WGM ? (nM - fm) : WGM;
        u.pm = fm + ((wgid % nig) % gsz); u.pn = (wgid % nig) / gsz; return true;
    }
};
template <class Epi>
__device__ __forceinline__ void gemm_phase(LAS unsigned char* lds, const Gemm g, const StaticOrder& S, const Epi& E) {
    const int tid = fresh_tid(), wid = __builtin_amdgcn_readfirstlane(tid >> 6), lane = tid & 63, wr = wid >> 2, wc = wid & 3, fr = lane & 15, fq = lane >> 4;
    const int K = g.K, nt = K / BK;
    unsigned voffA[2], voffB[2];
#pragma unroll
    for (int i = 0; i < 2; ++i) { int R, C; stage_rc(tid * 16 + i * 8192, R, C); voffA[i] = (unsigned)(R * g.lda + C) * 2u; voffB[i] = (unsigned)(R * g.ldb + C) * 2u; }
    const size_t kstep = (size_t)(BK * 2);
    const size_t hstepA = (size_t)HALF * g.lda * 2, hstepB = (size_t)HALF * g.ldb * 2, tstepA = 2 * hstepA, tstepB = 2 * hstepB;
    const unsigned ldsw = (unsigned)wid * 1024u;
    const int aoff = lds_byte(wr * 64 + fr, fq * 8), boff = lds_byte(wc * 32 + fr, fq * 8);
#define PG8_SA(b, h) (((b) * 2 + (h)) * HTB)
#define PG8_SB(b, h) ((4 + (b) * 2 + (h)) * HTB)
#define PG8_STAGE(bufoff, gbase, voff) do { _Pragma("unroll") for (int _i = 0; _i < 2; ++_i) \
        __builtin_amdgcn_global_load_lds((const unsigned*)((const char*)(gbase) + (voff)[_i]), (LAS unsigned*)(lds + (bufoff) + ldsw + _i * 8192), 16, 0, 0); } while (0)
#define PG8_LDA(dst, b, h) do { _Pragma("unroll") for (int m = 0; m < 4; ++m) _Pragma("unroll") for (int k = 0; k < 2; ++k) dst[m][k] = *(const LAS bf16x8*)(lds + PG8_SA(b, h) + aoff + m * 2048 + k * 1024); } while (0)
#define PG8_LDB(dst, b, h) do { _Pragma("unroll") for (int n = 0; n < 2; ++n) _Pragma("unroll") for (int k = 0; k < 2; ++k) dst[n][k] = *(const LAS bf16x8*)(lds + PG8_SB(b, h) + boff + n * 2048 + k * 1024); } while (0)
#define PG8_MMA(ai, bj, At, Bt) do { __builtin_amdgcn_s_setprio(1); _Pragma("unroll") for (int m = 0; m < 4; ++m) _Pragma("unroll") for (int n = 0; n < 2; ++n) _Pragma("unroll") for (int k = 0; k < 2; ++k) \
        acc[ai][bj][m][n] = __builtin_amdgcn_mfma_f32_16x16x32_bf16(Bt[n][k], At[m][k], acc[ai][bj][m][n], 0, 0, 0); __builtin_amdgcn_s_setprio(0); } while (0)
#define PG8_WAIT_V(n) asm volatile("s_waitcnt vmcnt(" #n ")" ::: "memory")
#define PG8_WAIT_L(n) asm volatile("s_waitcnt lgkmcnt(" #n ")" ::: "memory")
#define PG8_BAR __builtin_amdgcn_s_barrier()
#define PG8_SCHED __builtin_amdgcn_sched_barrier(0)
    Unit cur, nxt; int ui = 0;
    if (!S.next(0, cur)) return;
    f32x4 acc[2][2][4][2];
#pragma unroll
    for (int a = 0; a < 2; ++a)
#pragma unroll
        for (int b = 0; b < 2; ++b)
#pragma unroll
            for (int m = 0; m < 4; ++m)
#pragma unroll
                for (int n = 0; n < 2; ++n) acc[a][b][m][n] = (f32x4){0.f, 0.f, 0.f, 0.f};
    bf16x8 At[4][2], B0[2][2], B1[2][2];
    const char* cA = (const char*)g.A + (size_t)cur.pm * tstepA; const char* cB = (const char*)g.Bt + (size_t)cur.pn * tstepB;
    PG8_STAGE(PG8_SB(0, 0), cB, voffB); PG8_STAGE(PG8_SB(0, 1), cB + hstepB, voffB); PG8_STAGE(PG8_SA(0, 0), cA, voffA); PG8_STAGE(PG8_SA(0, 1), cA + hstepA, voffA);
    if (wr == 1) PG8_BAR;
    PG8_WAIT_V(2); PG8_BAR;
    PG8_STAGE(PG8_SB(1, 0), cB + kstep, voffB); PG8_STAGE(PG8_SA(1, 0), cA + kstep, voffA); PG8_STAGE(PG8_SB(1, 1), cB + hstepB + kstep, voffB);
    PG8_WAIT_V(6); PG8_BAR;
    for (;;) {
        const bool has_next = S.next(ui + 1, nxt);
        const char* nA = has_next ? (const char*)g.A + (size_t)nxt.pm * tstepA : cA; const char* nB = has_next ? (const char*)g.Bt + (size_t)nxt.pn * tstepB : cB;
        for (int t = 0; t < nt; t += 2) {
            const bool last = (t == nt - 2);
            const char* a1 = cA + (size_t)(t + 1) * kstep;
            const char* a2 = last ? nA : cA + (size_t)(t + 2) * kstep; const char* b2 = last ? nB : cB + (size_t)(t + 2) * kstep;
            const char* a3 = a2 + kstep; const char* b3 = b2 + kstep;
            PG8_LDB(B0, 0, 0); PG8_LDB(B1, 0, 1); PG8_SCHED; PG8_LDA(At, 0, 0); PG8_STAGE(PG8_SA(1, 1), a1 + hstepA, voffA);
            PG8_WAIT_V(8); PG8_WAIT_L(0); PG8_BAR; PG8_MMA(0, 0, At, B0); PG8_MMA(0, 1, At, B1); PG8_BAR; PG8_SCHED;
            PG8_LDA(At, 0, 1); PG8_STAGE(PG8_SB(0, 0), b2, voffB); PG8_STAGE(PG8_SB(0, 1), b2 + hstepB, voffB); PG8_STAGE(PG8_SA(0, 0), a2, voffA);
            PG8_WAIT_V(8); PG8_WAIT_L(0); PG8_BAR; PG8_MMA(1, 0, At, B0); PG8_MMA(1, 1, At, B1); PG8_BAR; PG8_SCHED;
            PG8_LDB(B0, 1, 0); PG8_LDB(B1, 1, 1); PG8_SCHED; PG8_LDA(At, 1, 0); PG8_STAGE(PG8_SA(0, 1), a2 + hstepA, voffA);
            PG8_WAIT_V(8); PG8_WAIT_L(0); PG8_BAR; PG8_MMA(0, 0, At, B0); PG8_MMA(0, 1, At, B1); PG8_BAR; PG8_SCHED;
            PG8_LDA(At, 1, 1); PG8_STAGE(PG8_SB(1, 0), b3, voffB); PG8_STAGE(PG8_SB(1, 1), b3 + hstepB, voffB); PG8_STAGE(PG8_SA(1, 0), a3, voffA);
            PG8_WAIT_V(8); PG8_WAIT_L(0); PG8_BAR; PG8_MMA(1, 0, At, B0); PG8_MMA(1, 1, At, B1); PG8_BAR; PG8_SCHED;
        }
        if (wr == 0) PG8_BAR;
        E(acc, cur, wr, wc, fr, fq);
        if (!has_next) break;
#pragma unroll
        for (int a = 0; a < 2; ++a)
#pragma unroll
            for (int b = 0; b < 2; ++b)
#pragma unroll
                for (int m = 0; m < 4; ++m)
#pragma unroll
                    for (int n = 0; n < 2; ++n) acc[a][b][m][n] = (f32x4){0.f, 0.f, 0.f, 0.f};
        cur = nxt; cA = nA; cB = nB; ++ui;
        if (wr == 1) PG8_BAR;
    }
    PG8_WAIT_V(0);
    PG8_BAR;
#undef PG8_SA
#undef PG8_SB
#undef PG8_STAGE
#undef PG8_LDA
#undef PG8_LDB
#undef PG8_MMA
#undef PG8_WAIT_V
#undef PG8_WAIT_L
#undef PG8_SCHED
}
}
#define WG_BAR() do { asm volatile("s_waitcnt lgkmcnt(0)" ::: "memory"); __builtin_amdgcn_s_barrier(); asm volatile("" ::: "memory"); } while (0)

#define XB_TMO      128
#define XB_XCNT(j)  (256  + 64 * (j))
#define XB_XSUB(j)  (1280 + 64 * (j))
#define XB_XGEN(j)  (2304 + 64 * (j))
#define XB_TOP      3328
#define XB_TOPGEN   3392
#define XCD_BAR_WORDS 3456
#define XB_SPIN_CAP (1u << 18)
__device__ __forceinline__ unsigned xb_ld(unsigned* p)              { return __hip_atomic_load(p, __ATOMIC_RELAXED, __HIP_MEMORY_SCOPE_AGENT); }
__device__ __forceinline__ unsigned xb_add(unsigned* p, unsigned v) { return __hip_atomic_fetch_add(p, v, __ATOMIC_RELAXED, __HIP_MEMORY_SCOPE_AGENT); }
__device__ __forceinline__ unsigned xb_xcc_id() { return (unsigned)__builtin_amdgcn_s_getreg((3 << 11) | 20) & 0xFu; }
#define XB_SPIN(cond, bar) do { unsigned _sp = 0; while (cond) { __builtin_amdgcn_s_sleep(1); \
    if ((++_sp & 255u) == 0u) { if (xb_ld(&(bar)[XB_TMO])) break; if (_sp > XB_SPIN_CAP) { atomicAdd(&(bar)[XB_TMO], 1u); break; } } } } while (0)
struct XcdBarrier { unsigned* bar; unsigned x; volatile LAS unsigned* st; };
__device__ __forceinline__ XcdBarrier xcd_barrier_post(unsigned* bar, volatile LAS unsigned* st) {
    XcdBarrier b; b.bar = bar; b.x = xb_xcc_id(); b.st = st;
    if (threadIdx.x == 0) (void)xb_add(&bar[XB_XCNT(b.x)], 1u);
    return b;
}
__device__ __forceinline__ void xcd_barrier_complete(unsigned* bar, unsigned x, unsigned& nloc, unsigned& nx) {
    const unsigned G = gridDim.x * gridDim.y * gridDim.z;
    unsigned sum, cnt, mine, sp = 0u;
    for (;;) {
        sum = 0u; cnt = 0u; mine = 0u;
#pragma unroll
        for (unsigned j = 0; j < 16; ++j) { const unsigned c = xb_ld(&bar[XB_XCNT(j)]); sum += c; cnt += (c > 0u) ? 1u : 0u; mine = (j == x) ? c : mine; }
        if (sum == G) break;
        __builtin_amdgcn_s_sleep(1);
        if ((++sp & 255u) == 0u) { if (xb_ld(&bar[XB_TMO])) break; if (sp > XB_SPIN_CAP) { atomicAdd(&bar[XB_TMO], 1u); break; } }
    }
    nloc = mine > 0u ? mine : 1u; nx = cnt > 0u ? cnt : 1u;
}
__device__ __forceinline__ void xcd_barrier(const XcdBarrier& b) {
    asm volatile("s_waitcnt vmcnt(0)" ::: "memory");
    __syncthreads();
    if (threadIdx.x == 0) {
        unsigned* bar = b.bar;
        __builtin_amdgcn_s_waitcnt(0);
        unsigned nloc = b.st[0], nx = b.st[1];
        if (nloc == 0u) { xcd_barrier_complete(bar, b.x, nloc, nx); b.st[0] = nloc; b.st[1] = nx; }
        const unsigned old = xb_add(&bar[XB_XSUB(b.x)], 1u);
        const unsigned gen = old / nloc;
        if (old + 1u == (gen + 1u) * nloc) {
            __builtin_amdgcn_fence(__ATOMIC_RELEASE, "agent");
            asm volatile("s_waitcnt vmcnt(0)" ::: "memory");
            const unsigned og = xb_add(&bar[XB_TOP], 1u);
            const unsigned tg = og / nx;
            if (og + 1u == (tg + 1u) * nx) xb_add(&bar[XB_TOPGEN], 1u);
            else XB_SPIN(xb_ld(&bar[XB_TOPGEN]) == tg, bar);
            __builtin_amdgcn_fence(__ATOMIC_ACQUIRE, "agent");
            xb_add(&bar[XB_XGEN(b.x)], 1u);
            asm volatile("s_waitcnt vmcnt(0)" ::: "memory");
        } else {
            XB_SPIN(xb_ld(&bar[XB_XGEN(b.x)]) == gen, bar);
            __builtin_amdgcn_fence(__ATOMIC_ACQUIRE, "agent");
            asm volatile("s_waitcnt vmcnt(0)" ::: "memory");
        }
    }
    __syncthreads();
}

enum MapId { MAP_STD = 0, MAP_EVEN_IN = 1, MAP_XQ = 2, MAP_XKV = 3, MAP_FFN_UP = 4, MAP_ODD_IN = 5 };
__device__ __forceinline__ int colmap(int mapid, int n) {
    const int pn = n >> 8, s = n & 255, bj = s >> 7, wc = (s >> 5) & 3, nn = (s >> 4) & 1, fq = (s >> 2) & 3, i = s & 3;
    const int d32 = 8 * fq + 4 * nn + i, hd = 32 * bj + d32;
    switch (mapid) {
    case MAP_STD: return 256 * pn + 128 * bj + 32 * wc + d32;
    case MAP_EVEN_IN:
        if (pn <= 1) return (4 * pn + wc) * 64 + hd;
        if (pn == 2) { if (wc == 0) return 512 + hd; if (wc == 1) return 576 + hd; if (wc == 2) return 896 + hd; return hd < 4 ? 960 + hd : -1; }
        if (pn == 3) return 640 + wc * 64 + hd;
        return 964 + 256 * (pn - 4) + 128 * bj + 32 * wc + d32;
    case MAP_XQ: return (2 * pn + (wc >> 1)) * 128 + 64 * (wc & 1) + hd;
    case MAP_XKV:
        if (pn <= 1) return (2 * pn + (wc >> 1)) * 128 + 64 * (wc & 1) + hd;
        return 512 + 256 * (pn - 2) + 128 * bj + 32 * wc + d32;
    case MAP_FFN_UP: { const int ch = 128 * pn + 32 * wc + d32; return bj ? DFF + ch : ch; }
    default: { const int ch = 64 * pn + 16 * wc + 4 * fq + i, q = 2 * bj + nn; return q == 3 ? -1 : q * 1024 + ch; }
    }
}
struct PrepJob { const float* W; const float* gain; bf16_t* dst; int K, N, npad, mapid; };
__device__ __forceinline__ void prep_item(const PrepJob& J, LAS float* scr, int item, int lane) {
    const int nblk = J.npad / 32, kb = item / nblk, nb = item % nblk, k0 = 64 * kb, n0 = 32 * nb;
    const int col = colmap(J.mapid, n0 + (lane & 31));
#pragma unroll 8
    for (int i = 0; i < 32; ++i) { const int kk = 2 * i + (lane >> 5); float v = 0.f; if (col >= 0) v = J.W[(size_t)(k0 + kk) * J.N + col]; if (J.gain) v *= J.gain[k0 + kk]; scr[kk * 33 + (lane & 31)] = v; }
    LDS_WAIT();
    const int c = lane & 7;
#pragma unroll
    for (int j = 0; j < 4; ++j) { const int n = (lane >> 3) + 8 * j; const LAS float* s = scr + (8 * c) * 33 + n;
        u32x4 o; o.x = pk2(s[0 * 33], s[1 * 33]); o.y = pk2(s[2 * 33], s[3 * 33]); o.z = pk2(s[4 * 33], s[5 * 33]); o.w = pk2(s[6 * 33], s[7 * 33]);
        *(u32x4*)(J.dst + (size_t)(n0 + n) * J.K + k0 + 8 * c) = o; }
    LDS_WAIT();
}

struct Params { const float* in[33]; float* out; unsigned char* ws; int ph_lo, ph_hi; };
enum InIdx { I_X = 0, I_MEM, I_NORM_MIX, I_NORM_X, I_NORM_MEM, I_NORM_FFN, I_EW_IN, I_EW_OUT, I_AQN, I_AKN, I_LAM_RE, I_LAM_IM, I_LOGSTEP, I_B_RE, I_B_IM, I_C_RE, I_C_IM, I_S5D, I_WGLU, I_BGLU,
             I_OW_IN, I_OCONV_W, I_OCONV_B, I_OW_OUT, I_XWQ, I_XWKV, I_XWO, I_XQN, I_XKN, I_FWUP, I_FCONV_W, I_FCONV_B, I_FWDN };

__device__ __forceinline__ bool get_job(const Params& P, int job, PrepJob& J) {
    bf16_t* wb = (bf16_t*)(P.ws + WS_W);
    if (job < 6) { const int j = job & 1, k = job >> 1;
        if (k == 0) { J = PrepJob{P.in[I_EW_IN] + (size_t)j * DM * 1476, P.in[I_NORM_MIX] + (2 * j) * DM, (bf16_t*)((char*)wb + W_EIN + j * 3 * MiB), DM, 1476, 1536, MAP_EVEN_IN}; return true; }
        if (k == 1) { J = PrepJob{P.in[I_EW_OUT] + (size_t)j * DM * DM, nullptr, (bf16_t*)((char*)wb + W_EOUT + j * 2 * MiB), DM, DM, DM, MAP_STD}; return true; }
        J = PrepJob{P.in[I_WGLU] + (size_t)j * 512 * 512, nullptr, (bf16_t*)((char*)wb + W_GLU + j * (MiB / 2)), 512, 512, 512, MAP_STD}; return true; }
    job -= 6;
    if (job < 4) { const int j = job & 1, k = job >> 1;
        if (k == 0) { J = PrepJob{P.in[I_OW_IN] + (size_t)j * DM * 3072, P.in[I_NORM_MIX] + (2 * j + 1) * DM, (bf16_t*)((char*)wb + W_OIN + j * 8 * MiB), DM, 3072, 4096, MAP_ODD_IN}; return true; }
        J = PrepJob{P.in[I_OW_OUT] + (size_t)j * DM * DM, nullptr, (bf16_t*)((char*)wb + W_OOUT + j * 2 * MiB), DM, DM, DM, MAP_STD}; return true; }
    job -= 4;
    if (job < 20) { const int i = job & 3, k = job >> 2;
        if (k == 0) { J = PrepJob{P.in[I_XWQ] + (size_t)i * DM * 512, P.in[I_NORM_X] + i * DM, (bf16_t*)((char*)wb + W_XQ + i * MiB), DM, 512, 512, MAP_XQ}; return true; }
        if (k == 1) { J = PrepJob{P.in[I_XWKV] + (size_t)i * DM * 1024, P.in[I_NORM_MEM] + i * DM, (bf16_t*)((char*)wb + W_XKV + i * 2 * MiB), DM, 1024, 1024, MAP_XKV}; return true; }
        if (k == 2) { J = PrepJob{P.in[I_XWO] + (size_t)i * 512 * DM, nullptr, (bf16_t*)((char*)wb + W_XO + i * MiB), 512, DM, DM, MAP_STD}; return true; }
        if (k == 3) { J = PrepJob{P.in[I_FWUP] + (size_t)i * DM * 2 * DFF, P.in[I_NORM_FFN] + i * DM, (bf16_t*)((char*)wb + W_UP + i * 11 * MiB), DM, 2 * DFF, 2 * DFF, MAP_FFN_UP}; return true; }
        J = PrepJob{P.in[I_FWDN] + (size_t)i * DFF * DM, nullptr, (bf16_t*)((char*)wb + W_DN + i * (11 * MiB / 2)), DFF, DM, DM, MAP_STD}; return true; }
    return false;
}
constexpr int NJOBS = 30;

__device__ __forceinline__ f32x2 cmul(f32x2 a, f32x2 b) { return (f32x2){a.x * b.x - a.y * b.y, a.x * b.y + a.y * b.x}; }
__device__ __forceinline__ void s5_precompute(const Params& P, LAS unsigned char* lds, int task) {
    const int tid = fresh_tid(), jg = task;
    LAS f32x2* PW = (LAS f32x2*)lds;
    LAS f32x2* BB = PW + 17 * 64;
    LAS f32x2* CC = BB + 64 * 16;
    unsigned char* op = P.ws + WS_S5OP + (size_t)jg * S5OP_STRIDE;
    if (tid < 64) {
        const int p = tid;
        const float delta = expf(P.in[I_LOGSTEP][jg]);
        const float lre = P.in[I_LAM_RE][jg * 64 + p], lim = P.in[I_LAM_IM][jg * 64 + p];
        for (int n = 0; n <= 16; ++n) { const float mag = expf((float)n * lre * delta); float sn, cs; sincosf((float)n * lim * delta, &sn, &cs); PW[n * 64 + p] = (f32x2){mag * cs, mag * sn}; }
        const f32x2 lb = PW[64 + p]; const float nr = lb.x - 1.f, ni = lb.y, den = lre * lre + lim * lim;
        const f32x2 coef = (f32x2){(nr * lre + ni * lim) / den, (ni * lre - nr * lim) / den};
        for (int c = 0; c < 16; ++c) { const f32x2 b = (f32x2){P.in[I_B_RE][((size_t)jg * 64 + p) * 16 + c], P.in[I_B_IM][((size_t)jg * 64 + p) * 16 + c]}; BB[p * 16 + c] = cmul(coef, b); }
        for (int c = 0; c < 16; ++c) CC[c * 64 + p] = (f32x2){P.in[I_C_RE][((size_t)jg * 16 + c) * 64 + p], P.in[I_C_IM][((size_t)jg * 16 + c) * 64 + p]};
        ((f32x2*)(op + S5OP_A16))[p] = PW[16 * 64 + p];
    }
    __syncthreads();
    bf16_t* Km = (bf16_t*)op; bf16_t* Pm = (bf16_t*)(op + S5OP_PM); bf16_t* Qm = (bf16_t*)(op + S5OP_QM);
    for (int idx = tid; idx < 17 * 256; idx += NTHREADS) {
        const int dd = idx >> 8, c1 = (idx >> 4) & 15, c = idx & 15; float v = 0.f;
        if (dd > 0) { const int d = dd - 1; for (int p = 0; p < 64; ++p) { const f32x2 m = cmul(cmul(CC[c1 * 64 + p], PW[d * 64 + p]), BB[p * 16 + c]); v += m.x; } }
        Km[idx] = (bf16_t)f2bf(v);
    }
    for (int idx = tid; idx < 128 * 256; idx += NTHREADS) {
        const int row = idx >> 8, col = idx & 255, p = row >> 1, ri = row & 1, tau = col >> 4, c = col & 15;
        const f32x2 m = cmul(PW[(15 - tau) * 64 + p], BB[p * 16 + c]);
        Pm[idx] = (bf16_t)f2bf(ri ? m.y : m.x);
    }
    for (int idx = tid; idx < 256 * 128; idx += NTHREADS) {
        const int row = idx >> 7, col = idx & 127, tau = row >> 4, c1 = row & 15, p = col >> 1, ri = col & 1;
        const f32x2 m = cmul(CC[c1 * 64 + p], PW[(tau + 1) * 64 + p]);
        Qm[idx] = (bf16_t)f2bf(ri ? -m.y : m.x);
    }
    __syncthreads();
}

__device__ __forceinline__ void prologue(const Params& P, LAS unsigned char* lds, int gw, int NGW, int wave, int lane) {
    for (int task = blockIdx.x; task < 64; task += gridDim.x) s5_precompute(P, lds, task);
    LAS float* scr = (LAS float*)(lds + wave * 16384);
    {
        int base = 0;
        for (int job = 0; job < NJOBS; ++job) {
            PrepJob J; get_job(P, job, J);
            const int nitems = (J.npad / 32) * (J.K / 64);
            int first = gw - (base % NGW); if (first < 0) first += NGW;
            for (int it = first; it < nitems; it += NGW) prep_item(J, scr, it, lane);
            base += nitems;
        }
    }
    {
        const float* x = P.in[I_X]; float* xf = P.out; bf16_t* xb = (bf16_t*)(P.ws + WS_XB); float* ssq = (float*)(P.ws + WS_SSQ);
        for (int m = gw; m < NTOK; m += NGW) {
            const f32x4* xr = (const f32x4*)(x + (size_t)m * DM) + lane; f32x4* xo = (f32x4*)(xf + (size_t)m * DM) + lane; u32x2* bo = (u32x2*)(xb + (size_t)m * DM) + lane;
            float sq[4];
#pragma unroll
            for (int j = 0; j < 4; ++j) { const f32x4 v = xr[64 * j]; xo[64 * j] = v; bo[64 * j] = (u32x2){pk2(v.x, v.y), pk2(v.z, v.w)}; sq[j] = wave_sum((v.x * v.x + v.y * v.y) + (v.z * v.z + v.w * v.w)); }
            if (lane == 0) *(f32x4*)(ssq + 4 * (size_t)m) = (f32x4){sq[0], sq[1], sq[2], sq[3]};
        }
    }
    {
        const float* mem = P.in[I_MEM]; bf16_t* mb = (bf16_t*)(P.ws + WS_MEMB); float* mrs = (float*)(P.ws + WS_MEMRS);
        for (int m = gw; m < MEMTOK; m += NGW) {
            const f32x4* xr = (const f32x4*)(mem + (size_t)m * DM) + lane; u32x2* bo = (u32x2*)(mb + (size_t)m * DM) + lane;
            float s = 0.f;
#pragma unroll
            for (int j = 0; j < 4; ++j) { const f32x4 v = xr[64 * j]; bo[64 * j] = (u32x2){pk2(v.x, v.y), pk2(v.z, v.w)}; s += (v.x * v.x + v.y * v.y) + (v.z * v.z + v.w * v.w); }
            s = wave_sum(s);
            if (lane == 0) mrs[m] = rsqrtf(s * (1.f / DM) + EPS);
        }
    }
}

typedef const f32x4 (&AccRef)[2][2][4][2];
__device__ __forceinline__ u32x4 pack8(f32x4 a, f32x4 b) { u32x4 w; w.x = cvt_pk_bf16(a.x, a.y); w.y = cvt_pk_bf16(a.z, a.w); w.z = cvt_pk_bf16(b.x, b.y); w.w = cvt_pk_bf16(b.z, b.w); return w; }
typedef __amdgpu_buffer_rsrc_t rsrc_t;
__device__ __forceinline__ rsrc_t mkrsrc(const void* p) { return __builtin_amdgcn_make_buffer_rsrc((void*)p, 0, 0x7fffffff, 0x00020000); }
#define BLD128(r, vo, so) __builtin_amdgcn_raw_buffer_load_b128((r), (vo), (so), 0)
#define BLD64(r, vo, so) __builtin_amdgcn_raw_buffer_load_b64((r), (vo), (so), 0)
#define BST128(v, r, vo, so) __builtin_amdgcn_raw_buffer_store_b128((v), (r), (vo), (so), 0)
#define BST64(v, r, vo, so) __builtin_amdgcn_raw_buffer_store_b64((v), (r), (vo), (so), 0)
__device__ __forceinline__ f32x4 asf4(u32x4 v) { return __builtin_bit_cast(f32x4, v); }
__device__ __forceinline__ u32x4 asu4(f32x4 v) { return __builtin_bit_cast(u32x4, v); }
#define RFL(x) __builtin_amdgcn_readfirstlane(x)
__device__ __forceinline__ float rs_row(rsrc_t rq, int vq, int ai, int m) { const f32x4 s = asf4(BLD128(rq, vq, (ai * 128 + m * 16) * 16)); return rsqrtf(((s.x + s.y) + (s.z + s.w)) * (1.f / DM) + EPS); }

struct EpiResidual {
    float* XF; bf16_t* XB; float* SSQ; LAS float* Pl;
    __device__ __forceinline__ void operator()(AccRef acc, const pg8::Unit& u, int wr, int wc, int fr, int fq) const {
        const int pm = RFL(u.pm), pn = RFL(u.pn);
        const rsrc_t rx = mkrsrc(XF + (size_t)pm * 256 * DM + pn * 256), rb = mkrsrc(XB + (size_t)pm * 256 * DM + pn * 256);
        const int vx = ((wr * 64 + fr) * DM + wc * 32 + 8 * fq) * 4, vb = vx >> 1;
#pragma unroll
        for (int ai = 0; ai < 2; ++ai)
#pragma unroll
            for (int m = 0; m < 4; ++m) {
                const int rl = ai * 128 + wr * 64 + m * 16 + fr; float s = 0.f;
#pragma unroll
                for (int bj = 0; bj < 2; ++bj) {
                    const int so = ((ai * 128 + m * 16) * DM + bj * 128) * 4;
                    f32x4 a = asf4(BLD128(rx, vx, so)), b = asf4(BLD128(rx, vx, so + 16));
                    a += acc[ai][bj][m][0]; b += acc[ai][bj][m][1];
                    BST128(asu4(a), rx, vx, so); BST128(asu4(b), rx, vx, so + 16);
                    BST128(pack8(a, b), rb, vb, so >> 1);
                    s += (a.x * a.x + a.y * a.y) + (a.z * a.z + a.w * a.w) + (b.x * b.x + b.y * b.y) + (b.z * b.z + b.w * b.w);
                }
                s += __shfl_xor(s, 16); s += __shfl_xor(s, 32);
                if (fq == 0) Pl[rl * 4 + wc] = s;
            }
        WG_BAR();
        const int t8 = (wr * 4 + wc) * 64 + fq * 16 + fr;
        if (t8 < 256) { const f32x4 p = *(const LAS f32x4*)(Pl + t8 * 4); SSQ[((size_t)pm * 256 + t8) * 4 + pn] = (p.x + p.y) + (p.z + p.w); }
        WG_BAR();
    }
};

struct EpiEvenIn {
    const float* SSQ; const float* qg; const float* kg;
    bf16_t *Q, *KV, *IK, *IQ, *U; float* IW;
    __device__ __forceinline__ void operator()(AccRef acc, const pg8::Unit& u, int wr, int wc, int fr, int fq) const {
        const int pm = RFL(u.pm), pn = RFL(u.pn);
        int kind;
        bf16_t* dst; int rowstride, bjoff; const float* gain = qg; float post = 1.f;
        if (pn <= 1) { kind = 0; dst = Q + (4 * pn + wc) * 64; rowstride = 512; bjoff = 32; gain = qg; post = 0.125f; }
        else if (pn == 2) {
            if (wc == 0) { kind = 0; dst = KV; rowstride = 128; bjoff = 32; gain = kg; }
            else if (wc == 1) { kind = 1; dst = KV + 64; rowstride = 128; bjoff = 32; }
            else if (wc == 2) { kind = 1; dst = IK; rowstride = 64; bjoff = 32; }
            else { kind = 2; dst = (bf16_t*)IW; rowstride = 8; bjoff = 0; }
        }
        else if (pn == 3) { kind = 1; dst = IQ + wc * 64; rowstride = 256; bjoff = 32; }
        else { kind = 3; dst = U + 256 * (pn - 4) + 32 * wc; rowstride = 512; bjoff = 128; }
        const rsrc_t rd = mkrsrc(dst + (size_t)pm * 256 * rowstride), rq = mkrsrc(SSQ + (size_t)pm * 256 * 4);
        const int vq = (wr * 64 + fr) * 16;
        const int vd = ((wr * 64 + fr) * rowstride + 8 * fq) * 2;
        const int rsb = rowstride * 2, bjb = bjoff * 2;
#pragma unroll
        for (int ai = 0; ai < 2; ++ai)
#pragma unroll
            for (int m = 0; m < 4; ++m) {
                float r = rs_row(rq, vq, ai, m);
                if (kind == 0) {
                    float ss = 0.f;
#pragma unroll
                    for (int bj = 0; bj < 2; ++bj)
#pragma unroll
                        for (int n = 0; n < 2; ++n) { const f32x4 v = acc[ai][bj][m][n]; ss += (v.x * v.x + v.y * v.y) + (v.z * v.z + v.w * v.w); }
                    ss += __shfl_xor(ss, 16); ss += __shfl_xor(ss, 32);
                    ss *= r * r;
                    r *= rsqrtf(ss * (1.f / 64.f) + EPS) * post;
                }
                if (kind == 2) {
                    if (fq == 0) BST128(asu4(acc[ai][0][m][0] * (r * 0.0625f)), rd, (wr * 64 + fr) * 16, (ai * 128 + m * 16) * 16);
                } else {
#pragma unroll
                    for (int bj = 0; bj < 2; ++bj) {
                        f32x4 g0 = (f32x4){1.f, 1.f, 1.f, 1.f}, g1 = g0;
                        if (kind == 0) { g0 = *(const f32x4*)(gain + 32 * bj + 8 * fq); g1 = *(const f32x4*)(gain + 32 * bj + 8 * fq + 4); }
                        BST128(pack8(acc[ai][bj][m][0] * r * g0, acc[ai][bj][m][1] * r * g1), rd, vd, (ai * 128 + m * 16) * rsb + bj * bjb);
                    }
                }
            }
    }
};

struct EpiHead128 {
    const float* SSQ;
    const float* RS;
    const float* gain;
    bf16_t* dst; int mode; float post; LAS float* Pl;
    __device__ __forceinline__ float rowscale(rsrc_t rq, int vq, int vr, int ai, int m) const {
        if (mode == 0) return rs_row(rq, vq, ai, m);
        return __builtin_bit_cast(float, __builtin_amdgcn_raw_buffer_load_b32(rq, vr, (ai * 128 + m * 16) * 4, 0));
    }
    __device__ __forceinline__ void operator()(AccRef acc, const pg8::Unit& u, int wr, int wc, int fr, int fq) const {
        const int pm = RFL(u.pm), pn = RFL(u.pn);
        const int layer = (mode == 1) ? (pn >> 2) : 0, jt = (mode == 1) ? (pn & 3) : pn;
        const bool normed = (mode == 0) || (jt < 2);
        const float* gl = gain + (mode == 1 ? layer * 128 : 0) + 64 * (wc & 1);
        const rsrc_t rq = (mode == 0) ? mkrsrc(SSQ + (size_t)pm * 256 * 4) : mkrsrc(RS + (size_t)pm * 256);
        const int vq = (wr * 64 + fr) * 16, vr = (wr * 64 + fr) * 4;
#pragma unroll
        for (int ai = 0; ai < 2; ++ai)
#pragma unroll
            for (int m = 0; m < 4; ++m) {
                const int rl = ai * 128 + wr * 64 + m * 16 + fr;
                const float r = rowscale(rq, vq, vr, ai, m);
                float ss = 0.f;
#pragma unroll
                for (int bj = 0; bj < 2; ++bj)
#pragma unroll
                    for (int n = 0; n < 2; ++n) { const f32x4 v = acc[ai][bj][m][n]; ss += (v.x * v.x + v.y * v.y) + (v.z * v.z + v.w * v.w); }
                ss += __shfl_xor(ss, 16); ss += __shfl_xor(ss, 32);
                if (fq == 0) Pl[rl * 4 + wc] = ss * r * r;
            }
        WG_BAR();
        int rowstride, bjoff; bf16_t* d0;
        if (mode == 0) { rowstride = 512; bjoff = 32; d0 = dst + (size_t)pm * 256 * 512 + (2 * jt + (wc >> 1)) * 128 + 64 * (wc & 1); }
        else if (jt < 2) { rowstride = 1024; bjoff = 32; d0 = dst + ((size_t)layer * MEMTOK + pm * 256) * 1024 + (2 * jt + (wc >> 1)) * 128 + 64 * (wc & 1); }
        else { rowstride = 1024; bjoff = 128; d0 = dst + ((size_t)layer * MEMTOK + pm * 256) * 1024 + 512 + 256 * (jt - 2) + 32 * wc; }
        const rsrc_t rd = mkrsrc(d0);
        const int vd = ((wr * 64 + fr) * rowstride + 8 * fq) * 2, rsb = rowstride * 2, bjb = bjoff * 2;
#pragma unroll
        for (int ai = 0; ai < 2; ++ai)
#pragma unroll
            for (int m = 0; m < 4; ++m) {
                const int rl = ai * 128 + wr * 64 + m * 16 + fr;
                float r = rowscale(rq, vq, vr, ai, m);
                if (normed) { const float ss = Pl[rl * 4 + wc] + Pl[rl * 4 + (wc ^ 1)]; r *= rsqrtf(ss * (1.f / 128.f) + EPS) * post; }
#pragma unroll
                for (int bj = 0; bj < 2; ++bj) {
                    f32x4 g0 = (f32x4){1.f, 1.f, 1.f, 1.f}, g1 = g0;
                    if (normed) { g0 = *(const f32x4*)(gl + 32 * bj + 8 * fq); g1 = *(const f32x4*)(gl + 32 * bj + 8 * fq + 4); }
                    BST128(pack8(acc[ai][bj][m][0] * r * g0, acc[ai][bj][m][1] * r * g1), rd, vd, (ai * 128 + m * 16) * rsb + bj * bjb);
                }
            }
        WG_BAR();
    }
};

struct EpiGlu {
    const bf16_t* YG; const float* bias; bf16_t* A2;
    __device__ __forceinline__ void operator()(AccRef acc, const pg8::Unit& u, int wr, int wc, int fr, int fq) const {
        const int pm = RFL(u.pm), pn = RFL(u.pn);
        const int col0 = pn * 256 + wc * 32 + 8 * fq;
        const rsrc_t ry = mkrsrc(YG + (size_t)pm * 256 * 512 + pn * 256), ro = mkrsrc(A2 + (size_t)pm * 256 * 1024 + 512 + pn * 256);
        const int vy = ((wr * 64 + fr) * 512 + wc * 32 + 8 * fq) * 2, vo = ((wr * 64 + fr) * 1024 + wc * 32 + 8 * fq) * 2;
#pragma unroll
        for (int ai = 0; ai < 2; ++ai)
#pragma unroll
            for (int m = 0; m < 4; ++m) {
#pragma unroll
                for (int bj = 0; bj < 2; ++bj) {
                    const f32x4 b0 = *(const f32x4*)(bias + col0 + bj * 128), b1 = *(const f32x4*)(bias + col0 + bj * 128 + 4);
                    const u32x4 y = BLD128(ry, vy, ((ai * 128 + m * 16) * 512 + bj * 128) * 2);
                    const f32x4 a = acc[ai][bj][m][0] + b0, b = acc[ai][bj][m][1] + b1;
                    f32x4 o0, o1;
                    o0.x = bflo(y.x) * sigmoid_f(a.x); o0.y = bfhi(y.x) * sigmoid_f(a.y); o0.z = bflo(y.y) * sigmoid_f(a.z); o0.w = bfhi(y.y) * sigmoid_f(a.w);
                    o1.x = bflo(y.z) * sigmoid_f(b.x); o1.y = bfhi(y.z) * sigmoid_f(b.y); o1.z = bflo(y.w) * sigmoid_f(b.z); o1.w = bfhi(y.w) * sigmoid_f(b.w);
                    BST128(pack8(o0, o1), ro, vo, ((ai * 128 + m * 16) * 1024 + bj * 128) * 2);
                }
            }
    }
};

__device__ __forceinline__ f32x4 shfl4(f32x4 v, int src) { f32x4 r; r.x = __shfl(v.x, src); r.y = __shfl(v.y, src); r.z = __shfl(v.z, src); r.w = __shfl(v.w, src); return r; }
__device__ __forceinline__ f32x4 sel4(bool c, f32x4 a, f32x4 b) { return c ? a : b; }

struct EpiFfnUp {
    const float* SSQ; const float* cw; const float* cb;
    bf16_t* ACT; float* TAIL; float* HEAD; LAS float* XG;
    __device__ __forceinline__ void operator()(AccRef acc, const pg8::Unit& u, int wr, int wc, int fr, int fq) const {
        const int lane = fq * 16 + fr;
        const int pm = RFL(u.pm), pn = RFL(u.pn);
        const int chl = 32 * wc + 8 * fq, ch0 = 128 * pn + chl;
        const size_t tix = (size_t)pm * 22 + pn;
        const rsrc_t rq = mkrsrc(SSQ + (size_t)pm * 256 * 4), ra = mkrsrc(ACT + (size_t)pm * 256 * DFF + 128 * pn);
        const int vq = (wr * 64 + fr) * 16, va = ((wr * 64 + fr) * DFF + chl) * 2;
#pragma unroll
        for (int ai = 0; ai < 2; ++ai) {
            const float r = rs_row(rq, vq, ai, 3);
            if (fr >= 14) {
#pragma unroll
                for (int n = 0; n < 2; ++n) {
                    const f32x4 g = acc[ai][0][3][n] * r;
                    *(LAS f32x4*)(XG + ((2 * ai + wr) * 2 + (fr - 14)) * 128 + chl + 4 * n) = g;
                    if (ai == 1 && wr == 1) *(f32x4*)(TAIL + tix * 256 + (fr - 14) * 128 + chl + 4 * n) = g;
                }
            }
        }
        WG_BAR();
        const int src1 = (lane & 48) | ((fr - 1) & 15), src2 = (lane & 48) | ((fr - 2) & 15);
#pragma unroll
        for (int n = 0; n < 2; ++n) {
            const f32x4 w0 = *(const f32x4*)(cw + ch0 + 4 * n), w1 = *(const f32x4*)(cw + DFF + ch0 + 4 * n), w2 = *(const f32x4*)(cw + 2 * DFF + ch0 + 4 * n), bb = *(const f32x4*)(cb + ch0 + 4 * n);
#pragma unroll
            for (int ai = 0; ai < 2; ++ai) {
                const int slot = 2 * ai + wr;
                f32x4 gprev = (slot > 0 && fr >= 14) ? *(const LAS f32x4*)(XG + ((slot - 1) * 2 + (fr - 14)) * 128 + chl + 4 * n) : (f32x4){0.f, 0.f, 0.f, 0.f};
#pragma unroll
                for (int m = 0; m < 4; ++m) {
                    const float r = rs_row(rq, vq, ai, m);
                    const f32x4 g = acc[ai][0][m][n] * r, uu = acc[ai][1][m][n] * r;
                    const f32x4 p1 = shfl4(sel4(fr == 15, gprev, g), src1), p2 = shfl4(sel4(fr >= 14, gprev, g), src2);
                    const f32x4 cg = w0 * p2 + w1 * p1 + w2 * g + bb;
                    f32x4 o; o.x = silu_f(cg.x) * uu.x; o.y = silu_f(cg.y) * uu.y; o.z = silu_f(cg.z) * uu.z; o.w = silu_f(cg.w) * uu.w;
                    if (ai == 0 && m == 0 && wr == 0 && fr < 2) { *(f32x4*)(HEAD + tix * 512 + fr * 128 + chl + 4 * n) = g; *(f32x4*)(HEAD + tix * 512 + (2 + fr) * 128 + chl + 4 * n) = uu; }
                    BST64(((u32x2){cvt_pk_bf16(o.x, o.y), cvt_pk_bf16(o.z, o.w)}), ra, va, ((ai * 128 + m * 16) * DFF + 4 * n) * 2);
                    gprev = g;
                }
            }
        }
        WG_BAR();
    }
};

struct EpiOddIn {
    const float* SSQ; const float* cw; const float* cb;
    bf16_t* MIX; float* TAIL; float* HEAD; LAS float* XG;
    __device__ __forceinline__ void operator()(AccRef acc, const pg8::Unit& u, int wr, int wc, int fr, int fq) const {
        const int lane = fq * 16 + fr;
        const int pm = RFL(u.pm), pn = RFL(u.pn);
        const int chl = 16 * wc + 4 * fq, ch0 = 64 * pn + chl;
        const size_t tix = (size_t)pm * 16 + pn;
        const rsrc_t rq = mkrsrc(SSQ + (size_t)pm * 256 * 4), ra = mkrsrc(MIX + (size_t)pm * 256 * DM + 64 * pn);
        const int vq = (wr * 64 + fr) * 16, va = ((wr * 64 + fr) * DM + chl) * 2;
#pragma unroll
        for (int ai = 0; ai < 2; ++ai) {
            const float r = rs_row(rq, vq, ai, 3);
            if (fr >= 14) {
                const f32x4 p = acc[ai][0][3][1] * acc[ai][1][3][0] * (r * r);
                *(LAS f32x4*)(XG + ((2 * ai + wr) * 2 + (fr - 14)) * 64 + chl) = p;
                if (ai == 1 && wr == 1) *(f32x4*)(TAIL + tix * 128 + (fr - 14) * 64 + chl) = p;
            }
        }
        WG_BAR();
        const f32x4 w0 = *(const f32x4*)(cw + ch0), w1 = *(const f32x4*)(cw + 1024 + ch0), w2 = *(const f32x4*)(cw + 2048 + ch0), bb = *(const f32x4*)(cb + ch0);
        const int src1 = (lane & 48) | ((fr - 1) & 15), src2 = (lane & 48) | ((fr - 2) & 15);
#pragma unroll
        for (int ai = 0; ai < 2; ++ai) {
            const int slot = 2 * ai + wr;
            f32x4 pprev = (slot > 0 && fr >= 14) ? *(const LAS f32x4*)(XG + ((slot - 1) * 2 + (fr - 14)) * 64 + chl) : (f32x4){0.f, 0.f, 0.f, 0.f};
#pragma unroll
            for (int m = 0; m < 4; ++m) {
                const float r = rs_row(rq, vq, ai, m);
                const f32x4 gb = acc[ai][0][m][0] * r, p = acc[ai][0][m][1] * acc[ai][1][m][0] * (r * r);
                const f32x4 p1 = shfl4(sel4(fr == 15, pprev, p), src1), p2 = shfl4(sel4(fr >= 14, pprev, p), src2);
                const f32x4 y = gb * (w0 * p2 + w1 * p1 + w2 * p + bb);
                if (ai == 0 && m == 0 && wr == 0 && fr < 2) { *(f32x4*)(HEAD + tix * 256 + fr * 64 + chl) = p; *(f32x4*)(HEAD + tix * 256 + (2 + fr) * 64 + chl) = gb; }
                BST64(((u32x2){cvt_pk_bf16(y.x, y.y), cvt_pk_bf16(y.z, y.w)}), ra, va, (ai * 128 + m * 16) * DM * 2);
                pprev = p;
            }
        }
        WG_BAR();
    }
};

__device__ __forceinline__ void fixup_ffn(const Params& P, int layer, int gtid, int gthreads) {
    const float* TAIL = (const float*)(P.ws + WS_HALO + HALO_FT); const float* HEAD = (const float*)(P.ws + WS_HALO + HALO_FH);
    const float* cw = P.in[I_FCONV_W] + (size_t)layer * 3 * DFF; const float* cb = P.in[I_FCONV_B] + (size_t)layer * DFF; bf16_t* ACT = (bf16_t*)(P.ws + WS_R + R_ACT);
    for (int idx = gtid; idx < 128 * 22 * 256; idx += gthreads) {
        const int ch = idx & 127, r = (idx >> 7) & 1, t = idx >> 8, pn = t % 22, pm = t / 22;
        if ((pm & 15) == 0) continue;
        const float* Tl = TAIL + ((size_t)(pm - 1) * 22 + pn) * 256; const float* H = HEAD + ((size_t)pm * 22 + pn) * 512;
        const int c = 128 * pn + ch; const float w0 = cw[c], w1 = cw[DFF + c], w2 = cw[2 * DFF + c], b = cb[c];
        const float gm2 = Tl[ch], gm1 = Tl[128 + ch], g0 = H[ch], g1 = H[128 + ch];
        const float cg = r == 0 ? (w0 * gm2 + w1 * gm1 + w2 * g0 + b) : (w0 * gm1 + w1 * g0 + w2 * g1 + b);
        const float uu = H[(2 + r) * 128 + ch];
        ACT[((size_t)pm * 256 + r) * DFF + c] = (bf16_t)f2bf(silu_f(cg) * uu);
    }
}
__device__ __forceinline__ void fixup_odd(const Params& P, int j, int gtid, int gthreads) {
    const float* TAIL = (const float*)(P.ws + WS_HALO + HALO_OT); const float* HEAD = (const float*)(P.ws + WS_HALO + HALO_OH);
    const float* cw = P.in[I_OCONV_W] + (size_t)j * 3 * 1024; const float* cb = P.in[I_OCONV_B] + (size_t)j * 1024; bf16_t* MIX = (bf16_t*)(P.ws + WS_R + R_MIX);
    for (int idx = gtid; idx < 128 * 16 * 128; idx += gthreads) {
        const int ch = idx & 63, r = (idx >> 6) & 1, t = idx >> 7, pn = t & 15, pm = t >> 4;
        if ((pm & 15) == 0) continue;
        const float* Tl = TAIL + ((size_t)(pm - 1) * 16 + pn) * 128; const float* H = HEAD + ((size_t)pm * 16 + pn) * 256;
        const int c = 64 * pn + ch; const float w0 = cw[c], w1 = cw[1024 + c], w2 = cw[2048 + c], b = cb[c];
        const float pm2 = Tl[ch], pm1 = Tl[64 + ch], p0 = H[ch], p1 = H[64 + ch];
        const float cv = r == 0 ? (w0 * pm2 + w1 * pm1 + w2 * p0 + b) : (w0 * pm1 + w1 * p0 + w2 * p1 + b);
        MIX[((size_t)pm * 256 + r) * DM + c] = (bf16_t)f2bf(H[(2 + r) * 64 + ch] * cv);
    }
}

#define MFMA16(a, b, c) __builtin_amdgcn_mfma_f32_16x16x32_bf16((a), (b), (c), 0, 0, 0)
constexpr int EH_STRIDE = 132;
__device__ __forceinline__ void s5_unit(const Params& P, LAS unsigned char* lds, int j, int b, int g, int wave, int lane) {
    const unsigned char* op = P.ws + WS_S5OP + (size_t)(j * 32 + g) * S5OP_STRIDE;
    const bf16_t* Km = (const bf16_t*)op; const bf16_t* Pm = (const bf16_t*)(op + S5OP_PM); const bf16_t* Qm = (const bf16_t*)(op + S5OP_QM); const f32x2* A16 = (const f32x2*)(op + S5OP_A16);
    const bf16_t* U = (const bf16_t*)(P.ws + WS_R + R_U); bf16_t* YG = (bf16_t*)(P.ws + WS_R + R_YG);
    const float* Dv = P.in[I_S5D] + (size_t)j * 512 + 16 * g;
    LAS float* EH = (LAS float*)lds;
    const int l15 = lane & 15, kb = lane >> 4;
#pragma unroll 1
    for (int q = 0; q < 2; ++q) {
        const int chunk = 16 * (2 * wave + q) + l15;
        bf16x8 ub[8];
#pragma unroll
        for (int ks = 0; ks < 8; ++ks) ub[ks] = *(const bf16x8*)(U + ((size_t)(b * SEQ + chunk * 16 + 2 * ks + (kb >> 1))) * 512 + 16 * g + 8 * (kb & 1));
#pragma unroll 2
        for (int mt = 0; mt < 8; ++mt) {
            f32x4 acc = (f32x4){0.f, 0.f, 0.f, 0.f};
#pragma unroll
            for (int ks = 0; ks < 8; ++ks) { const bf16x8 a = *(const bf16x8*)(Pm + (16 * mt + l15) * 256 + 32 * ks + 8 * kb); acc = MFMA16(a, ub[ks], acc); }
            *(LAS f32x4*)(EH + chunk * EH_STRIDE + 16 * mt + 4 * kb) = acc;
        }
    }
    __syncthreads();
    if (wave == 0) {
        const f32x2 a16 = A16[lane]; f32x2 h = (f32x2){0.f, 0.f};
#pragma unroll 4
        for (int c = 0; c < 256; ++c) {
            LAS f32x2* e = (LAS f32x2*)(EH + c * EH_STRIDE) + lane;
            const f32x2 ev = *e; *e = h;
            h = (f32x2){a16.x * h.x - a16.y * h.y + ev.x, a16.x * h.y + a16.y * h.x + ev.y};
        }
    }
    __syncthreads();
#pragma unroll 1
    for (int q = 0; q < 2; ++q) {
        const int chunk = 16 * (2 * wave + q) + l15;
        bf16x8 ub[8], hb[4];
#pragma unroll
        for (int ks = 0; ks < 8; ++ks) ub[ks] = *(const bf16x8*)(U + ((size_t)(b * SEQ + chunk * 16 + 2 * ks + (kb >> 1))) * 512 + 16 * g + 8 * (kb & 1));
#pragma unroll
        for (int ks = 0; ks < 4; ++ks) { const f32x4 h0 = *(const LAS f32x4*)(EH + chunk * EH_STRIDE + 32 * ks + 8 * kb), h1 = *(const LAS f32x4*)(EH + chunk * EH_STRIDE + 32 * ks + 8 * kb + 4); hb[ks] = as_bf16x8(pack8(h0, h1)); }
        const f32x4 dv = *(const f32x4*)(Dv + 4 * kb);
#pragma unroll 1
        for (int mt = 0; mt < 16; ++mt) {
            f32x4 acc = (f32x4){0.f, 0.f, 0.f, 0.f};
#pragma unroll
            for (int ks = 0; ks < 4; ++ks) { const bf16x8 a = *(const bf16x8*)(Qm + (16 * mt + l15) * 128 + 32 * ks + 8 * kb); acc = MFMA16(a, hb[ks], acc); }
#pragma unroll
            for (int ks = 0; ks < 8; ++ks) {
                if (2 * ks <= mt) { const int dd = mt - 2 * ks - (kb >> 1) + 1; const bf16x8 a = *(const bf16x8*)(Km + (dd * 16 + l15) * 16 + 8 * (kb & 1)); acc = MFMA16(a, ub[ks], acc); }
            }
            const size_t off = ((size_t)(b * SEQ + chunk * 16 + mt)) * 512 + 16 * g + 4 * kb;
            const u32x2 uw = *(const u32x2*)(U + off);
            f32x4 y; y.x = acc.x + dv.x * bflo(uw.x); y.y = acc.y + dv.y * bfhi(uw.x); y.z = acc.z + dv.z * bflo(uw.y); y.w = acc.w + dv.w * bfhi(uw.y);
            *(u32x2*)(YG + off) = (u32x2){cvt_pk_bf16(gelu_tanh_f(y.x), gelu_tanh_f(y.y)), cvt_pk_bf16(gelu_tanh_f(y.z), gelu_tanh_f(y.w))};
        }
    }
    __syncthreads();
}

constexpr int SROW = 8208;
constexpr int SEL_OFF = 16 * SROW;
__device__ __forceinline__ unsigned tr_pair_lo_hi(unsigned a0, unsigned a1, s16x4& lo, s16x4& hi) {
    asm volatile("ds_read_b64_tr_b16 %0, %2\n\tds_read_b64_tr_b16 %1, %3\n\ts_waitcnt lgkmcnt(0)" : "=&v"(lo), "=&v"(hi) : "v"(a0), "v"(a1) : "memory");
    return 0;
}
__device__ __forceinline__ bf16x8 join8(s16x4 lo, s16x4 hi) { bf16x8 r; r[0] = lo[0]; r[1] = lo[1]; r[2] = lo[2]; r[3] = lo[3]; r[4] = hi[0]; r[5] = hi[1]; r[6] = hi[2]; r[7] = hi[3]; return r; }

template <int NR>
__device__ __forceinline__ void dsa_select(LAS unsigned char* lds, int q, int L, int lane) {
    const LAS unsigned short* srow = (const LAS unsigned short*)(lds + q * SROW);
    LAS unsigned short* sel = (LAS unsigned short*)(lds + SEL_OFF + q * 512);
    const int nreg = L >> 6;
    unsigned kk[NR];
#pragma unroll
    for (int i = 0; i < NR; ++i) kk[i] = (i < nreg) ? (unsigned)srow[64 * i + lane] : 0u;
    unsigned T = 0;
#pragma unroll 1
    for (int bit = 15; bit >= 0; --bit) {
        const unsigned trial = T | (1u << bit); int cnt = 0;
#pragma unroll
        for (int i = 0; i < NR; ++i) cnt += (kk[i] >= trial) ? 1 : 0;
        cnt = wave_sum_i(cnt);
        if (cnt >= 256) T = trial;
    }
    int cgt = 0;
#pragma unroll
    for (int i = 0; i < NR; ++i) cgt += (kk[i] > T) ? 1 : 0;
    cgt = wave_sum_i(cgt);
    const int need_eq = 256 - cgt;
    int out_base = 0, eq_base = 0;
#pragma unroll
    for (int i = 0; i < NR; ++i) {
        const bool gt = kk[i] > T, eq = kk[i] == T;
        const unsigned long long eqm = __ballot(eq);
        const int eq_rank = eq_base + __builtin_amdgcn_mbcnt_hi((unsigned)(eqm >> 32), __builtin_amdgcn_mbcnt_lo((unsigned)eqm, 0));
        const bool take = gt || (eq && eq_rank < need_eq);
        const unsigned long long tm = __ballot(take);
        const int pos = out_base + __builtin_amdgcn_mbcnt_hi((unsigned)(tm >> 32), __builtin_amdgcn_mbcnt_lo((unsigned)tm, 0));
        if (take && pos < 256) sel[pos] = (unsigned short)(64 * i + lane);
        out_base += __popcll(tm); eq_base += __popcll(eqm);
    }
}

__device__ __forceinline__ void dsa_unit(const Params& P, LAS unsigned char* lds, int b, int t0, int L, int wave, int lane) {
    const bf16_t* Q = (const bf16_t*)(P.ws + WS_R + R_Q); const bf16_t* KV = (const bf16_t*)(P.ws + WS_R + R_KV); const bf16_t* IK = (const bf16_t*)(P.ws + WS_R + R_IK);
    const bf16_t* IQ = (const bf16_t*)(P.ws + WS_R + R_IQ); const float* IW = (const float*)(P.ws + WS_R + R_IW); bf16_t* A2 = (bf16_t*)(P.ws + WS_R + R_A2);
    const int l15 = lane & 15, kb = lane >> 4;
    const size_t row0 = (size_t)b * SEQ + t0;
    if (L > 256) {
        bf16x8 iqf[4][2];
#pragma unroll
        for (int h = 0; h < 4; ++h)
#pragma unroll
            for (int ks = 0; ks < 2; ++ks) iqf[h][ks] = *(const bf16x8*)(IQ + (row0 + l15) * 256 + h * 64 + 32 * ks + 8 * kb);
        const f32x4 iw = *(const f32x4*)(IW + (row0 + l15) * 4);
        const int ntile = L >> 4;
#pragma unroll 1
        for (int t = wave; t < ntile; t += 8) {
            const bf16_t* kp = IK + ((size_t)b * SEQ + 16 * t + l15) * 64 + 8 * kb;
            const bf16x8 a0 = *(const bf16x8*)kp, a1 = *(const bf16x8*)(kp + 32);
            f32x4 s = (f32x4){0.f, 0.f, 0.f, 0.f};
#pragma unroll
            for (int h = 0; h < 4; ++h) {
                f32x4 acc = (f32x4){0.f, 0.f, 0.f, 0.f};
                acc = MFMA16(a0, iqf[h][0], acc); acc = MFMA16(a1, iqf[h][1], acc);
                const float w = iw[h];
                s.x += w * fmaxf(acc.x, 0.f); s.y += w * fmaxf(acc.y, 0.f); s.z += w * fmaxf(acc.z, 0.f); s.w += w * fmaxf(acc.w, 0.f);
            }
            unsigned short kq[4];
#pragma unroll
            for (int e = 0; e < 4; ++e) { const _Float16 hf = (_Float16)(s[e] + 0.0f); const unsigned short bits = __builtin_bit_cast(unsigned short, hf); kq[e] = (bits & 0x8000u) ? (unsigned short)~bits : (unsigned short)(bits | 0x8000u); }
            *(LAS u32x2*)(lds + l15 * SROW + 2 * (16 * t + 4 * kb)) = (u32x2){(unsigned)kq[0] | ((unsigned)kq[1] << 16), (unsigned)kq[2] | ((unsigned)kq[3] << 16)};
        }
    }
    __syncthreads();
    const int nsel = L < 256 ? L : 256;
#pragma unroll 1
    for (int qq = 0; qq < 2; ++qq) {
        const int q = 2 * wave + qq;
        LAS unsigned short* sel = (LAS unsigned short*)(lds + SEL_OFF + q * 512);
        if (L <= 256) {
#pragma unroll
            for (int i = 0; i < 4; ++i) { const int jx = 64 * i + lane; sel[jx] = (unsigned short)(jx < L ? jx : 0); }
        } else if (L <= 1024) dsa_select<16>(lds, q, L, lane);
        else if (L <= 2048) dsa_select<32>(lds, q, L, lane);
        else if (L <= 3072) dsa_select<48>(lds, q, L, lane);
        else dsa_select<64>(lds, q, L, lane);
    }
    LDS_WAIT();
    LAS unsigned char* VB = lds + (2 * wave) * SROW;
    const unsigned vb_addr = (unsigned)(uintptr_t)VB;
    const int qd = l15 >> 2, pp = lane & 3;
#pragma unroll 1
    for (int qq = 0; qq < 2; ++qq) {
        const int q = 2 * wave + qq; const size_t row = row0 + q;
        const LAS unsigned short* sel = (const LAS unsigned short*)(lds + SEL_OFF + q * 512);
        bf16x8 qf[2];
#pragma unroll
        for (int ks = 0; ks < 2; ++ks) { u32x4 z = (u32x4){0u, 0u, 0u, 0u}; if (l15 < 8) z = *(const u32x4*)(Q + row * 512 + l15 * 64 + 32 * ks + 8 * kb); qf[ks] = as_bf16x8(z); }
        f32x4 o[4];
#pragma unroll
        for (int mt = 0; mt < 4; ++mt) o[mt] = (f32x4){0.f, 0.f, 0.f, 0.f};
        float mrun = -INFINITY, lsum = 0.f;
        const int nblk = nsel >> 6;
#pragma unroll 1
        for (int blk = 0; blk < nblk; ++blk) {
            f32x4 s[4];
#pragma unroll
            for (int t = 0; t < 4; ++t) {
                const int kidx = sel[64 * blk + 16 * t + l15];
                const bf16_t* kp = KV + ((size_t)b * SEQ + kidx) * 128 + 8 * kb;
                const bf16x8 a0 = *(const bf16x8*)kp, a1 = *(const bf16x8*)(kp + 32);
                f32x4 acc = (f32x4){0.f, 0.f, 0.f, 0.f};
                acc = MFMA16(a0, qf[0], acc); acc = MFMA16(a1, qf[1], acc);
                s[t] = acc;
            }
#pragma unroll
            for (int i = 0; i < 8; ++i) {
                const int rk = 8 * i + (lane >> 3); const int kidx = sel[64 * blk + rk];
                const u32x4 v = *(const u32x4*)(KV + ((size_t)b * SEQ + kidx) * 128 + 64 + 8 * (lane & 7));
                *(LAS u32x4*)(VB + 128 * rk + 16 * ((lane & 7) ^ (2 * ((rk >> 1) & 3)))) = v;
            }
            float bm = -INFINITY;
#pragma unroll
            for (int t = 0; t < 4; ++t) bm = fmaxf(bm, fmaxf(fmaxf(s[t].x, s[t].y), fmaxf(s[t].z, s[t].w)));
            bm = fmaxf(bm, __shfl_xor(bm, 16)); bm = fmaxf(bm, __shfl_xor(bm, 32));
            const float mnew = fmaxf(mrun, bm), alpha = __expf(mrun - mnew);
            mrun = mnew; lsum *= alpha;
#pragma unroll
            for (int t = 0; t < 4; ++t) { s[t].x = __expf(s[t].x - mnew); s[t].y = __expf(s[t].y - mnew); s[t].z = __expf(s[t].z - mnew); s[t].w = __expf(s[t].w - mnew); lsum += (s[t].x + s[t].y) + (s[t].z + s[t].w); }
#pragma unroll
            for (int mt = 0; mt < 4; ++mt) o[mt] *= alpha;
            LDS_WAIT();
#pragma unroll
            for (int s2 = 0; s2 < 2; ++s2) {
                const bf16x8 pf = as_bf16x8(pack8(s[2 * s2], s[2 * s2 + 1]));
                const int r0 = 32 * s2 + 4 * kb + qd, r1 = r0 + 16;
#pragma unroll
                for (int mt = 0; mt < 4; ++mt) {
                    const unsigned a0 = vb_addr + 128 * r0 + 16 * ((2 * mt + (pp >> 1)) ^ (2 * ((r0 >> 1) & 3))) + 8 * (pp & 1);
                    const unsigned a1 = vb_addr + 128 * r1 + 16 * ((2 * mt + (pp >> 1)) ^ (2 * ((r1 >> 1) & 3))) + 8 * (pp & 1);
                    s16x4 lo, hi; tr_pair_lo_hi(a0, a1, lo, hi);
                    o[mt] = MFMA16(join8(lo, hi), pf, o[mt]);
                }
            }
        }
        lsum += __shfl_xor(lsum, 16); lsum += __shfl_xor(lsum, 32);
        const float inv = 1.f / lsum;
        if (l15 < 8) {
#pragma unroll
            for (int mt = 0; mt < 4; ++mt) *(u32x2*)(A2 + row * 1024 + l15 * 64 + 16 * mt + 4 * kb) = (u32x2){cvt_pk_bf16(o[mt].x * inv, o[mt].y * inv), cvt_pk_bf16(o[mt].z * inv, o[mt].w * inv)};
        }
    }
    __syncthreads();
}

__device__ __forceinline__ unsigned off_b(unsigned row, unsigned ch) { return 256u * row + 16u * (ch ^ (((row & 3) << 2) | ((row >> 2) & 3))); }
__device__ __forceinline__ void xattn_wg(const Params& P, LAS unsigned char* lds, int layer, int wg, int wave, int lane) {
    const bf16_t* MKV = (const bf16_t*)(P.ws + WS_MEMKV) + (size_t)layer * MEMTOK * 1024; const bf16_t* QX = (const bf16_t*)(P.ws + WS_R + R_QX); bf16_t* OX = (bf16_t*)(P.ws + WS_R + R_OX);
    const int tid = wave * 64 + lane, l15 = lane & 15, kb = lane >> 4, qd = l15 >> 2, pp = lane & 3;
    LAS unsigned char* KI = lds; LAS unsigned char* VI = lds + 65536;
    const unsigned vi_addr = (unsigned)(uintptr_t)VI;
    const int bh = (2 * wg) >> 4, b = bh >> 2, head = bh & 3;
#pragma unroll
    for (int i = 0; i < 8; ++i) {
        const int id = tid + 512 * i, rw = id >> 4, ch = id & 15;
        const bf16_t* src = MKV + ((size_t)b * NMEM + rw) * 1024 + head * 128 + 8 * ch;
        *(LAS u32x4*)(KI + off_b(rw, ch)) = *(const u32x4*)src;
        *(LAS u32x4*)(VI + off_b(rw, ch)) = *(const u32x4*)(src + 512);
    }
    __syncthreads();
#pragma unroll 1
    for (int uu = 0; uu < 2; ++uu) {
        const int pi = (2 * wg + uu) & 15; const size_t prow = (size_t)b * SEQ + pi * 256;
#pragma unroll 1
        for (int gq = 0; gq < 2; ++gq) {
            const size_t r = prow + 16 * (2 * wave + gq) + l15;
            bf16x8 qf[4];
#pragma unroll
            for (int ks = 0; ks < 4; ++ks) qf[ks] = *(const bf16x8*)(QX + r * 512 + head * 128 + 32 * ks + 8 * kb);
            f32x4 o[8];
#pragma unroll
            for (int mt = 0; mt < 8; ++mt) o[mt] = (f32x4){0.f, 0.f, 0.f, 0.f};
            float mrun = -INFINITY, lsum = 0.f;
#pragma unroll 1
            for (int blk = 0; blk < 4; ++blk) {
                f32x4 s[4];
#pragma unroll
                for (int t = 0; t < 4; ++t) {
                    f32x4 acc = (f32x4){0.f, 0.f, 0.f, 0.f};
#pragma unroll
                    for (int ks = 0; ks < 4; ++ks) { const bf16x8 a = *(const LAS bf16x8*)(KI + off_b(64 * blk + 16 * t + l15, 4 * ks + kb)); acc = MFMA16(a, qf[ks], acc); }
                    s[t] = acc;
                }
                float bm = -INFINITY;
#pragma unroll
                for (int t = 0; t < 4; ++t) bm = fmaxf(bm, fmaxf(fmaxf(s[t].x, s[t].y), fmaxf(s[t].z, s[t].w)));
                bm = fmaxf(bm, __shfl_xor(bm, 16)); bm = fmaxf(bm, __shfl_xor(bm, 32));
                const float mnew = fmaxf(mrun, bm), alpha = __expf(mrun - mnew);
                mrun = mnew; lsum *= alpha;
#pragma unroll
                for (int t = 0; t < 4; ++t) { s[t].x = __expf(s[t].x - mnew); s[t].y = __expf(s[t].y - mnew); s[t].z = __expf(s[t].z - mnew); s[t].w = __expf(s[t].w - mnew); lsum += (s[t].x + s[t].y) + (s[t].z + s[t].w); }
#pragma unroll
                for (int mt = 0; mt < 8; ++mt) o[mt] *= alpha;
#pragma unroll
                for (int s2 = 0; s2 < 2; ++s2) {
                    const bf16x8 pf = as_bf16x8(pack8(s[2 * s2], s[2 * s2 + 1]));
                    const unsigned r0 = 64 * blk + 32 * s2 + 4 * kb + qd, r1 = r0 + 16;
#pragma unroll
                    for (int mt = 0; mt < 8; ++mt) {
                        const unsigned a0 = vi_addr + off_b(r0, 2 * mt + (pp >> 1)) + 8 * (pp & 1), a1 = vi_addr + off_b(r1, 2 * mt + (pp >> 1)) + 8 * (pp & 1);
                        s16x4 lo, hi; tr_pair_lo_hi(a0, a1, lo, hi);
                        o[mt] = MFMA16(join8(lo, hi), pf, o[mt]);
                    }
                }
            }
            lsum += __shfl_xor(lsum, 16); lsum += __shfl_xor(lsum, 32);
            const float inv = 1.f / lsum;
#pragma unroll
            for (int mt = 0; mt < 8; ++mt) *(u32x2*)(OX + r * 512 + head * 128 + 16 * mt + 4 * kb) = (u32x2){cvt_pk_bf16(o[mt].x * inv, o[mt].y * inv), cvt_pk_bf16(o[mt].z * inv, o[mt].w * inv)};
        }
    }
    __syncthreads();
}

#ifndef MK_MASK
#define MK_MASK 0xFFFFF
#endif
#define MKON(n) (((MK_MASK) >> (n)) & 1)
constexpr int LAST_PHASE = 2 + 16 * 3 + 9;
__global__ void __launch_bounds__(NTHREADS, 2) mk_fwd(Params P) {
    extern __shared__ __attribute__((aligned(16))) unsigned char lds_raw[];
    LAS unsigned char* lds = (LAS unsigned char*)lds_raw;
    const int tid = threadIdx.x, lane = tid & 63, wave = __builtin_amdgcn_readfirstlane(tid >> 6);
    const int G = gridDim.x, bx = blockIdx.x;
    const int NGW = G * NWAVES; (void)lane; (void)wave;
    volatile LAS unsigned* MISC = (volatile LAS unsigned*)(lds + LDSCTL_OFF);
    if (tid < 64) MISC[tid] = 0u;
    __syncthreads();
    unsigned* ctl = (unsigned*)(P.ws + WS_CTL);
    XcdBarrier bar = xcd_barrier_post(ctl + CW_BAR, MISC + 8);
    const int lo = P.ph_lo, hi = P.ph_hi;
#define IN(k) (lo <= (k) && (k) < hi)
#define FRESH const int ftid = fresh_tid(), flane = ftid & 63, fwave = __builtin_amdgcn_readfirstlane(ftid >> 6), fgw = bx * NWAVES + fwave; (void)fgw; (void)flane
#define SEAM(k) do { if ((k) < LAST_PHASE && (k) + 1 < hi) xcd_barrier(bar); } while (0)
    unsigned char* ws = P.ws;
    bf16_t* wb = (bf16_t*)(ws + WS_W);
    bf16_t* XB = (bf16_t*)(ws + WS_XB); float* SSQ = (float*)(ws + WS_SSQ);
    LAS float* EPIL = (LAS float*)(lds + EPI_OFF);

    if (MKON(0) && IN(0)) { FRESH; prologue(P, lds, fgw, NGW, fwave, flane); SEAM(0); }
    if (MKON(1) && IN(1)) {
        pg8::Gemm g{(const bf16_t*)(ws + WS_MEMB), (const bf16_t*)((char*)wb + W_XKV), DM, DM, DM}; pg8::StaticOrder S; S.init(MEMTOK, 4096, G, bx);
        EpiHead128 E{nullptr, (const float*)(ws + WS_MEMRS), P.in[I_XKN], (bf16_t*)(ws + WS_MEMKV), 1, 1.f, EPIL};
        pg8::gemm_phase(lds, g, S, E); SEAM(1);
    }
#pragma unroll 1
    for (int layer = 0; layer < 4; ++layer) {
        const int pb = 2 + 16 * layer, j = layer >> 1;
        if ((layer & 1) == 0) {
            if (MKON(2) && IN(pb + 0)) {
                pg8::Gemm g{XB, (const bf16_t*)((char*)wb + W_EIN + j * 3 * MiB), DM, DM, DM}; pg8::StaticOrder S; S.init(NTOK, 1536, G, bx);
                EpiEvenIn E{SSQ, P.in[I_AQN] + j * 64, P.in[I_AKN] + j * 64, (bf16_t*)(ws + WS_R + R_Q), (bf16_t*)(ws + WS_R + R_KV), (bf16_t*)(ws + WS_R + R_IK), (bf16_t*)(ws + WS_R + R_IQ), (bf16_t*)(ws + WS_R + R_U), (float*)(ws + WS_R + R_IW)};
                pg8::gemm_phase(lds, g, S, E); SEAM(pb + 0);
            }
            if (MKON(3) && IN(pb + 1)) {
                FRESH;
                for (int task = bx; task < 256; task += G) s5_unit(P, lds, j, task >> 5, task & 31, fwave, flane);
                for (int w2 = bx; w2 < 256; w2 += G) {
                    const int b = w2 >> 5, r = w2 & 31;
#pragma unroll 1
                    for (int k = 0; k < 8; ++k) { const int cc = (k < 4) ? r : 63 - r; dsa_unit(P, lds, b, 64 * cc + 16 * (k & 3), 64 * (cc + 1), fwave, flane); }
                }
                SEAM(pb + 1);
            }
            if (MKON(4) && IN(pb + 2)) {
                pg8::Gemm g{(const bf16_t*)(ws + WS_R + R_YG), (const bf16_t*)((char*)wb + W_GLU + j * (MiB / 2)), 512, 512, 512}; pg8::StaticOrder S; S.init(NTOK, 512, G, bx);
                EpiGlu E{(const bf16_t*)(ws + WS_R + R_YG), P.in[I_BGLU] + j * 512, (bf16_t*)(ws + WS_R + R_A2)};
                pg8::gemm_phase(lds, g, S, E); SEAM(pb + 2);
            }
            if (MKON(5) && IN(pb + 3)) {
                pg8::Gemm g{(const bf16_t*)(ws + WS_R + R_A2), (const bf16_t*)((char*)wb + W_EOUT + j * 2 * MiB), DM, DM, DM}; pg8::StaticOrder S; S.init(NTOK, DM, G, bx);
                EpiResidual E{P.out, XB, SSQ, EPIL};
                pg8::gemm_phase(lds, g, S, E); SEAM(pb + 3);
            }
        } else {
            if (MKON(6) && IN(pb + 0)) {
                pg8::Gemm g{XB, (const bf16_t*)((char*)wb + W_OIN + j * 8 * MiB), DM, DM, DM}; pg8::StaticOrder S; S.init(NTOK, 4096, G, bx);
                EpiOddIn E{SSQ, P.in[I_OCONV_W] + (size_t)j * 3 * 1024, P.in[I_OCONV_B] + (size_t)j * 1024, (bf16_t*)(ws + WS_R + R_MIX), (float*)(ws + WS_HALO + HALO_OT), (float*)(ws + WS_HALO + HALO_OH), EPIL};
                pg8::gemm_phase(lds, g, S, E); SEAM(pb + 0);
            }
            if (MKON(7) && IN(pb + 1)) { FRESH; fixup_odd(P, j, bx * NTHREADS + ftid, G * NTHREADS); SEAM(pb + 1); }
            if (MKON(8) && IN(pb + 2)) {
                pg8::Gemm g{(const bf16_t*)(ws + WS_R + R_MIX), (const bf16_t*)((char*)wb + W_OOUT + j * 2 * MiB), DM, DM, DM}; pg8::StaticOrder S; S.init(NTOK, DM, G, bx);
                EpiResidual E{P.out, XB, SSQ, EPIL};
                pg8::gemm_phase(lds, g, S, E); SEAM(pb + 2);
            }
        }
        if (MKON(9) && IN(pb + 4)) {
            pg8::Gemm g{XB, (const bf16_t*)((char*)wb + W_XQ + layer * MiB), DM, DM, DM}; pg8::StaticOrder S; S.init(NTOK, 512, G, bx);
            EpiHead128 E{SSQ, nullptr, P.in[I_XQN] + layer * 128, (bf16_t*)(ws + WS_R + R_QX), 0, 0.08838834764831845f, EPIL};
            pg8::gemm_phase(lds, g, S, E); SEAM(pb + 4);
        }
        if (MKON(10) && IN(pb + 5)) { FRESH; for (int w2 = bx; w2 < 256; w2 += G) xattn_wg(P, lds, layer, w2, fwave, flane); SEAM(pb + 5); }
        if (MKON(11) && IN(pb + 6)) {
            pg8::Gemm g{(const bf16_t*)(ws + WS_R + R_OX), (const bf16_t*)((char*)wb + W_XO + layer * MiB), 512, 512, 512}; pg8::StaticOrder S; S.init(NTOK, DM, G, bx);
            EpiResidual E{P.out, XB, SSQ, EPIL};
            pg8::gemm_phase(lds, g, S, E); SEAM(pb + 6);
        }
        if (MKON(12) && IN(pb + 7)) {
            pg8::Gemm g{XB, (const bf16_t*)((char*)wb + W_UP + layer * 11 * MiB), DM, DM, DM}; pg8::StaticOrder S; S.init(NTOK, 2 * DFF, G, bx);
            EpiFfnUp E{SSQ, P.in[I_FCONV_W] + (size_t)layer * 3 * DFF, P.in[I_FCONV_B] + (size_t)layer * DFF, (bf16_t*)(ws + WS_R + R_ACT), (float*)(ws + WS_HALO + HALO_FT), (float*)(ws + WS_HALO + HALO_FH), EPIL};
            pg8::gemm_phase(lds, g, S, E); SEAM(pb + 7);
        }
        if (MKON(13) && IN(pb + 8)) { FRESH; fixup_ffn(P, layer, bx * NTHREADS + ftid, G * NTHREADS); SEAM(pb + 8); }
        if (MKON(14) && IN(pb + 9)) {
            pg8::Gemm g{(const bf16_t*)(ws + WS_R + R_ACT), (const bf16_t*)((char*)wb + W_DN + layer * (11 * MiB / 2)), DFF, DFF, DFF}; pg8::StaticOrder S; S.init(NTOK, DM, G, bx);
            EpiResidual E{P.out, XB, SSQ, EPIL};
            pg8::gemm_phase(lds, g, S, E); SEAM(pb + 9);
        }
    }
#undef IN
#undef SEAM
}

extern "C" void kernel_launch(void* const* d_in, const int* in_sizes, int n_in, void* d_out, int out_size, void* d_ws, size_t ws_size, hipStream_t stream) {
    static int grid = 0;
    if (grid == 0) {
        if (n_in != 33 || out_size != NTOK * DM || ws_size < WS_END) { fprintf(stderr, "kernel_launch: unexpected problem (n_in %d out %d ws %zu)\n", n_in, out_size, ws_size); grid = -1; return; }
        int dev = 0, cus = 0, per_cu = 0;
        if (hipGetDevice(&dev) != hipSuccess || hipDeviceGetAttribute(&cus, hipDeviceAttributeMultiprocessorCount, dev) != hipSuccess) { grid = -1; return; }
        if (hipFuncSetAttribute((const void*)mk_fwd, hipFuncAttributeMaxDynamicSharedMemorySize, LDS_BYTES) != hipSuccess) { fprintf(stderr, "kernel_launch: hipFuncSetAttribute failed\n"); grid = -1; return; }
        if (hipOccupancyMaxActiveBlocksPerMultiprocessor(&per_cu, (const void*)mk_fwd, NTHREADS, LDS_BYTES) != hipSuccess || per_cu < 1) { fprintf(stderr, "kernel_launch: occupancy query reports %d\n", per_cu); }
        (void)hipGetLastError();
        grid = cus < 256 ? cus : 256;
    }
    if (grid < 0) return;
    (void)hipMemsetAsync((char*)d_ws + WS_CTL, 0, CTL_ZERO_BYTES, stream);
    Params p{};
    for (int i = 0; i < 33; ++i) p.in[i] = (const float*)d_in[i];
    p.out = (float*)d_out; p.ws = (unsigned char*)d_ws;
#ifdef MK_PER_PHASE
    for (int ph = 0; ph <= LAST_PHASE; ++ph) { p.ph_lo = ph; p.ph_hi = ph + 1; hipLaunchKernelGGL(mk_fwd, dim3(grid), dim3(NTHREADS), LDS_BYTES, stream, p); }
#else
    p.ph_lo = 0; p.ph_hi = 1 << 20;
    hipLaunchKernelGGL(mk_fwd, dim3(grid), dim3(NTHREADS), LDS_BYTES, stream, p);
#endif
}
```

```cpp
#include <hip/hip_runtime.h>
#include <cstdio>
#include <cstdint>

#define LAS __attribute__((address_space(3)))
#ifndef MK_ALIGN6
#define MK_ALIGN6 true
#endif
#ifndef MK_DSA_REP
#define MK_DSA_REP 0
#endif
#ifndef MK_SSQ_AUX
#define MK_SSQ_AUX 0
#endif
#ifndef MK_SSQ_ST_AUX
#define MK_SSQ_ST_AUX 0
#endif
typedef unsigned short bf16_t;
typedef short bf16x8 __attribute__((ext_vector_type(8)));
typedef short s16x4 __attribute__((ext_vector_type(4)));
typedef float f32x4 __attribute__((ext_vector_type(4)));
typedef float f32x2 __attribute__((ext_vector_type(2)));
typedef unsigned u32x4 __attribute__((ext_vector_type(4)));
typedef unsigned u32x2 __attribute__((ext_vector_type(2)));

constexpr int DM = 1024, NBATCH = 8, SEQ = 4096, NTOK = NBATCH * SEQ, NMEM = 256, MEMTOK = NBATCH * NMEM, DFF = 2816;
constexpr float EPS = 1e-6f;
constexpr int NWAVES = 8, NTHREADS = 512;

constexpr size_t MiB = 1u << 20;
constexpr size_t WS_CTL = 0, CTL_ZERO_BYTES = 65536;
constexpr size_t WS_W = 1 * MiB;
constexpr size_t W_EIN = 0, W_EOUT = 6 * MiB, W_GLU = 10 * MiB, W_OIN = 11 * MiB, W_OOUT = 27 * MiB, W_XQ = 31 * MiB, W_XKV = 35 * MiB, W_XO = 43 * MiB, W_UP = 47 * MiB, W_DN = 91 * MiB;
constexpr size_t WS_XB = 115 * MiB, WS_SSQ = 179 * MiB, WS_MEMB = 180 * MiB, WS_MEMRS = 184 * MiB, WS_MEMKV = 185 * MiB, WS_S5OP = 201 * MiB, WS_HALO = 211 * MiB, WS_R = 224 * MiB, WS_SSQ16 = 416 * MiB, WS_QSS = 418 * MiB, WS_MEMSS = 419 * MiB, WS_HALO2 = 420 * MiB, WS_END = 468 * MiB;
constexpr size_t S5OP_STRIDE = 160 * 1024, S5OP_PM = 16 * 1024, S5OP_QM = 80 * 1024, S5OP_A16 = 144 * 1024;
constexpr size_t HALO_FT = 0, HALO_FH = 12 * MiB, HALO_OT = 36 * MiB, HALO_OH = 40 * MiB;
constexpr size_t R_ACT = 0, R_Q = 0, R_KV = 32 * MiB, R_IK = 40 * MiB, R_IQ = 44 * MiB, R_IW = 60 * MiB, R_U = 61 * MiB, R_A2 = 93 * MiB, R_YG = 157 * MiB, R_MIX = 0, R_QX = 0, R_OX = 32 * MiB;
constexpr int CW_BAR = 4096;

constexpr int RING_BYTES = 131072, EPI_OFF = 131072, LDS_BYTES = 163840, LDSCTL_OFF = 143360;

__device__ __forceinline__ unsigned f2bf(float f) { unsigned u = __builtin_bit_cast(unsigned, f); return (u + 0x7fffu + ((u >> 16) & 1u)) >> 16; }
__device__ __forceinline__ unsigned pk2(float lo, float hi) { return f2bf(lo) | (f2bf(hi) << 16); }
__device__ __forceinline__ unsigned cvt_pk_bf16(float lo, float hi) { unsigned r; asm volatile("v_cvt_pk_bf16_f32 %0, %1, %2" : "=v"(r) : "v"(lo), "v"(hi)); return r; }
__device__ __forceinline__ float bf2f(unsigned short b) { return __builtin_bit_cast(float, (unsigned)b << 16); }
__device__ __forceinline__ float bflo(unsigned w) { return __builtin_bit_cast(float, w << 16); }
__device__ __forceinline__ float bfhi(unsigned w) { return __builtin_bit_cast(float, w & 0xffff0000u); }
__device__ __forceinline__ int fresh_tid() { int t = threadIdx.x; asm volatile("" : "+v"(t)); return t; }
#define LDS_WAIT() asm volatile("s_waitcnt lgkmcnt(0)" ::: "memory")
#define VM_WAIT() asm volatile("s_waitcnt vmcnt(0)" ::: "memory")
__device__ __forceinline__ float wave_sum(float v) {
#pragma unroll
    for (int o = 1; o < 64; o <<= 1) v += __shfl_xor(v, o);
    return v;
}
__device__ __forceinline__ float wave_max(float v) {
#pragma unroll
    for (int o = 1; o < 64; o <<= 1) v = fmaxf(v, __shfl_xor(v, o));
    return v;
}
__device__ __forceinline__ int wave_sum_i(int v) {
#pragma unroll
    for (int o = 1; o < 64; o <<= 1) v += __shfl_xor(v, o);
    return v;
}
__device__ __forceinline__ float silu_f(float x) { return x * __builtin_amdgcn_rcpf(1.f + __expf(-x)); }
__device__ __forceinline__ float sigmoid_f(float x) { return __builtin_amdgcn_rcpf(1.f + __expf(-x)); }
__device__ __forceinline__ float gelu_tanh_f(float y) { const float a = 0.7978845608f * (y + 0.044715f * y * y * y); const float t = 1.f - 2.f * __builtin_amdgcn_rcpf(__expf(2.f * a) + 1.f); return 0.5f * y * (1.f + t); }
__device__ __forceinline__ float rs_from_ssq(const float* ssq, int row) { const f32x4 s = *(const f32x4*)(ssq + 4 * (size_t)row); return rsqrtf(((s.x + s.y) + (s.z + s.w)) * (1.f / DM) + EPS); }
__device__ __forceinline__ bf16x8 as_bf16x8(u32x4 v) { return __builtin_bit_cast(bf16x8, v); }

namespace pg8 {
constexpr int BM = 256, BK = 64, HALF = 128, HTB = HALF * BK * 2, STAGE_BYTES = 8 * HTB, NXCD = 8, WGM = 8;
__host__ __device__ __forceinline__ int lds_byte(int r, int c) { const int st = (r >> 4) * 2 + (c >> 5), rr = r & 15, cc = c & 31, ob = rr * 64 + cc * 2; return st * 1024 + (ob ^ (((ob >> 9) & 1) << 5)); }
__host__ __device__ __forceinline__ void stage_rc(int b, int& R, int& C) { const int st = b / 1024, sb = b % 1024, swz = sb ^ (((sb >> 9) & 1) << 5); R = (st >> 1) * 16 + swz / 64; C = (st & 1) * 32 + (swz % 64) / 2; }
struct Unit { int pm, pn; };
struct Gemm { const bf16_t* A; const bf16_t* Bt; int lda, ldb, K; };
struct StaticOrder {
    int nM, nN, nwg, G, c;
    __device__ __forceinline__ void init(int M, int N, int G_, int c_) { nM = M / BM; nN = N / BM; nwg = nM * nN; G = G_; c = c_; }
    __device__ __forceinline__ bool next(int i, Unit& u) const {
        const long L = (long)i * G + c; if (L >= nwg) return false;
        int wgid = (int)L; { const int q = nwg / NXCD, r = nwg % NXCD, xcd = wgid % NXCD, off = wgid / NXCD; wgid = (xcd < r ? xcd * (q + 1) : r * (q + 1) + (xcd - r) * q) + off; }
        const int nig = WGM * nN, gid = wgid / nig, fm = gid * WGM, gsz = (nM - fm) < WGM ? (nM - fm) : WGM;
        u.pm = fm + ((wgid % nig) % gsz); u.pn = (wgid % nig) / gsz; return true;
    }
};
template <bool ALIGN_EPI = false, class Epi>
__device__ __forceinline__ void gemm_phase(LAS unsigned char* lds, const Gemm g, const StaticOrder& S, const Epi& E) {
    const int tid = fresh_tid(), wid = __builtin_amdgcn_readfirstlane(tid >> 6), lane = tid & 63, wr = wid >> 2, wc = wid & 3, fr = lane & 15, fq = lane >> 4;
    const int K = g.K, nt = K / BK;
    unsigned voffA[2], voffB[2];
#pragma unroll
    for (int i = 0; i < 2; ++i) { int R, C; stage_rc(tid * 16 + i * 8192, R, C); voffA[i] = (unsigned)(R * g.lda + C) * 2u; voffB[i] = (unsigned)(R * g.ldb + C) * 2u; }
    const size_t kstep = (size_t)(BK * 2);
    const size_t hstepA = (size_t)HALF * g.lda * 2, hstepB = (size_t)HALF * g.ldb * 2, tstepA = 2 * hstepA, tstepB = 2 * hstepB;
    const unsigned ldsw = (unsigned)wid * 1024u;
    const int aoff = lds_byte(wr * 64 + fr, fq * 8), boff = lds_byte(wc * 32 + fr, fq * 8);
#define PG8_SA(b, h) (((b) * 2 + (h)) * HTB)
#define PG8_SB(b, h) ((4 + (b) * 2 + (h)) * HTB)
#define PG8_STAGE(bufoff, gbase, voff) do { _Pragma("unroll") for (int _i = 0; _i < 2; ++_i) \
        __builtin_amdgcn_global_load_lds((const unsigned*)((const char*)(gbase) + (voff)[_i]), (LAS unsigned*)(lds + (bufoff) + ldsw + _i * 8192), 16, 0, 0); } while (0)
#define PG8_LDA(dst, b, h) do { _Pragma("unroll") for (int m = 0; m < 4; ++m) _Pragma("unroll") for (int k = 0; k < 2; ++k) dst[m][k] = *(const LAS bf16x8*)(lds + PG8_SA(b, h) + aoff + m * 2048 + k * 1024); } while (0)
#define PG8_LDB(dst, b, h) do { _Pragma("unroll") for (int n = 0; n < 2; ++n) _Pragma("unroll") for (int k = 0; k < 2; ++k) dst[n][k] = *(const LAS bf16x8*)(lds + PG8_SB(b, h) + boff + n * 2048 + k * 1024); } while (0)
#define PG8_MMA(ai, bj, At, Bt) do { __builtin_amdgcn_s_setprio(1); _Pragma("unroll") for (int m = 0; m < 4; ++m) _Pragma("unroll") for (int n = 0; n < 2; ++n) _Pragma("unroll") for (int k = 0; k < 2; ++k) \
        acc[ai][bj][m][n] = __builtin_amdgcn_mfma_f32_16x16x32_bf16(Bt[n][k], At[m][k], acc[ai][bj][m][n], 0, 0, 0); __builtin_amdgcn_s_setprio(0); } while (0)
#define PG8_WAIT_V(n) asm volatile("s_waitcnt vmcnt(" #n ")" ::: "memory")
#define PG8_WAIT_L(n) asm volatile("s_waitcnt lgkmcnt(" #n ")" ::: "memory")
#define PG8_BAR __builtin_amdgcn_s_barrier()
#define PG8_SCHED __builtin_amdgcn_sched_barrier(0)
    Unit cur, nxt; int ui = 0;
    if (!S.next(0, cur)) return;
    f32x4 acc[2][2][4][2];
#pragma unroll
    for (int a = 0; a < 2; ++a)
#pragma unroll
        for (int b = 0; b < 2; ++b)
#pragma unroll
            for (int m = 0; m < 4; ++m)
#pragma unroll
                for (int n = 0; n < 2; ++n) acc[a][b][m][n] = (f32x4){0.f, 0.f, 0.f, 0.f};
    bf16x8 At[4][2], B0[2][2], B1[2][2];
    const char* cA = (const char*)g.A + (size_t)cur.pm * tstepA; const char* cB = (const char*)g.Bt + (size_t)cur.pn * tstepB;
    PG8_STAGE(PG8_SB(0, 0), cB, voffB); PG8_STAGE(PG8_SB(0, 1), cB + hstepB, voffB); PG8_STAGE(PG8_SA(0, 0), cA, voffA); PG8_STAGE(PG8_SA(0, 1), cA + hstepA, voffA);
    if (wr == 1) PG8_BAR;
    PG8_WAIT_V(2); PG8_BAR;
    PG8_STAGE(PG8_SB(1, 0), cB + kstep, voffB); PG8_STAGE(PG8_SA(1, 0), cA + kstep, voffA); PG8_STAGE(PG8_SB(1, 1), cB + hstepB + kstep, voffB);
    PG8_WAIT_V(6); PG8_BAR;
    for (;;) {
        const bool has_next = S.next(ui + 1, nxt);
        const char* nA = has_next ? (const char*)g.A + (size_t)nxt.pm * tstepA : cA; const char* nB = has_next ? (const char*)g.Bt + (size_t)nxt.pn * tstepB : cB;
        for (int t = 0; t < nt; t += 2) {
            const bool last = (t == nt - 2);
            const char* a1 = cA + (size_t)(t + 1) * kstep;
            const char* a2 = last ? nA : cA + (size_t)(t + 2) * kstep; const char* b2 = last ? nB : cB + (size_t)(t + 2) * kstep;
            const char* a3 = a2 + kstep; const char* b3 = b2 + kstep;
            PG8_LDB(B0, 0, 0); PG8_LDB(B1, 0, 1); PG8_SCHED; PG8_LDA(At, 0, 0); PG8_STAGE(PG8_SA(1, 1), a1 + hstepA, voffA);
            PG8_WAIT_V(8); PG8_WAIT_L(0); PG8_BAR; PG8_MMA(0, 0, At, B0); PG8_MMA(0, 1, At, B1); PG8_BAR; PG8_SCHED;
            PG8_LDA(At, 0, 1); PG8_STAGE(PG8_SB(0, 0), b2, voffB); PG8_STAGE(PG8_SB(0, 1), b2 + hstepB, voffB); PG8_STAGE(PG8_SA(0, 0), a2, voffA);
            PG8_WAIT_V(8); PG8_WAIT_L(0); PG8_BAR; PG8_MMA(1, 0, At, B0); PG8_MMA(1, 1, At, B1); PG8_BAR; PG8_SCHED;
            PG8_LDB(B0, 1, 0); PG8_LDB(B1, 1, 1); PG8_SCHED; PG8_LDA(At, 1, 0); PG8_STAGE(PG8_SA(0, 1), a2 + hstepA, voffA);
            PG8_WAIT_V(8); PG8_WAIT_L(0); PG8_BAR; PG8_MMA(0, 0, At, B0); PG8_MMA(0, 1, At, B1); PG8_BAR; PG8_SCHED;
            PG8_LDA(At, 1, 1); PG8_STAGE(PG8_SB(1, 0), b3, voffB); PG8_STAGE(PG8_SB(1, 1), b3 + hstepB, voffB); PG8_STAGE(PG8_SA(1, 0), a3, voffA);
            PG8_WAIT_V(8); PG8_WAIT_L(0); PG8_BAR; PG8_MMA(1, 0, At, B0); PG8_MMA(1, 1, At, B1); PG8_BAR; PG8_SCHED;
        }
        if constexpr (ALIGN_EPI) { if (wr == 0) PG8_BAR; }
#ifdef MK_FENCE_EPI
        PG8_SCHED; asm volatile("s_waitcnt vmcnt(0) lgkmcnt(0)\n\ts_nop 15" ::: "memory"); PG8_SCHED;
#endif
        E(acc, cur, wr, wc, fr, fq);
#ifdef MK_FENCE_EPI
        PG8_SCHED; asm volatile("s_waitcnt vmcnt(0) lgkmcnt(0)\n\ts_nop 15" ::: "memory"); PG8_SCHED;
#endif
        if (!has_next) break;
#pragma unroll
        for (int a = 0; a < 2; ++a)
#pragma unroll
            for (int b = 0; b < 2; ++b)
#pragma unroll
                for (int m = 0; m < 4; ++m)
#pragma unroll
                    for (int n = 0; n < 2; ++n) acc[a][b][m][n] = (f32x4){0.f, 0.f, 0.f, 0.f};
        cur = nxt; cA = nA; cB = nB; ++ui;
        if constexpr (ALIGN_EPI) { if (wr == 1) PG8_BAR; }
    }
    PG8_WAIT_V(0);
    if constexpr (!ALIGN_EPI) { if (wr == 0) PG8_BAR; }
    PG8_BAR;
#undef PG8_SA
#undef PG8_SB
#undef PG8_STAGE
#undef PG8_LDA
#undef PG8_LDB
#undef PG8_MMA
#undef PG8_WAIT_V
#undef PG8_WAIT_L
#undef PG8_SCHED
}
}
#define WG_BAR() do { asm volatile("s_waitcnt lgkmcnt(0)" ::: "memory"); __builtin_amdgcn_s_barrier(); asm volatile("" ::: "memory"); } while (0)

#define XB_TMO      128
#define XB_XCNT(j)  (256  + 64 * (j))
#define XB_XSUB(j)  (1280 + 64 * (j))
#define XB_XGEN(j)  (2304 + 64 * (j))
#define XB_TOP      3328
#define XB_TOPGEN   3392
#define XCD_BAR_WORDS 3456
#define XB_SPIN_CAP (1u << 18)
__device__ __forceinline__ unsigned xb_ld(unsigned* p)              { return __hip_atomic_load(p, __ATOMIC_RELAXED, __HIP_MEMORY_SCOPE_AGENT); }
__device__ __forceinline__ unsigned xb_add(unsigned* p, unsigned v) { return __hip_atomic_fetch_add(p, v, __ATOMIC_RELAXED, __HIP_MEMORY_SCOPE_AGENT); }
__device__ __forceinline__ unsigned xb_xcc_id() { return (unsigned)__builtin_amdgcn_s_getreg((3 << 11) | 20) & 0xFu; }
#define XB_SPIN(cond, bar) do { unsigned _sp = 0; while (cond) { __builtin_amdgcn_s_sleep(1); \
    if ((++_sp & 255u) == 0u) { if (xb_ld(&(bar)[XB_TMO])) break; if (_sp > XB_SPIN_CAP) { atomicAdd(&(bar)[XB_TMO], 1u); break; } } } } while (0)
struct XcdBarrier { unsigned* bar; unsigned x; volatile LAS unsigned* st; };
__device__ __forceinline__ XcdBarrier xcd_barrier_post(unsigned* bar, volatile LAS unsigned* st) {
    XcdBarrier b; b.bar = bar; b.x = xb_xcc_id(); b.st = st;
    if (threadIdx.x == 0) (void)xb_add(&bar[XB_XCNT(b.x)], 1u);
    return b;
}
__device__ __forceinline__ void xcd_barrier_complete(unsigned* bar, unsigned x, unsigned& nloc, unsigned& nx) {
    const unsigned G = gridDim.x * gridDim.y * gridDim.z;
    unsigned sum, cnt, mine, sp = 0u;
    for (;;) {
        sum = 0u; cnt = 0u; mine = 0u;
#pragma unroll
        for (unsigned j = 0; j < 16; ++j) { const unsigned c = xb_ld(&bar[XB_XCNT(j)]); sum += c; cnt += (c > 0u) ? 1u : 0u; mine = (j == x) ? c : mine; }
        if (sum == G) break;
        __builtin_amdgcn_s_sleep(1);
        if ((++sp & 255u) == 0u) { if (xb_ld(&bar[XB_TMO])) break; if (sp > XB_SPIN_CAP) { atomicAdd(&bar[XB_TMO], 1u); break; } }
    }
    nloc = mine > 0u ? mine : 1u; nx = cnt > 0u ? cnt : 1u;
}
__device__ __forceinline__ void xcd_barrier(const XcdBarrier& b) {
    asm volatile("s_waitcnt vmcnt(0)" ::: "memory");
    __syncthreads();
    if (threadIdx.x == 0) {
        unsigned* bar = b.bar;
        __builtin_amdgcn_s_waitcnt(0);
        unsigned nloc = b.st[0], nx = b.st[1];
        if (nloc == 0u) { xcd_barrier_complete(bar, b.x, nloc, nx); b.st[0] = nloc; b.st[1] = nx; }
        const unsigned old = xb_add(&bar[XB_XSUB(b.x)], 1u);
        const unsigned gen = old / nloc;
        if (old + 1u == (gen + 1u) * nloc) {
            __builtin_amdgcn_fence(__ATOMIC_RELEASE, "agent");
            asm volatile("s_waitcnt vmcnt(0)" ::: "memory");
            const unsigned og = xb_add(&bar[XB_TOP], 1u);
            const unsigned tg = og / nx;
            if (og + 1u == (tg + 1u) * nx) xb_add(&bar[XB_TOPGEN], 1u);
            else XB_SPIN(xb_ld(&bar[XB_TOPGEN]) == tg, bar);
            __builtin_amdgcn_fence(__ATOMIC_ACQUIRE, "agent");
            xb_add(&bar[XB_XGEN(b.x)], 1u);
            asm volatile("s_waitcnt vmcnt(0)" ::: "memory");
        } else {
            XB_SPIN(xb_ld(&bar[XB_XGEN(b.x)]) == gen, bar);
            __builtin_amdgcn_fence(__ATOMIC_ACQUIRE, "agent");
            asm volatile("s_waitcnt vmcnt(0)" ::: "memory");
        }
    }
    __syncthreads();
}

enum MapId { MAP_STD = 0, MAP_EVEN_IN = 1, MAP_XQ = 2, MAP_XKV = 3, MAP_FFN_UP = 4, MAP_ODD_IN = 5 };
__device__ __forceinline__ int colmap(int mapid, int n) {
    const int pn = n >> 8, s = n & 255, bj = s >> 7, wc = (s >> 5) & 3, nn = (s >> 4) & 1, fq = (s >> 2) & 3, i = s & 3;
    const int d32 = 8 * fq + 4 * nn + i, hd = 32 * bj + d32;
    switch (mapid) {
    case MAP_STD: return 256 * pn + 128 * bj + 32 * wc + d32;
    case MAP_EVEN_IN:
        if (pn <= 1) return (4 * pn + wc) * 64 + hd;
        if (pn == 2) { if (wc == 0) return 512 + hd; if (wc == 1) return 576 + hd; if (wc == 2) return 896 + hd; return hd < 4 ? 960 + hd : -1; }
        if (pn == 3) return 640 + wc * 64 + hd;
        return 964 + 256 * (pn - 4) + 128 * bj + 32 * wc + d32;
    case MAP_XQ: return (2 * pn + (wc >> 1)) * 128 + 64 * (wc & 1) + hd;
    case MAP_XKV:
        if (pn <= 1) return (2 * pn + (wc >> 1)) * 128 + 64 * (wc & 1) + hd;
        return 512 + 256 * (pn - 2) + 128 * bj + 32 * wc + d32;
    case MAP_FFN_UP: { const int ch = 128 * pn + 32 * wc + d32; return bj ? DFF + ch : ch; }
    default: { const int ch = 64 * pn + 16 * wc + 4 * fq + i, q = 2 * bj + nn; return q == 3 ? -1 : q * 1024 + ch; }
    }
}
struct PrepJob { const float* W; const float* gain; bf16_t* dst; int K, N, npad, mapid; };
__device__ __forceinline__ void prep_item(const PrepJob& J, LAS float* scr, int item, int lane) {
    const int nblk = J.npad / 32, kb = item / nblk, nb = item % nblk, k0 = 64 * kb, n0 = 32 * nb;
    const int col = colmap(J.mapid, n0 + (lane & 31));
    float wv[32];
#pragma unroll
    for (int i = 0; i < 32; ++i) { const int kk = 2 * i + (lane >> 5); wv[i] = (col >= 0) ? J.W[(size_t)(k0 + kk) * J.N + col] : 0.f; }
#pragma unroll
    for (int i = 0; i < 32; ++i) { const int kk = 2 * i + (lane >> 5); float v = wv[i]; if (J.gain) v *= J.gain[k0 + kk]; scr[kk * 33 + (lane & 31)] = v; }
    LDS_WAIT();
    const int c = lane & 7;
#pragma unroll
    for (int j = 0; j < 4; ++j) { const int n = (lane >> 3) + 8 * j; const LAS float* s = scr + (8 * c) * 33 + n;
        u32x4 o; o.x = pk2(s[0 * 33], s[1 * 33]); o.y = pk2(s[2 * 33], s[3 * 33]); o.z = pk2(s[4 * 33], s[5 * 33]); o.w = pk2(s[6 * 33], s[7 * 33]);
        *(u32x4*)(J.dst + (size_t)(n0 + n) * J.K + k0 + 8 * c) = o; }
    LDS_WAIT();
}

struct Params { const float* in[33]; float* out; unsigned char* ws; int ph_lo, ph_hi; };
enum InIdx { I_X = 0, I_MEM, I_NORM_MIX, I_NORM_X, I_NORM_MEM, I_NORM_FFN, I_EW_IN, I_EW_OUT, I_AQN, I_AKN, I_LAM_RE, I_LAM_IM, I_LOGSTEP, I_B_RE, I_B_IM, I_C_RE, I_C_IM, I_S5D, I_WGLU, I_BGLU,
             I_OW_IN, I_OCONV_W, I_OCONV_B, I_OW_OUT, I_XWQ, I_XWKV, I_XWO, I_XQN, I_XKN, I_FWUP, I_FCONV_W, I_FCONV_B, I_FWDN };

__device__ __forceinline__ bool get_job(const Params& P, int job, PrepJob& J) {
    bf16_t* wb = (bf16_t*)(P.ws + WS_W);
    if (job < 6) { const int j = job & 1, k = job >> 1;
        if (k == 0) { J = PrepJob{P.in[I_EW_IN] + (size_t)j * DM * 1476, P.in[I_NORM_MIX] + (2 * j) * DM, (bf16_t*)((char*)wb + W_EIN + j * 3 * MiB), DM, 1476, 1536, MAP_EVEN_IN}; return true; }
        if (k == 1) { J = PrepJob{P.in[I_EW_OUT] + (size_t)j * DM * DM, nullptr, (bf16_t*)((char*)wb + W_EOUT + j * 2 * MiB), DM, DM, DM, MAP_STD}; return true; }
        J = PrepJob{P.in[I_WGLU] + (size_t)j * 512 * 512, nullptr, (bf16_t*)((char*)wb + W_GLU + j * (MiB / 2)), 512, 512, 512, MAP_STD}; return true; }
    job -= 6;
    if (job < 4) { const int j = job & 1, k = job >> 1;
        if (k == 0) { J = PrepJob{P.in[I_OW_IN] + (size_t)j * DM * 3072, P.in[I_NORM_MIX] + (2 * j + 1) * DM, (bf16_t*)((char*)wb + W_OIN + j * 8 * MiB), DM, 3072, 4096, MAP_ODD_IN}; return true; }
        J = PrepJob{P.in[I_OW_OUT] + (size_t)j * DM * DM, nullptr, (bf16_t*)((char*)wb + W_OOUT + j * 2 * MiB), DM, DM, DM, MAP_STD}; return true; }
    job -= 4;
    if (job < 20) { const int i = job & 3, k = job >> 2;
        if (k == 0) { J = PrepJob{P.in[I_XWQ] + (size_t)i * DM * 512, P.in[I_NORM_X] + i * DM, (bf16_t*)((char*)wb + W_XQ + i * MiB), DM, 512, 512, MAP_XQ}; return true; }
        if (k == 1) { J = PrepJob{P.in[I_XWKV] + (size_t)i * DM * 1024, P.in[I_NORM_MEM] + i * DM, (bf16_t*)((char*)wb + W_XKV + i * 2 * MiB), DM, 1024, 1024, MAP_XKV}; return true; }
        if (k == 2) { J = PrepJob{P.in[I_XWO] + (size_t)i * 512 * DM, nullptr, (bf16_t*)((char*)wb + W_XO + i * MiB), 512, DM, DM, MAP_STD}; return true; }
        if (k == 3) { J = PrepJob{P.in[I_FWUP] + (size_t)i * DM * 2 * DFF, P.in[I_NORM_FFN] + i * DM, (bf16_t*)((char*)wb + W_UP + i * 11 * MiB), DM, 2 * DFF, 2 * DFF, MAP_FFN_UP}; return true; }
        J = PrepJob{P.in[I_FWDN] + (size_t)i * DFF * DM, nullptr, (bf16_t*)((char*)wb + W_DN + i * (11 * MiB / 2)), DFF, DM, DM, MAP_STD}; return true; }
    return false;
}
constexpr int NJOBS = 30;

__device__ __forceinline__ f32x2 cmul(f32x2 a, f32x2 b) { return (f32x2){a.x * b.x - a.y * b.y, a.x * b.y + a.y * b.x}; }
__device__ __forceinline__ void s5_precompute(const Params& P, LAS unsigned char* lds, int task) {
    const int tid = fresh_tid(), jg = task;
    LAS f32x2* PW = (LAS f32x2*)lds;
    LAS f32x2* BB = PW + 17 * 64;
    LAS f32x2* CC = BB + 64 * 16;
    unsigned char* op = P.ws + WS_S5OP + (size_t)jg * S5OP_STRIDE;
    if (tid < 64) {
        const int p = tid;
        const float delta = expf(P.in[I_LOGSTEP][jg]);
        const float lre = P.in[I_LAM_RE][jg * 64 + p], lim = P.in[I_LAM_IM][jg * 64 + p];
        for (int n = 0; n <= 16; ++n) { const float mag = expf((float)n * lre * delta); float sn, cs; sincosf((float)n * lim * delta, &sn, &cs); PW[n * 64 + p] = (f32x2){mag * cs, mag * sn}; }
        const f32x2 lb = PW[64 + p]; const float nr = lb.x - 1.f, ni = lb.y, den = lre * lre + lim * lim;
        const f32x2 coef = (f32x2){(nr * lre + ni * lim) / den, (ni * lre - nr * lim) / den};
        for (int c = 0; c < 16; ++c) { const f32x2 b = (f32x2){P.in[I_B_RE][((size_t)jg * 64 + p) * 16 + c], P.in[I_B_IM][((size_t)jg * 64 + p) * 16 + c]}; BB[p * 16 + c] = cmul(coef, b); }
        for (int c = 0; c < 16; ++c) CC[c * 64 + p] = (f32x2){P.in[I_C_RE][((size_t)jg * 16 + c) * 64 + p], P.in[I_C_IM][((size_t)jg * 16 + c) * 64 + p]};
        ((f32x2*)(op + S5OP_A16))[p] = PW[16 * 64 + p];
    }
    __syncthreads();
    bf16_t* Km = (bf16_t*)op; bf16_t* Pm = (bf16_t*)(op + S5OP_PM); bf16_t* Qm = (bf16_t*)(op + S5OP_QM);
    for (int idx = tid; idx < 17 * 256; idx += NTHREADS) {
        const int dd = idx >> 8, c1 = (idx >> 4) & 15, c = idx & 15; float v = 0.f;
        if (dd > 0) { const int d = dd - 1; for (int p = 0; p < 64; ++p) { const f32x2 m = cmul(cmul(CC[c1 * 64 + p], PW[d * 64 + p]), BB[p * 16 + c]); v += m.x; } }
        Km[idx] = (bf16_t)f2bf(v);
    }
    for (int idx = tid; idx < 128 * 256; idx += NTHREADS) {
        const int row = idx >> 8, col = idx & 255, p = row >> 1, ri = row & 1, tau = col >> 4, c = col & 15;
        const f32x2 m = cmul(PW[(15 - tau) * 64 + p], BB[p * 16 + c]);
        Pm[((((row >> 4) * 8 + (col >> 5)) * 64 + ((col >> 3) & 3) * 16 + (row & 15)) << 3) + (col & 7)] = (bf16_t)f2bf(ri ? m.y : m.x);
    }
    for (int idx = tid; idx < 256 * 128; idx += NTHREADS) {
        const int row = idx >> 7, col = idx & 127, tau = row >> 4, c1 = row & 15, p = col >> 1, ri = col & 1;
        const f32x2 m = cmul(CC[c1 * 64 + p], PW[(tau + 1) * 64 + p]);
        Qm[((((row >> 4) * 4 + (col >> 5)) * 64 + ((col >> 3) & 3) * 16 + (row & 15)) << 3) + (col & 7)] = (bf16_t)f2bf(ri ? -m.y : m.x);
    }
    __syncthreads();
}

__device__ __forceinline__ void prologue(const Params& P, LAS unsigned char* lds, int gw, int NGW, int wave, int lane) {
    for (int task = blockIdx.x; task < 64; task += gridDim.x) s5_precompute(P, lds, task);
    LAS float* scr = (LAS float*)(lds + wave * 16384);
    {
        int base = 0;
        for (int job = 0; job < NJOBS; ++job) {
            PrepJob J; get_job(P, job, J);
            const int nitems = (J.npad / 32) * (J.K / 64);
            int first = gw - (base % NGW); if (first < 0) first += NGW;
            for (int it = first; it < nitems; it += NGW) prep_item(J, scr, it, lane);
            base += nitems;
        }
    }
    {
        const float* x = P.in[I_X]; bf16_t* xb = (bf16_t*)(P.ws + WS_XB); float* ssq = (float*)(P.ws + WS_SSQ16);
        for (int m = gw; m < NTOK; m += NGW) {
            const f32x4* xr = (const f32x4*)(x + (size_t)m * DM) + lane; u32x2* bo = (u32x2*)(xb + (size_t)m * DM) + lane;
            float sq[4];
#pragma unroll
            for (int j = 0; j < 4; ++j) { const f32x4 v = xr[64 * j]; bo[64 * j] = (u32x2){pk2(v.x, v.y), pk2(v.z, v.w)}; sq[j] = wave_sum((v.x * v.x + v.y * v.y) + (v.z * v.z + v.w * v.w)); }
            if (lane < 16) ssq[16 * (size_t)m + lane] = (lane & 3) ? 0.f : ((lane >> 2) == 0 ? sq[0] : (lane >> 2) == 1 ? sq[1] : (lane >> 2) == 2 ? sq[2] : sq[3]);
        }
    }
    {
        const float* mem = P.in[I_MEM]; bf16_t* mb = (bf16_t*)(P.ws + WS_MEMB); float* mrs = (float*)(P.ws + WS_MEMRS);
        for (int m = gw; m < MEMTOK; m += NGW) {
            const f32x4* xr = (const f32x4*)(mem + (size_t)m * DM) + lane; u32x2* bo = (u32x2*)(mb + (size_t)m * DM) + lane;
            float s = 0.f;
#pragma unroll
            for (int j = 0; j < 4; ++j) { const f32x4 v = xr[64 * j]; bo[64 * j] = (u32x2){pk2(v.x, v.y), pk2(v.z, v.w)}; s += (v.x * v.x + v.y * v.y) + (v.z * v.z + v.w * v.w); }
            s = wave_sum(s);
            if (lane == 0) mrs[m] = rsqrtf(s * (1.f / DM) + EPS);
        }
    }
}

typedef const f32x4 (&AccRef)[2][2][4][2];
__device__ __forceinline__ u32x4 pack8(f32x4 a, f32x4 b) { u32x4 w; w.x = cvt_pk_bf16(a.x, a.y); w.y = cvt_pk_bf16(a.z, a.w); w.z = cvt_pk_bf16(b.x, b.y); w.w = cvt_pk_bf16(b.z, b.w); return w; }
typedef __amdgpu_buffer_rsrc_t rsrc_t;
__device__ __forceinline__ rsrc_t mkrsrc(const void* p) { return __builtin_amdgcn_make_buffer_rsrc((void*)p, 0, 0x7fffffff, 0x00020000); }
#define BLD128(r, vo, so) __builtin_amdgcn_raw_buffer_load_b128((r), (vo), (so), 0)
#define BLD64(r, vo, so) __builtin_amdgcn_raw_buffer_load_b64((r), (vo), (so), 0)
#define BST128(v, r, vo, so) __builtin_amdgcn_raw_buffer_store_b128((v), (r), (vo), (so), 0)
#define BST64(v, r, vo, so) __builtin_amdgcn_raw_buffer_store_b64((v), (r), (vo), (so), 0)
__device__ __forceinline__ f32x4 asf4(u32x4 v) { return __builtin_bit_cast(f32x4, v); }
__device__ __forceinline__ u32x4 asu4(f32x4 v) { return __builtin_bit_cast(u32x4, v); }
#define RFL(x) __builtin_amdgcn_readfirstlane(x)
__device__ __forceinline__ float rs_sum16(u32x4 a, u32x4 b, u32x4 c, u32x4 d) { const f32x4 s = (asf4(a) + asf4(b)) + (asf4(c) + asf4(d)); return rsqrtf(((s.x + s.y) + (s.z + s.w)) * (1.f / DM) + EPS); }
__device__ __forceinline__ LAS float* rs_stage(rsrc_t rq, LAS unsigned char* lds, int wr, int wc, int fr, int fq) {
    LAS float* sl = (LAS float*)(lds + EPI_OFF + (wr * 4 + wc) * 512);
    const int l = fq * 16 + fr;
    u32x4 t[2][4];
#pragma unroll
    for (int j = 0; j < 2; ++j) { const int rl = 128 * j + 64 * wr + l;
#pragma unroll
        for (int k = 0; k < 4; ++k) t[j][k] = BLD128(rq, rl * 64, 16 * k); }
#pragma unroll
    for (int j = 0; j < 2; ++j) sl[l + 64 * j] = rs_sum16(t[j][0], t[j][1], t[j][2], t[j][3]);
    LDS_WAIT();
    return sl;
}
__device__ __forceinline__ float xrow_sum(float v) {
    float a = v, b = v;
    asm("s_nop 1\n\tv_permlane32_swap_b32_e32 %0, %1\n\ts_nop 1\n\tv_add_f32_e32 %0, %0, %1\n\tv_mov_b32_e32 %1, %0\n\ts_nop 1\n\tv_permlane16_swap_b32_e32 %0, %1\n\ts_nop 1\n\tv_add_f32_e32 %0, %0, %1" : "+v"(a), "+v"(b));
    return a;
}
__device__ __forceinline__ float row_ror1(float v) { return __builtin_bit_cast(float, __builtin_amdgcn_update_dpp(0, __builtin_bit_cast(int, v), 0x121, 0xf, 0xf, true)); }
__device__ __forceinline__ float row_ror2(float v) { return __builtin_bit_cast(float, __builtin_amdgcn_update_dpp(0, __builtin_bit_cast(int, v), 0x122, 0xf, 0xf, true)); }
__device__ __forceinline__ float row_shr1(float v) { return __builtin_bit_cast(float, __builtin_amdgcn_update_dpp(0, __builtin_bit_cast(int, v), 0x111, 0xf, 0xf, true)); }
__device__ __forceinline__ float row_shr2(float v) { return __builtin_bit_cast(float, __builtin_amdgcn_update_dpp(0, __builtin_bit_cast(int, v), 0x112, 0xf, 0xf, true)); }
__device__ __forceinline__ f32x4 shr1_4(f32x4 v) { return (f32x4){row_shr1(v.x), row_shr1(v.y), row_shr1(v.z), row_shr1(v.w)}; }
__device__ __forceinline__ f32x4 shr2_4(f32x4 v) { return (f32x4){row_shr2(v.x), row_shr2(v.y), row_shr2(v.z), row_shr2(v.w)}; }
__device__ __forceinline__ void conv_taps(f32x4& c, f32x4 x, f32x4 w1, f32x4 w0) {
    asm("s_nop 1\n\t"
        "v_fmac_f32_dpp %0, %4, %8 row_shr:1 row_mask:0xf bank_mask:0xf\n\tv_fmac_f32_dpp %1, %5, %9 row_shr:1 row_mask:0xf bank_mask:0xf\n\t"
        "v_fmac_f32_dpp %2, %6, %10 row_shr:1 row_mask:0xf bank_mask:0xf\n\tv_fmac_f32_dpp %3, %7, %11 row_shr:1 row_mask:0xf bank_mask:0xf\n\t"
        "v_fmac_f32_dpp %0, %4, %12 row_shr:2 row_mask:0xf bank_mask:0xf\n\tv_fmac_f32_dpp %1, %5, %13 row_shr:2 row_mask:0xf bank_mask:0xf\n\t"
        "v_fmac_f32_dpp %2, %6, %14 row_shr:2 row_mask:0xf bank_mask:0xf\n\tv_fmac_f32_dpp %3, %7, %15 row_shr:2 row_mask:0xf bank_mask:0xf"
        : "+v"(c.x), "+v"(c.y), "+v"(c.z), "+v"(c.w)
        : "v"(x.x), "v"(x.y), "v"(x.z), "v"(x.w), "v"(w1.x), "v"(w1.y), "v"(w1.z), "v"(w1.w), "v"(w0.x), "v"(w0.y), "v"(w0.z), "v"(w0.w));
}
__device__ __forceinline__ void conv_taps_prev(f32x4& c, f32x4 xp, f32x4 w1a, f32x4 w0a) {
    asm("s_nop 1\n\t"
        "v_fmac_f32_dpp %0, %4, %8 row_ror:1 row_mask:0xf bank_mask:0xf\n\tv_fmac_f32_dpp %1, %5, %9 row_ror:1 row_mask:0xf bank_mask:0xf\n\t"
        "v_fmac_f32_dpp %2, %6, %10 row_ror:1 row_mask:0xf bank_mask:0xf\n\tv_fmac_f32_dpp %3, %7, %11 row_ror:1 row_mask:0xf bank_mask:0xf\n\t"
        "v_fmac_f32_dpp %0, %4, %12 row_ror:2 row_mask:0xf bank_mask:0xf\n\tv_fmac_f32_dpp %1, %5, %13 row_ror:2 row_mask:0xf bank_mask:0xf\n\t"
        "v_fmac_f32_dpp %2, %6, %14 row_ror:2 row_mask:0xf bank_mask:0xf\n\tv_fmac_f32_dpp %3, %7, %15 row_ror:2 row_mask:0xf bank_mask:0xf"
        : "+v"(c.x), "+v"(c.y), "+v"(c.z), "+v"(c.w)
        : "v"(xp.x), "v"(xp.y), "v"(xp.z), "v"(xp.w), "v"(w1a.x), "v"(w1a.y), "v"(w1a.z), "v"(w1a.w), "v"(w0a.x), "v"(w0a.y), "v"(w0a.z), "v"(w0a.w));
}
__device__ __forceinline__ f32x4 ror1_4(f32x4 v) { return (f32x4){row_ror1(v.x), row_ror1(v.y), row_ror1(v.z), row_ror1(v.w)}; }
__device__ __forceinline__ f32x4 ror2_4(f32x4 v) { return (f32x4){row_ror2(v.x), row_ror2(v.y), row_ror2(v.z), row_ror2(v.w)}; }

struct EpiResidual {
    float* XF; bf16_t* XB; float* SSQ; float sign;
    __device__ __forceinline__ void operator()(AccRef acc, const pg8::Unit& u, int wr, int wc, int fr, int fq) const {
        const int pm = RFL(u.pm), pn = RFL(u.pn);
        const rsrc_t rb = mkrsrc(XB + (size_t)pm * 256 * DM + pn * 256), rs = mkrsrc(SSQ + (size_t)pm * 256 * 16 + pn * 4 + wc);
        const bool fin = XF != nullptr;
        const rsrc_t rx = mkrsrc((fin ? XF : (float*)XB) + (size_t)pm * 256 * DM + pn * 256);
        const int vx = ((wr * 64 + fr) * DM + wc * 32 + 8 * fq) * 4, vb = vx >> 1, vs = (wr * 64 + fr) * 64;
        u32x4 xin[2][4][2];
#pragma unroll
        for (int ai = 0; ai < 2; ++ai)
#pragma unroll
            for (int m = 0; m < 4; ++m)
#pragma unroll
                for (int bj = 0; bj < 2; ++bj) xin[ai][m][bj] = BLD128(rb, vb, (((ai * 128 + m * 16) * DM + bj * 128) * 4) >> 1);
#pragma unroll
        for (int ai = 0; ai < 2; ++ai) {
#pragma unroll
            for (int m = 0; m < 4; ++m) {
                float s = 0.f;
#pragma unroll
                for (int bj = 0; bj < 2; ++bj) {
                    const int so = ((ai * 128 + m * 16) * DM + bj * 128) * 4;
                    const u32x4 xo = xin[ai][m][bj];
                    f32x4 a = (f32x4){bflo(xo.x), bfhi(xo.x), bflo(xo.y), bfhi(xo.y)}, b = (f32x4){bflo(xo.z), bfhi(xo.z), bflo(xo.w), bfhi(xo.w)};
#if MK_DUP
                    a += acc[ai][bj][m][0] * sign; b += acc[ai][bj][m][1] * sign;
#else
                    a += acc[ai][bj][m][0]; b += acc[ai][bj][m][1];
#endif
                    BST128(pack8(a, b), rb, vb, so >> 1);
                    if (fin) { BST128(asu4(a), rx, vx, so); BST128(asu4(b), rx, vx, so + 16); }
                    s += (a.x * a.x + a.y * a.y) + (a.z * a.z + a.w * a.w) + (b.x * b.x + b.y * b.y) + (b.z * b.z + b.w * b.w);
                }
                s = xrow_sum(s);
                if (fq == 0) __builtin_amdgcn_raw_buffer_store_b32(__builtin_bit_cast(unsigned, s), rs, vs, (ai * 128 + m * 16) * 64, 0);
            }
        }
    }
};

struct EpiEvenIn {
    const float* SSQ; const float* qg; const float* kg;
    bf16_t *Q, *KV, *IK, *IQ, *U; float* IW; LAS unsigned char* lds;
    __device__ __forceinline__ void operator()(AccRef acc, const pg8::Unit& u, int wr, int wc, int fr, int fq) const {
        const int pm = RFL(u.pm), pn = RFL(u.pn);
        int kind;
        bf16_t* dst; int rowstride, bjoff; const float* gain = qg; float post = 1.f;
        if (pn <= 1) { kind = 0; dst = Q + (4 * pn + wc) * 64; rowstride = 512; bjoff = 32; gain = qg; post = 0.125f * 1.4426950408889634f; }
        else if (pn == 2) {
            if (wc == 0) { kind = 0; dst = KV; rowstride = 128; bjoff = 32; gain = kg; }
            else if (wc == 1) { kind = 1; dst = KV + 64; rowstride = 128; bjoff = 32; }
            else if (wc == 2) { kind = 1; dst = IK; rowstride = 64; bjoff = 32; }
            else { kind = 2; dst = (bf16_t*)IW; rowstride = 8; bjoff = 0; }
        }
        else if (pn == 3) { kind = 1; dst = IQ + wc * 64; rowstride = 256; bjoff = 32; }
        else { kind = 3; dst = U + 256 * (pn - 4) + 32 * wc; rowstride = 512; bjoff = 128; }
        const rsrc_t rd = mkrsrc(dst + (size_t)pm * 256 * rowstride), rq = mkrsrc(SSQ + (size_t)pm * 256 * 16);
        const int vq = (wr * 64 + fr) * 64;
        int vd = ((wr * 64 + fr) * rowstride + 8 * fq) * 2;
        int rsb = rowstride * 2, bjb = bjoff * 2;
        if (pn == 2 && wc == 2) { vd = fq * 256 + fr * 16 + wr * 8192; bjb = 1024; }
        f32x4 gn[2][2];
#pragma unroll
        for (int bj = 0; bj < 2; ++bj) { gn[bj][0] = (f32x4){1.f, 1.f, 1.f, 1.f}; gn[bj][1] = gn[bj][0]; if (kind == 0) { gn[bj][0] = *(const f32x4*)(gain + 32 * bj + 8 * fq); gn[bj][1] = *(const f32x4*)(gain + 32 * bj + 8 * fq + 4); } }
        const LAS float* rsl = rs_stage(rq, lds, wr, wc, fr, fq);
#pragma unroll
        for (int ai = 0; ai < 2; ++ai) {
#pragma unroll
            for (int m = 0; m < 4; ++m) {
                float r = rsl[64 * ai + 16 * m + fr];
                if (kind == 0) {
                    float ss = 0.f;
#pragma unroll
                    for (int bj = 0; bj < 2; ++bj)
#pragma unroll
                        for (int n = 0; n < 2; ++n) { const f32x4 v = acc[ai][bj][m][n]; ss += (v.x * v.x + v.y * v.y) + (v.z * v.z + v.w * v.w); }
                    ss = xrow_sum(ss);
                    ss *= r * r;
                    r *= rsqrtf(ss * (1.f / 64.f) + EPS) * post;
                }
                if (kind == 2) {
                    if (fq == 0) BST128(asu4(acc[ai][0][m][0] * (r * 0.0625f)), rd, (wr * 64 + fr) * 16, (ai * 128 + m * 16) * 16);
                } else {
#pragma unroll
                    for (int bj = 0; bj < 2; ++bj) {
                        const f32x4 g0 = gn[bj][0], g1 = gn[bj][1];
                        BST128(pack8(acc[ai][bj][m][0] * r * g0, acc[ai][bj][m][1] * r * g1), rd, vd, (ai * 128 + m * 16) * rsb + bj * bjb);
                    }
                }
            }
        }
    }
};

template <int mode> struct EpiHead128 {
    const float* SSQ;
    const float* RS;
    bf16_t* dst; float* HSS; LAS unsigned char* lds;
    __device__ __forceinline__ void operator()(AccRef acc, const pg8::Unit& u, int wr, int wc, int fr, int fq) const {
        const int pm = RFL(u.pm), pn = RFL(u.pn);
        const int layer = (mode == 1) ? (pn >> 2) : 0, jt = (mode == 1) ? (pn & 3) : pn;
        const bool khead = (mode == 0) || (jt < 2);
        const rsrc_t rq = (mode == 0) ? mkrsrc(SSQ + (size_t)pm * 256 * 16) : mkrsrc(RS + (size_t)pm * 256);
        const int vq = (wr * 64 + fr) * 64, vr = (wr * 64 + fr) * 4;
        int rowstride, bjoff; bf16_t* d0; size_t hrow0;
        if (mode == 0) { rowstride = 512; bjoff = 32; d0 = dst + (size_t)pm * 256 * 512 + (2 * jt + (wc >> 1)) * 128 + 64 * (wc & 1); hrow0 = (size_t)pm * 256; }
        else if (jt < 2) { rowstride = 1024; bjoff = 32; d0 = dst + ((size_t)layer * MEMTOK + pm * 256) * 1024 + (2 * jt + (wc >> 1)) * 128 + 64 * (wc & 1); hrow0 = (size_t)layer * MEMTOK + pm * 256; }
        else { rowstride = 1024; bjoff = 128; d0 = dst + ((size_t)layer * MEMTOK + pm * 256) * 1024 + 512 + 256 * (jt - 2) + 32 * wc; hrow0 = 0; }
        const rsrc_t rd = mkrsrc(d0), rh = mkrsrc(HSS + hrow0 * 8 + (2 * (khead ? jt : 0) + (wc >> 1)) * 2 + (wc & 1));
        const int vd = ((wr * 64 + fr) * rowstride + 8 * fq) * 2, rsb = rowstride * 2, bjb = bjoff * 2, vh = (wr * 64 + fr) * 32;
        const LAS float* rsl = nullptr; if constexpr (mode == 0) rsl = rs_stage(rq, lds, wr, wc, fr, fq);
#pragma unroll
        for (int ai = 0; ai < 2; ++ai) {
            float rr[4];
            if constexpr (mode == 0) {
#pragma unroll
                for (int m = 0; m < 4; ++m) rr[m] = rsl[64 * ai + 16 * m + fr];
            } else {
#pragma unroll
                for (int m = 0; m < 4; ++m) rr[m] = __builtin_bit_cast(float, __builtin_amdgcn_raw_buffer_load_b32(rq, vr, (ai * 128 + m * 16) * 4, 0));
            }
#pragma unroll
            for (int m = 0; m < 4; ++m) {
                const float r = rr[m];
                if (khead) {
                    float ss = 0.f;
#pragma unroll
                    for (int bj = 0; bj < 2; ++bj)
#pragma unroll
                        for (int n = 0; n < 2; ++n) { const f32x4 v = acc[ai][bj][m][n]; ss += (v.x * v.x + v.y * v.y) + (v.z * v.z + v.w * v.w); }
                    ss = xrow_sum(ss);
                    if (fq == 0) __builtin_amdgcn_raw_buffer_store_b32(__builtin_bit_cast(unsigned, ss * r * r), rh, vh, (ai * 128 + m * 16) * 32, 0);
                }
#pragma unroll
                for (int bj = 0; bj < 2; ++bj) BST128(pack8(acc[ai][bj][m][0] * r, acc[ai][bj][m][1] * r), rd, vd, (ai * 128 + m * 16) * rsb + bj * bjb);
            }
        }
    }
};

struct EpiGlu {
    const bf16_t* YG; const float* bias; bf16_t* A2;
    __device__ __forceinline__ void operator()(AccRef acc, const pg8::Unit& u, int wr, int wc, int fr, int fq) const {
        const int pm = RFL(u.pm), pn = RFL(u.pn);
        const int col0 = pn * 256 + wc * 32 + 8 * fq;
        const rsrc_t ry = mkrsrc(YG + (size_t)pm * 256 * 512 + pn * 256), ro = mkrsrc(A2 + (size_t)pm * 256 * 1024 + 512 + pn * 256);
        const int vy = ((wr * 64 + fr) * 512 + wc * 32 + 8 * fq) * 2, vo = ((wr * 64 + fr) * 1024 + wc * 32 + 8 * fq) * 2;
        f32x4 bv[2][2];
#pragma unroll
        for (int bj = 0; bj < 2; ++bj) { bv[bj][0] = *(const f32x4*)(bias + col0 + bj * 128); bv[bj][1] = *(const f32x4*)(bias + col0 + bj * 128 + 4); }
#pragma unroll
        for (int ai = 0; ai < 2; ++ai) {
            u32x4 yin[4][2];
#pragma unroll
            for (int m = 0; m < 4; ++m)
#pragma unroll
                for (int bj = 0; bj < 2; ++bj) yin[m][bj] = BLD128(ry, vy, ((ai * 128 + m * 16) * 512 + bj * 128) * 2);
#pragma unroll
            for (int m = 0; m < 4; ++m) {
#pragma unroll
                for (int bj = 0; bj < 2; ++bj) {
                    const u32x4 y = yin[m][bj];
                    const f32x4 a = acc[ai][bj][m][0] + bv[bj][0], b = acc[ai][bj][m][1] + bv[bj][1];
                    f32x4 o0, o1;
                    o0.x = bflo(y.x) * sigmoid_f(a.x); o0.y = bfhi(y.x) * sigmoid_f(a.y); o0.z = bflo(y.y) * sigmoid_f(a.z); o0.w = bfhi(y.y) * sigmoid_f(a.w);
                    o1.x = bflo(y.z) * sigmoid_f(b.x); o1.y = bfhi(y.z) * sigmoid_f(b.y); o1.z = bflo(y.w) * sigmoid_f(b.z); o1.w = bfhi(y.w) * sigmoid_f(b.w);
                    BST128(pack8(o0, o1), ro, vo, ((ai * 128 + m * 16) * 1024 + bj * 128) * 2);
                }
            }
        }
    }
};

__device__ __forceinline__ f32x4 shfl4(f32x4 v, int src) { f32x4 r; r.x = __shfl(v.x, src); r.y = __shfl(v.y, src); r.z = __shfl(v.z, src); r.w = __shfl(v.w, src); return r; }
__device__ __forceinline__ f32x4 sel4(bool c, f32x4 a, f32x4 b) { return c ? a : b; }

struct EpiFfnUp {
    const float* SSQ; const float* cw; const float* cb;
    bf16_t* ACT; float* TAIL; float* HEAD; LAS unsigned char* lds;
    __device__ __forceinline__ void operator()(AccRef acc, const pg8::Unit& u, int wr, int wc, int fr, int fq) const {
        const int pm = RFL(u.pm), pn = RFL(u.pn);
        const int chl = 32 * wc + 8 * fq, ch0 = 128 * pn + chl;
        const size_t tix = (size_t)pm * 22 + pn;
        const rsrc_t rq = mkrsrc(SSQ + (size_t)pm * 256 * 16), ra = mkrsrc(ACT + (size_t)pm * 256 * DFF + 128 * pn);
        const int vq = (wr * 64 + fr) * 64, va = ((wr * 64 + fr) * DFF + chl) * 2;
        f32x4 w0v[2], w1v[2], w2v[2], bbv[2], w0a[2], w1a[2];
#pragma unroll
        for (int n = 0; n < 2; ++n) { w0v[n] = *(const f32x4*)(cw + ch0 + 4 * n); w1v[n] = *(const f32x4*)(cw + DFF + ch0 + 4 * n); w2v[n] = *(const f32x4*)(cw + 2 * DFF + ch0 + 4 * n); bbv[n] = *(const f32x4*)(cb + ch0 + 4 * n); }
        const LAS float* rsl = rs_stage(rq, lds, wr, wc, fr, fq);
        const f32x4 z4 = (f32x4){0.f, 0.f, 0.f, 0.f};
#pragma unroll
        for (int n = 0; n < 2; ++n) { w1a[n] = (fr == 0) ? w1v[n] : z4; w0a[n] = (fr < 2) ? w0v[n] : z4; }
#pragma unroll
        for (int ai = 0; ai < 2; ++ai) {
            float rr[4];
#pragma unroll
            for (int m = 0; m < 4; ++m) rr[m] = rsl[64 * ai + 16 * m + fr];
            f32x4 gp[2] = {z4, z4};
#pragma unroll
            for (int m = 0; m < 4; ++m) {
                const float r = rr[m];
                unsigned pk[4];
#pragma unroll
                for (int n = 0; n < 2; ++n) {
                    float* hd = HEAD + ((tix * 4 + 2 * ai + wr) * 4) * 128 + chl + 4 * n; float* tl = TAIL + ((tix * 4 + 2 * ai + wr) * 2) * 128 + chl + 4 * n;
                    const f32x4 g = acc[ai][0][m][n] * r, uu = acc[ai][1][m][n] * r;
                    f32x4 cg = w2v[n] * g + bbv[n];
                    conv_taps(cg, g, w1v[n], w0v[n]);
                    if (m > 0) conv_taps_prev(cg, gp[n], w1a[n], w0a[n]);
                    f32x4 o;
                    o.x = (cg.x * uu.x) * __builtin_amdgcn_rcpf(1.f + __builtin_amdgcn_exp2f(cg.x * -1.4426950408889634f));
                    o.y = (cg.y * uu.y) * __builtin_amdgcn_rcpf(1.f + __builtin_amdgcn_exp2f(cg.y * -1.4426950408889634f));
                    o.z = (cg.z * uu.z) * __builtin_amdgcn_rcpf(1.f + __builtin_amdgcn_exp2f(cg.z * -1.4426950408889634f));
                    o.w = (cg.w * uu.w) * __builtin_amdgcn_rcpf(1.f + __builtin_amdgcn_exp2f(cg.w * -1.4426950408889634f));
                    if (m == 0 && fr < 2) { *(f32x4*)(hd + fr * 128) = g; *(f32x4*)(hd + (2 + fr) * 128) = uu; }
                    if (m == 3 && fr >= 14) *(f32x4*)(tl + (fr - 14) * 128) = g;
                    pk[2 * n] = cvt_pk_bf16(o.x, o.y); pk[2 * n + 1] = cvt_pk_bf16(o.z, o.w);
                    gp[n] = g;
                }
                BST128(((u32x4){pk[0], pk[1], pk[2], pk[3]}), ra, va, ((ai * 128 + m * 16) * DFF) * 2);
            }
        }
    }
};

struct EpiOddIn {
    const float* SSQ; const float* cw; const float* cb;
    bf16_t* MIX; float* TAIL; float* HEAD; LAS unsigned char* lds;
    __device__ __forceinline__ void operator()(AccRef acc, const pg8::Unit& u, int wr, int wc, int fr, int fq) const {
        const int pm = RFL(u.pm), pn = RFL(u.pn);
        const int chl = 16 * wc + 4 * fq, ch0 = 64 * pn + chl;
        const size_t tix = (size_t)pm * 16 + pn;
        const rsrc_t rq = mkrsrc(SSQ + (size_t)pm * 256 * 16), ra = mkrsrc(MIX + (size_t)pm * 256 * DM + 64 * pn);
        const int vq = (wr * 64 + fr) * 64, va = ((wr * 64 + fr) * DM + chl) * 2;
        const f32x4 w0 = *(const f32x4*)(cw + ch0), w1 = *(const f32x4*)(cw + 1024 + ch0), w2 = *(const f32x4*)(cw + 2048 + ch0), bb = *(const f32x4*)(cb + ch0);
        const LAS float* rsl = rs_stage(rq, lds, wr, wc, fr, fq);
        const f32x4 z4 = (f32x4){0.f, 0.f, 0.f, 0.f};
        const f32x4 w1a = (fr == 0) ? w1 : z4, w0a = (fr < 2) ? w0 : z4;
#pragma unroll
        for (int ai = 0; ai < 2; ++ai) {
            float rr[4];
#pragma unroll
            for (int m = 0; m < 4; ++m) rr[m] = rsl[64 * ai + 16 * m + fr];
            float* hd = HEAD + ((tix * 4 + 2 * ai + wr) * 4) * 64 + chl; float* tl = TAIL + ((tix * 4 + 2 * ai + wr) * 2) * 64 + chl;
            f32x4 pprev = (f32x4){0.f, 0.f, 0.f, 0.f};
#pragma unroll
            for (int m = 0; m < 4; ++m) {
                const float r = rr[m];
                const f32x4 gb = acc[ai][0][m][0] * r, p = acc[ai][0][m][1] * acc[ai][1][m][0] * (r * r);
                f32x4 cv = w2 * p + bb;
                conv_taps(cv, p, w1, w0);
                if (m > 0) conv_taps_prev(cv, pprev, w1a, w0a);
                const f32x4 y = gb * cv;
                if (m == 0 && fr < 2) { *(f32x4*)(hd + fr * 64) = p; *(f32x4*)(hd + (2 + fr) * 64) = gb; }
                if (m == 3 && fr >= 14) *(f32x4*)(tl + (fr - 14) * 64) = p;
                BST64(((u32x2){cvt_pk_bf16(y.x, y.y), cvt_pk_bf16(y.z, y.w)}), ra, va, (ai * 128 + m * 16) * DM * 2);
                pprev = p;
            }
        }
    }
};


struct EpiNull {
    __device__ __forceinline__ void operator()(AccRef acc, const pg8::Unit& u, int wr, int wc, int fr, int fq) const {
#pragma unroll
        for (int ai = 0; ai < 2; ++ai)
#pragma unroll
            for (int bj = 0; bj < 2; ++bj)
#pragma unroll
                for (int m = 0; m < 4; ++m)
#pragma unroll
                    for (int n = 0; n < 2; ++n) asm volatile("" :: "v"(acc[ai][bj][m][n]));
    }
};

struct EpiPlain {
    bf16_t* O; int ldc;
    __device__ __forceinline__ void operator()(AccRef acc, const pg8::Unit& u, int wr, int wc, int fr, int fq) const {
        const int pm = RFL(u.pm), pn = RFL(u.pn);
        const rsrc_t rd = mkrsrc(O + (size_t)pm * 256 * ldc + pn * 256);
        const int vd = ((wr * 64 + fr) * ldc + wc * 32 + 8 * fq) * 2;
#pragma unroll
        for (int ai = 0; ai < 2; ++ai)
#pragma unroll
            for (int m = 0; m < 4; ++m)
#pragma unroll
                for (int bj = 0; bj < 2; ++bj) BST128(pack8(acc[ai][bj][m][0], acc[ai][bj][m][1]), rd, vd, ((ai * 128 + m * 16) * ldc + bj * 128) * 2);
    }
};

__device__ __forceinline__ void fixup_ffn(const Params& P, int layer, int gtid, int gthreads) {
    const float* TAIL = (const float*)(P.ws + WS_HALO2 + HALO_FT); const float* HEAD = (const float*)(P.ws + WS_HALO2 + HALO_FH);
    const float* cw = P.in[I_FCONV_W] + (size_t)layer * 3 * DFF; const float* cb = P.in[I_FCONV_B] + (size_t)layer * DFF; bf16_t* ACT = (bf16_t*)(P.ws + WS_R + R_ACT);
    constexpr int NIT = 128 * 22 * 4 * 2 * 32, NB = 3;
#pragma unroll 1
    for (int base = gtid; base < NIT; base += NB * gthreads) {
        f32x4 w0[NB], w1[NB], w2[NB], bb[NB], gm2[NB], gm1[NB], g0[NB], g1[NB], uu[NB]; bool ok[NB]; size_t dst[NB]; int rr[NB];
#pragma unroll
        for (int k = 0; k < NB; ++k) {
            const int idx = base + k * gthreads;
            const int ch = 4 * (idx & 31), r = (idx >> 5) & 1, q4 = (idx >> 6) & 3, t = idx >> 8, pn = t % 22, pm = t / 22;
            ok[k] = idx < NIT && !((pm & 15) == 0 && q4 == 0); rr[k] = r;
            if (ok[k]) {
                const size_t bcur = ((size_t)pm * 22 + pn) * 4 + q4, bprev = q4 ? bcur - 1 : ((size_t)(pm - 1) * 22 + pn) * 4 + 3;
                const float* Tl = TAIL + bprev * 256 + ch; const float* H = HEAD + bcur * 512 + ch; const int c = 128 * pn + ch;
                w0[k] = *(const f32x4*)(cw + c); w1[k] = *(const f32x4*)(cw + DFF + c); w2[k] = *(const f32x4*)(cw + 2 * DFF + c); bb[k] = *(const f32x4*)(cb + c);
                gm2[k] = *(const f32x4*)Tl; gm1[k] = *(const f32x4*)(Tl + 128); g0[k] = *(const f32x4*)H; g1[k] = *(const f32x4*)(H + 128); uu[k] = *(const f32x4*)(H + (2 + r) * 128);
                dst[k] = ((size_t)pm * 256 + q4 * 64 + r) * DFF + c;
            }
        }
#pragma unroll
        for (int k = 0; k < NB; ++k) if (ok[k]) {
            const f32x4 cg = rr[k] == 0 ? (w0[k] * gm2[k] + w1[k] * gm1[k] + w2[k] * g0[k] + bb[k]) : (w0[k] * gm1[k] + w1[k] * g0[k] + w2[k] * g1[k] + bb[k]);
            *(u32x2*)(ACT + dst[k]) = (u32x2){cvt_pk_bf16(silu_f(cg.x) * uu[k].x, silu_f(cg.y) * uu[k].y), cvt_pk_bf16(silu_f(cg.z) * uu[k].z, silu_f(cg.w) * uu[k].w)};
        }
    }
}
__device__ __forceinline__ void fixup_odd(const Params& P, int j, int gtid, int gthreads) {
    const float* TAIL = (const float*)(P.ws + WS_HALO2 + HALO_OT); const float* HEAD = (const float*)(P.ws + WS_HALO2 + HALO_OH);
    const float* cw = P.in[I_OCONV_W] + (size_t)j * 3 * 1024; const float* cb = P.in[I_OCONV_B] + (size_t)j * 1024; bf16_t* MIX = (bf16_t*)(P.ws + WS_R + R_MIX);
    constexpr int NIT = 128 * 16 * 4 * 2 * 16, NB = 2;
#pragma unroll 1
    for (int base = gtid; base < NIT; base += NB * gthreads) {
        f32x4 w0[NB], w1[NB], w2[NB], bb[NB], pm2[NB], pm1[NB], p0[NB], p1[NB], gb[NB]; bool ok[NB]; size_t dst[NB]; int rr[NB];
#pragma unroll
        for (int k = 0; k < NB; ++k) {
            const int idx = base + k * gthreads;
            const int ch = 4 * (idx & 15), r = (idx >> 4) & 1, q4 = (idx >> 5) & 3, t = idx >> 7, pn = t & 15, pm = t >> 4;
            ok[k] = idx < NIT && !((pm & 15) == 0 && q4 == 0); rr[k] = r;
            if (ok[k]) {
                const size_t bcur = ((size_t)pm * 16 + pn) * 4 + q4, bprev = q4 ? bcur - 1 : ((size_t)(pm - 1) * 16 + pn) * 4 + 3;
                const float* Tl = TAIL + bprev * 128 + ch; const float* H = HEAD + bcur * 256 + ch; const int c = 64 * pn + ch;
                w0[k] = *(const f32x4*)(cw + c); w1[k] = *(const f32x4*)(cw + 1024 + c); w2[k] = *(const f32x4*)(cw + 2048 + c); bb[k] = *(const f32x4*)(cb + c);
                pm2[k] = *(const f32x4*)Tl; pm1[k] = *(const f32x4*)(Tl + 64); p0[k] = *(const f32x4*)H; p1[k] = *(const f32x4*)(H + 64); gb[k] = *(const f32x4*)(H + (2 + r) * 64);
                dst[k] = ((size_t)pm * 256 + q4 * 64 + r) * DM + c;
            }
        }
#pragma unroll
        for (int k = 0; k < NB; ++k) if (ok[k]) {
            const f32x4 cv = rr[k] == 0 ? (w0[k] * pm2[k] + w1[k] * pm1[k] + w2[k] * p0[k] + bb[k]) : (w0[k] * pm1[k] + w1[k] * p0[k] + w2[k] * p1[k] + bb[k]);
            const f32x4 y = gb[k] * cv;
            *(u32x2*)(MIX + dst[k]) = (u32x2){cvt_pk_bf16(y.x, y.y), cvt_pk_bf16(y.z, y.w)};
        }
    }
}

#define MFMA16(a, b, c) __builtin_amdgcn_mfma_f32_16x16x32_bf16((a), (b), (c), 0, 0, 0)
constexpr int EH_STRIDE = 132;
__device__ __forceinline__ void s5_unit(const Params& P, LAS unsigned char* lds, int j, int b, int g, int wave, int lane) {
    const unsigned char* op = P.ws + WS_S5OP + (size_t)(j * 32 + g) * S5OP_STRIDE;
    const bf16_t* Km = (const bf16_t*)op; const bf16_t* Pm = (const bf16_t*)(op + S5OP_PM); const bf16_t* Qm = (const bf16_t*)(op + S5OP_QM); const f32x2* A16 = (const f32x2*)(op + S5OP_A16);
    const bf16_t* U = (const bf16_t*)(P.ws + WS_R + R_U); bf16_t* YG = (bf16_t*)(P.ws + WS_R + R_YG);
    const float* Dv = P.in[I_S5D] + (size_t)j * 512 + 16 * g;
    LAS float* EH = (LAS float*)lds;
    const int l15 = lane & 15, kb = lane >> 4;
    bf16x8 ub[2][8];
#pragma unroll
    for (int q = 0; q < 2; ++q) { const int chunk = 16 * (2 * wave + q) + l15;
#pragma unroll
        for (int ks = 0; ks < 8; ++ks) ub[q][ks] = *(const bf16x8*)(U + ((size_t)(b * SEQ + chunk * 16 + 2 * ks + (kb >> 1))) * 512 + 16 * g + 8 * (kb & 1)); }
#pragma unroll 2
    for (int mt = 0; mt < 8; ++mt) {
        f32x4 acc0 = (f32x4){0.f, 0.f, 0.f, 0.f}, acc1 = acc0;
#pragma unroll
        for (int ks = 0; ks < 8; ++ks) { const bf16x8 a = *(const bf16x8*)(Pm + (mt * 8 + ks) * 512 + 8 * lane); acc0 = MFMA16(a, ub[0][ks], acc0); acc1 = MFMA16(a, ub[1][ks], acc1); }
        *(LAS f32x4*)(EH + (16 * (2 * wave) + l15) * EH_STRIDE + 16 * mt + 4 * kb) = acc0;
        *(LAS f32x4*)(EH + (16 * (2 * wave + 1) + l15) * EH_STRIDE + 16 * mt + 4 * kb) = acc1;
    }
    __syncthreads();
    {
        const f32x2 a16 = A16[lane];
        LAS f32x2* HL = (LAS f32x2*)(lds + 256 * EH_STRIDE * 4);
        f32x2 h = (f32x2){0.f, 0.f};
#pragma unroll 4
        for (int k = 0; k < 32; ++k) {
            LAS f32x2* e = (LAS f32x2*)(EH + (32 * wave + k) * EH_STRIDE) + lane;
            const f32x2 ev = *e; *e = h;
            h = (f32x2){a16.x * h.x - a16.y * h.y + ev.x, a16.x * h.y + a16.y * h.x + ev.y};
        }
        HL[wave * 64 + lane] = h;
        f32x2 p32 = a16;
#pragma unroll
        for (int i = 0; i < 5; ++i) p32 = cmul(p32, p32);
        __syncthreads();
        f32x2 hin = (f32x2){0.f, 0.f};
        for (int v = 0; v < wave; ++v) { const f32x2 ev = HL[v * 64 + lane]; hin = (f32x2){p32.x * hin.x - p32.y * hin.y + ev.x, p32.x * hin.y + p32.y * hin.x + ev.y}; }
        if (wave > 0) {
            f32x2 t = hin;
#pragma unroll 4
            for (int k = 0; k < 32; ++k) {
                LAS f32x2* e = (LAS f32x2*)(EH + (32 * wave + k) * EH_STRIDE) + lane;
                const f32x2 ev = *e; *e = (f32x2){ev.x + t.x, ev.y + t.y};
                t = cmul(a16, t);
            }
        }
    }
    __syncthreads();
    {
        bf16x8 hb[2][4];
#pragma unroll
        for (int q = 0; q < 2; ++q) { const int chunk = 16 * (2 * wave + q) + l15;
#pragma unroll
            for (int ks = 0; ks < 4; ++ks) { const f32x4 h0 = *(const LAS f32x4*)(EH + chunk * EH_STRIDE + 32 * ks + 8 * kb), h1 = *(const LAS f32x4*)(EH + chunk * EH_STRIDE + 32 * ks + 8 * kb + 4); hb[q][ks] = as_bf16x8(pack8(h0, h1)); } }
        const f32x4 dv = *(const f32x4*)(Dv + 4 * kb);
#pragma unroll 2
        for (int mt = 0; mt < 16; ++mt) {
            f32x4 acc[2]; acc[0] = (f32x4){0.f, 0.f, 0.f, 0.f}; acc[1] = acc[0];
#pragma unroll
            for (int ks = 0; ks < 4; ++ks) { const bf16x8 a = *(const bf16x8*)(Qm + (mt * 4 + ks) * 512 + 8 * lane); acc[0] = MFMA16(a, hb[0][ks], acc[0]); acc[1] = MFMA16(a, hb[1][ks], acc[1]); }
#pragma unroll
            for (int ks = 0; ks < 8; ++ks) {
                if (2 * ks <= mt) { const int dd = mt - 2 * ks - (kb >> 1) + 1; const bf16x8 a = *(const bf16x8*)(Km + (dd * 16 + l15) * 16 + 8 * (kb & 1)); acc[0] = MFMA16(a, ub[0][ks], acc[0]); acc[1] = MFMA16(a, ub[1][ks], acc[1]); }
            }
#pragma unroll
            for (int q = 0; q < 2; ++q) {
                const int chunk = 16 * (2 * wave + q) + l15;
                const size_t off = ((size_t)(b * SEQ + chunk * 16 + mt)) * 512 + 16 * g + 4 * kb;
                const u32x2 uw = *(const u32x2*)(U + off);
                f32x4 y; y.x = acc[q].x + dv.x * bflo(uw.x); y.y = acc[q].y + dv.y * bfhi(uw.x); y.z = acc[q].z + dv.z * bflo(uw.y); y.w = acc[q].w + dv.w * bfhi(uw.y);
                *(u32x2*)(YG + off) = (u32x2){cvt_pk_bf16(gelu_tanh_f(y.x), gelu_tanh_f(y.y)), cvt_pk_bf16(gelu_tanh_f(y.z), gelu_tanh_f(y.w))};
            }
        }
    }
    __syncthreads();
}

constexpr int SROW = 8208;
constexpr int SEL_OFF = 16 * SROW;
__device__ __forceinline__ unsigned tr_pair_lo_hi(unsigned a0, unsigned a1, s16x4& lo, s16x4& hi) {
    asm volatile("ds_read_b64_tr_b16 %0, %2\n\tds_read_b64_tr_b16 %1, %3\n\ts_waitcnt lgkmcnt(0)" : "=&v"(lo), "=&v"(hi) : "v"(a0), "v"(a1) : "memory");
    return 0;
}
__device__ __forceinline__ void tr_quad(const unsigned (&a0)[4], const unsigned (&a1)[4], s16x4 (&lo)[4], s16x4 (&hi)[4]) {
    asm volatile("ds_read_b64_tr_b16 %0, %8\n\tds_read_b64_tr_b16 %1, %9\n\tds_read_b64_tr_b16 %2, %10\n\tds_read_b64_tr_b16 %3, %11\n\t"
                 "ds_read_b64_tr_b16 %4, %12\n\tds_read_b64_tr_b16 %5, %13\n\tds_read_b64_tr_b16 %6, %14\n\tds_read_b64_tr_b16 %7, %15\n\ts_waitcnt lgkmcnt(0)"
                 : "=&v"(lo[0]), "=&v"(lo[1]), "=&v"(lo[2]), "=&v"(lo[3]), "=&v"(hi[0]), "=&v"(hi[1]), "=&v"(hi[2]), "=&v"(hi[3])
                 : "v"(a0[0]), "v"(a0[1]), "v"(a0[2]), "v"(a0[3]), "v"(a1[0]), "v"(a1[1]), "v"(a1[2]), "v"(a1[3]) : "memory");
}
template <int OFF>
__device__ __forceinline__ void tr_quad_off(const unsigned (&a0)[4], const unsigned (&a1)[4], s16x4 (&lo)[4], s16x4 (&hi)[4]) {
    asm volatile("ds_read_b64_tr_b16 %0, %8 offset:%16\n\tds_read_b64_tr_b16 %1, %9 offset:%16\n\tds_read_b64_tr_b16 %2, %10 offset:%16\n\tds_read_b64_tr_b16 %3, %11 offset:%16\n\t"
                 "ds_read_b64_tr_b16 %4, %12 offset:%16\n\tds_read_b64_tr_b16 %5, %13 offset:%16\n\tds_read_b64_tr_b16 %6, %14 offset:%16\n\tds_read_b64_tr_b16 %7, %15 offset:%16\n\ts_waitcnt lgkmcnt(0)"
                 : "=&v"(lo[0]), "=&v"(lo[1]), "=&v"(lo[2]), "=&v"(lo[3]), "=&v"(hi[0]), "=&v"(hi[1]), "=&v"(hi[2]), "=&v"(hi[3])
                 : "v"(a0[0]), "v"(a0[1]), "v"(a0[2]), "v"(a0[3]), "v"(a1[0]), "v"(a1[1]), "v"(a1[2]), "v"(a1[3]), "n"(OFF) : "memory");
}
template <int OFF>
__device__ __forceinline__ void tr_issue_off(const unsigned (&a0)[4], const unsigned (&a1)[4], s16x4 (&lo)[4], s16x4 (&hi)[4]) {
    asm volatile("ds_read_b64_tr_b16 %0, %8 offset:%16\n\tds_read_b64_tr_b16 %1, %9 offset:%16\n\tds_read_b64_tr_b16 %2, %10 offset:%16\n\tds_read_b64_tr_b16 %3, %11 offset:%16\n\t"
                 "ds_read_b64_tr_b16 %4, %12 offset:%16\n\tds_read_b64_tr_b16 %5, %13 offset:%16\n\tds_read_b64_tr_b16 %6, %14 offset:%16\n\tds_read_b64_tr_b16 %7, %15 offset:%16"
                 : "=&v"(lo[0]), "=&v"(lo[1]), "=&v"(lo[2]), "=&v"(lo[3]), "=&v"(hi[0]), "=&v"(hi[1]), "=&v"(hi[2]), "=&v"(hi[3])
                 : "v"(a0[0]), "v"(a0[1]), "v"(a0[2]), "v"(a0[3]), "v"(a1[0]), "v"(a1[1]), "v"(a1[2]), "v"(a1[3]), "n"(OFF) : "memory");
}
__device__ __forceinline__ void tr_wait16(s16x4 (&l0)[4], s16x4 (&h0)[4], s16x4 (&l1)[4], s16x4 (&h1)[4]) {
    asm volatile("s_waitcnt lgkmcnt(0)" : "+v"(l0[0]), "+v"(l0[1]), "+v"(l0[2]), "+v"(l0[3]), "+v"(h0[0]), "+v"(h0[1]), "+v"(h0[2]), "+v"(h0[3]),
                 "+v"(l1[0]), "+v"(l1[1]), "+v"(l1[2]), "+v"(l1[3]), "+v"(h1[0]), "+v"(h1[1]), "+v"(h1[2]), "+v"(h1[3]) :: "memory");
}
__device__ __forceinline__ bf16x8 join8(s16x4 lo, s16x4 hi) { bf16x8 r; r[0] = lo[0]; r[1] = lo[1]; r[2] = lo[2]; r[3] = lo[3]; r[4] = hi[0]; r[5] = hi[1]; r[6] = hi[2]; r[7] = hi[3]; return r; }

struct Mask8 { unsigned long long m[8]; };
__device__ __forceinline__ Mask8 ge_masks8(unsigned t, unsigned k0, unsigned k1, unsigned k2, unsigned k3, unsigned k4, unsigned k5, unsigned k6, unsigned k7) {
    Mask8 r;
    asm("v_cmp_le_u32_e64 %0, %8, %9\n\tv_cmp_le_u32_e64 %1, %8, %10\n\tv_cmp_le_u32_e64 %2, %8, %11\n\tv_cmp_le_u32_e64 %3, %8, %12\n\t"
        "v_cmp_le_u32_e64 %4, %8, %13\n\tv_cmp_le_u32_e64 %5, %8, %14\n\tv_cmp_le_u32_e64 %6, %8, %15\n\tv_cmp_le_u32_e64 %7, %8, %16"
        : "=&s"(r.m[0]), "=&s"(r.m[1]), "=&s"(r.m[2]), "=&s"(r.m[3]), "=&s"(r.m[4]), "=&s"(r.m[5]), "=&s"(r.m[6]), "=&s"(r.m[7])
        : "s"(t), "v"(k0), "v"(k1), "v"(k2), "v"(k3), "v"(k4), "v"(k5), "v"(k6), "v"(k7));
    return r;
}
__device__ __forceinline__ int cnt_ge8(unsigned t, unsigned k0, unsigned k1, unsigned k2, unsigned k3, unsigned k4, unsigned k5, unsigned k6, unsigned k7) {
    const Mask8 r = ge_masks8(t, k0, k1, k2, k3, k4, k5, k6, k7);
    return (__popcll(r.m[0]) + __popcll(r.m[1])) + (__popcll(r.m[2]) + __popcll(r.m[3])) + (__popcll(r.m[4]) + __popcll(r.m[5])) + (__popcll(r.m[6]) + __popcll(r.m[7]));
}
__device__ __forceinline__ int mbcnt64(unsigned long long m, int base) { return __builtin_amdgcn_mbcnt_hi((unsigned)(m >> 32), __builtin_amdgcn_mbcnt_lo((unsigned)m, base)); }
__device__ __forceinline__ float relu_i(float x) { const int i = __builtin_bit_cast(int, x); return __builtin_bit_cast(float, i > 0 ? i : 0); }
typedef _Float16 f16x2 __attribute__((ext_vector_type(2)));
typedef short i16x2 __attribute__((ext_vector_type(2)));
__device__ __forceinline__ unsigned sortkey2(float a, float b) {
    const f16x2 h = (f16x2){(_Float16)a, (_Float16)b};
    const i16x2 m = __builtin_bit_cast(i16x2, h) >> 15;
    const unsigned u = __builtin_bit_cast(unsigned, h);
    return u ^ (__builtin_bit_cast(unsigned, m) | 0x80008000u);
}
__device__ __forceinline__ float xrow_max(float v) {
    float a = v, b = v;
    asm("s_nop 1\n\tv_permlane32_swap_b32_e32 %0, %1\n\ts_nop 1\n\tv_max_f32_e32 %0, %0, %1\n\tv_mov_b32_e32 %1, %0\n\ts_nop 1\n\tv_permlane16_swap_b32_e32 %0, %1\n\ts_nop 1\n\tv_max_f32_e32 %0, %0, %1" : "+v"(a), "+v"(b));
    return a;
}
__device__ __forceinline__ int cnt_ge4(unsigned t, unsigned k0, unsigned k1, unsigned k2, unsigned k3) {
    unsigned long long m0, m1, m2, m3;
    asm("v_cmp_le_u32_e64 %0, %4, %5\n\tv_cmp_le_u32_e64 %1, %4, %6\n\tv_cmp_le_u32_e64 %2, %4, %7\n\tv_cmp_le_u32_e64 %3, %4, %8"
        : "=&s"(m0), "=&s"(m1), "=&s"(m2), "=&s"(m3) : "s"(t), "v"(k0), "v"(k1), "v"(k2), "v"(k3));
    return (__popcll(m0) + __popcll(m1)) + (__popcll(m2) + __popcll(m3));
}
template <int NR, int SH>
__device__ __forceinline__ void dsa_pick(const unsigned (&kk)[NR], LAS unsigned short* sel, int lane, int cge0) {
    unsigned T = 0; int cge = cge0;
#pragma unroll 1
    for (int bit = 15; bit >= 0; --bit) {
        const unsigned trial = T | (1u << bit); int cnt = 0;
#pragma unroll
        for (int i = 0; i < NR; i += 8) cnt += cnt_ge8(trial << SH, kk[i], kk[i + 1], kk[i + 2], kk[i + 3], kk[i + 4], kk[i + 5], kk[i + 6], kk[i + 7]);
        if (cnt >= 256) { T = trial; cge = cnt; }
    }
    const unsigned tge = T << SH, tgt = (SH && T >= 0xffffu) ? 0xffffffffu : ((T + 1u) << SH);
    int out_base = 0;
    if (cge == 256) {
#pragma unroll
        for (int i = 0; i < NR; i += 8) {
            const Mask8 ge = ge_masks8(tge, kk[i], kk[i + 1], kk[i + 2], kk[i + 3], kk[i + 4], kk[i + 5], kk[i + 6], kk[i + 7]);
#pragma unroll
            for (int j = 0; j < 8; ++j) {
                const unsigned long long tm = ge.m[j];
                const int pos = mbcnt64(tm, out_base);
                if (__builtin_amdgcn_inverse_ballot_w64(tm)) sel[pos] = (unsigned short)(SH ? (kk[i + j] & 0xffffu) : (unsigned)(64 * (i + j) + lane));
                out_base += __popcll(tm);
            }
        }
    } else {
        int room;
        { int cgt = 0;
#pragma unroll
          for (int i = 0; i < NR; i += 8) cgt += cnt_ge8(tgt, kk[i], kk[i + 1], kk[i + 2], kk[i + 3], kk[i + 4], kk[i + 5], kk[i + 6], kk[i + 7]);
          room = 256 - cgt; }
#pragma unroll
        for (int i = 0; i < NR; i += 8) {
            const Mask8 ge = ge_masks8(tge, kk[i], kk[i + 1], kk[i + 2], kk[i + 3], kk[i + 4], kk[i + 5], kk[i + 6], kk[i + 7]);
            const Mask8 gt = ge_masks8(tgt, kk[i], kk[i + 1], kk[i + 2], kk[i + 3], kk[i + 4], kk[i + 5], kk[i + 6], kk[i + 7]);
#pragma unroll
            for (int j = 0; j < 8; ++j) {
                unsigned long long tm = gt.m[j], eqm = ge.m[j] & ~gt.m[j];
                if (eqm != 0ull) {
                    const int ec = __popcll(eqm);
                    if (ec <= room) { tm |= eqm; room -= ec; }
                    else { while (room > 0) { const unsigned long long low = eqm & (0ull - eqm); tm |= low; eqm ^= low; --room; } }
                }
                const int pos = mbcnt64(tm, out_base);
                if (__builtin_amdgcn_inverse_ballot_w64(tm)) sel[pos] = (unsigned short)(SH ? (kk[i + j] & 0xffffu) : (unsigned)(64 * (i + j) + lane));
                out_base += __popcll(tm);
            }
        }
    }
}
template <int NR>
__device__ __forceinline__ void dsa_select(LAS unsigned char* lds, int q, int L, int lane) {
    const LAS unsigned short* srow = (const LAS unsigned short*)(lds + q * SROW);
    LAS unsigned short* sel = (LAS unsigned short*)(lds + SEL_OFF + q * 512);
    const int nreg = L >> 6;
    unsigned kk[NR];
#pragma unroll
    for (int i = 0; i < NR; ++i) kk[i] = (i < nreg) ? (unsigned)srow[64 * i + lane] : 0u;
    if constexpr (NR >= 32) {
        const int c0 = min(500, (448 * 512) / L + 8);
        unsigned Ts = 0;
#pragma unroll 1
        for (int bit = 15; bit >= 0; --bit) { const unsigned trial = Ts | (1u << bit);
            if (cnt_ge8(trial, kk[0], kk[NR / 8], kk[2 * NR / 8], kk[3 * NR / 8], kk[4 * NR / 8], kk[5 * NR / 8], kk[6 * NR / 8], kk[7 * NR / 8]) >= c0) Ts = trial; }
        int ncand = 0;
#pragma unroll
        for (int i = 0; i < NR; i += 8) ncand += cnt_ge8(Ts, kk[i], kk[i + 1], kk[i + 2], kk[i + 3], kk[i + 4], kk[i + 5], kk[i + 6], kk[i + 7]);
        if (Ts >= 1u && ncand >= 256 && ncand <= 2048) {
            LAS unsigned* cand = (LAS unsigned*)(lds + q * SROW);
            int base = 0;
#pragma unroll
            for (int i = 0; i < NR; i += 8) {
                const Mask8 ge = ge_masks8(Ts, kk[i], kk[i + 1], kk[i + 2], kk[i + 3], kk[i + 4], kk[i + 5], kk[i + 6], kk[i + 7]);
#pragma unroll
                for (int j = 0; j < 8; ++j) {
                    const unsigned long long tm = ge.m[j];
                    const int pos = mbcnt64(tm, base);
                    if (__builtin_amdgcn_inverse_ballot_w64(tm)) cand[pos] = (kk[i + j] << 16) | (unsigned)(64 * (i + j) + lane);
                    base += __popcll(tm);
                }
            }
            LDS_WAIT();
            if (ncand <= 512) {
                unsigned cc[8];
#pragma unroll
                for (int i = 0; i < 8; ++i) cc[i] = (64 * i + lane < ncand) ? cand[64 * i + lane] : 0u;
                dsa_pick<8, 16>(cc, sel, lane, ncand);
            } else if (ncand <= 1024) {
                unsigned cc[16];
#pragma unroll
                for (int i = 0; i < 16; ++i) cc[i] = (64 * i + lane < ncand) ? cand[64 * i + lane] : 0u;
                dsa_pick<16, 16>(cc, sel, lane, ncand);
            } else {
                unsigned cc[32];
#pragma unroll
                for (int i = 0; i < 32; ++i) cc[i] = (64 * i + lane < ncand) ? cand[64 * i + lane] : 0u;
                dsa_pick<32, 16>(cc, sel, lane, ncand);
            }
            return;
        }
    }
    dsa_pick<NR, 0>(kk, sel, lane, NR * 64);
}

__device__ __forceinline__ void dsa_unit(const Params& P, LAS unsigned char* lds, int b, int t0, int L, int wave, int lane, float negB) {
    const bf16_t* Q = (const bf16_t*)(P.ws + WS_R + R_Q); const bf16_t* KV = (const bf16_t*)(P.ws + WS_R + R_KV); const bf16_t* IK = (const bf16_t*)(P.ws + WS_R + R_IK);
    const bf16_t* IQ = (const bf16_t*)(P.ws + WS_R + R_IQ); const float* IW = (const float*)(P.ws + WS_R + R_IW); bf16_t* A2 = (bf16_t*)(P.ws + WS_R + R_A2);
    lane = fresh_tid() & 63;
    const int l15 = lane & 15, kb = lane >> 4;
    const size_t row0 = (size_t)b * SEQ + t0;
#pragma unroll 1
    for (int rep_ = 0; rep_ < ((MK_DSA_REP & 1) ? 2 : 1); ++rep_)
    if (L > 256) {
        bf16x8 iqf[4][2];
#pragma unroll
        for (int h = 0; h < 4; ++h)
#pragma unroll
            for (int ks = 0; ks < 2; ++ks) iqf[h][ks] = *(const bf16x8*)(IQ + (row0 + l15) * 256 + h * 64 + 32 * ks + 8 * kb);
        const f32x4 iw = *(const f32x4*)(IW + (row0 + l15) * 4);
        const int ntile = L >> 4;
        bf16x8 a0[4], a1[4], b0[4], b1[4];
        const bf16_t* ikb = IK + (size_t)b * SEQ * 64 + 8 * lane;
#define DSA_LOAD4(x0, x1, tb_) do { const int tb__ = ((tb_) < ntile) ? (tb_) : wave; _Pragma("unroll") for (int j = 0; j < 4; ++j) { const int t = (tb__ + 8 * j < ntile) ? tb__ + 8 * j : tb__; \
            const bf16_t* kp = ikb + (size_t)t * 1024; x0[j] = *(const bf16x8*)kp; x1[j] = *(const bf16x8*)(kp + 512); } } while (0)
#define DSA_SCORE4(x0, x1, tb_) do { _Pragma("unroll") for (int j = 0; j < 4; ++j) { const int t = (tb_) + 8 * j; if (t < ntile) { \
            f32x4 s = (f32x4){0.f, 0.f, 0.f, 0.f}; \
            _Pragma("unroll") for (int h = 0; h < 4; ++h) { f32x4 acc = (f32x4){0.f, 0.f, 0.f, 0.f}; acc = MFMA16(x0[j], iqf[h][0], acc); acc = MFMA16(x1[j], iqf[h][1], acc); const float w = iw[h]; \
                s.x += w * relu_i(acc.x); s.y += w * relu_i(acc.y); s.z += w * relu_i(acc.z); s.w += w * relu_i(acc.w); } \
            *(LAS u32x2*)(lds + l15 * SROW + 2 * (16 * t + 4 * kb)) = (u32x2){sortkey2(s.x, s.y), sortkey2(s.z, s.w)}; } } } while (0)
        DSA_LOAD4(a0, a1, wave);
#pragma unroll 1
        for (int t0 = wave; t0 < ntile; t0 += 64) {
            DSA_LOAD4(b0, b1, t0 + 32);
            DSA_SCORE4(a0, a1, t0);
            if (t0 + 32 >= ntile) break;
            DSA_LOAD4(a0, a1, t0 + 64);
            DSA_SCORE4(b0, b1, t0 + 32);
        }
#undef DSA_LOAD4
#undef DSA_SCORE4
    }
    __syncthreads();
    const int nsel = L < 256 ? L : 256;
#pragma unroll 1
    for (int rep_ = 0; rep_ < ((MK_DSA_REP & 2) ? 2 : 1); ++rep_)
#pragma unroll 1
    for (int qq = 0; qq < 2; ++qq) {
        const int q = 2 * wave + qq;
        LAS unsigned short* sel = (LAS unsigned short*)(lds + SEL_OFF + q * 512);
        if (L <= 256) {
#pragma unroll
            for (int i = 0; i < 4; ++i) { const int jx = 64 * i + lane; sel[jx] = (unsigned short)(jx < L ? jx : 0); }
        } else if (L <= 1024) dsa_select<16>(lds, q, L, lane);
        else if (L <= 2048) dsa_select<32>(lds, q, L, lane);
        else if (L <= 3072) dsa_select<48>(lds, q, L, lane);
        else dsa_select<64>(lds, q, L, lane);
    }
    LDS_WAIT();
    {
    const int lane = fresh_tid() & 63, l15 = lane & 15, kb = lane >> 4;
    LAS unsigned char* KBUF = lds + (2 * wave) * SROW; LAS unsigned char* VBUF = KBUF + 8192;
    const unsigned vb_addr = (unsigned)(uintptr_t)VBUF;
    const int qd = l15 >> 2, pp = lane & 3;
    const int nblk = nsel >> 6, ntot = 2 * nblk;
    const bf16_t* KVb = KV + (size_t)b * SEQ * 128;
    const __amdgpu_buffer_rsrc_t rkv = __builtin_amdgcn_make_buffer_rsrc((void*)KVb, 0, 0x7fffffff, 0x00020000);
    const unsigned klane0 = 16u * ((lane & 7) ^ (lane >> 4)), klane1 = 16u * ((lane & 7) ^ (4 + (lane >> 4)));
    const unsigned vlane = 128u + 16u * ((lane & 7) ^ (2 * kb));
    const LAS unsigned char* kfr0 = KBUF + 128 * l15 + 16 * ((0 + kb) ^ ((l15 >> 1) & 7));
    const LAS unsigned char* kfr1 = KBUF + 128 * l15 + 16 * ((4 + kb) ^ ((l15 >> 1) & 7));
    unsigned ta0[2][4], ta1[2][4];
#pragma unroll
    for (int s2 = 0; s2 < 2; ++s2) { const int r0 = 32 * s2 + 4 * kb + qd, r1 = r0 + 16;
#pragma unroll
        for (int mt = 0; mt < 4; ++mt) {
            ta0[s2][mt] = vb_addr + 128 * r0 + 16 * ((2 * mt + (pp >> 1)) ^ (2 * ((r0 >> 1) & 3))) + 8 * (pp & 1);
            ta1[s2][mt] = vb_addr + 128 * r1 + 16 * ((2 * mt + (pp >> 1)) ^ (2 * ((r1 >> 1) & 3))) + 8 * (pp & 1); } }
    const LAS unsigned short* selw = (const LAS unsigned short*)(lds + SEL_OFF + (2 * wave) * 512);
#define DSA_SELP(g_) (selw + (((g_) >= nblk) ? 256 + 64 * ((g_) - nblk) : 64 * (g_)))
#define DSA_DMAK(sv) do { _Pragma("unroll") for (int i = 0; i < 8; ++i) __builtin_amdgcn_raw_ptr_buffer_load_lds(rkv, (LAS void*)(KBUF + 1024 * i), 16, (int)(sv[i] * 256u + ((i & 1) ? klane1 : klane0)), 0, 0, 0); } while (0)
#define DSA_DMAV(sv) do { _Pragma("unroll") for (int i = 0; i < 8; ++i) __builtin_amdgcn_raw_ptr_buffer_load_lds(rkv, (LAS void*)(VBUF + 1024 * i), 16, (int)(sv[i] * 256u + vlane), 0, 0, 0); } while (0)
#define DSA_LOADQ(qx, qi_) do { const size_t row_ = row0 + 2 * wave + (qi_); _Pragma("unroll") for (int ks = 0; ks < 2; ++ks) { u32x4 z = (u32x4){0u, 0u, 0u, 0u}; if (l15 < 8) z = *(const u32x4*)(Q + row_ * 512 + l15 * 64 + 32 * ks + 8 * kb); qx[ks] = as_bf16x8(z); } } while (0)
#pragma unroll 1
    for (int rep_ = 0; rep_ < ((MK_DSA_REP & 4) ? 2 : 1); ++rep_) {
        bf16x8 qf[2], qfn[2];
        f32x4 o[4];
#pragma unroll
        for (int mt = 0; mt < 4; ++mt) o[mt] = (f32x4){0.f, 0.f, 0.f, 0.f};
        float lsum = 0.f;
        const f32x4 negB4 = (f32x4){negB, negB, negB, negB};
        DSA_LOADQ(qf, 0); DSA_LOADQ(qfn, 1);
        unsigned sv[8];
        { const LAS unsigned short* sp_ = DSA_SELP(0);
#pragma unroll
          for (int i = 0; i < 8; ++i) sv[i] = sp_[8 * i + (lane >> 3)]; }
        DSA_DMAK(sv); DSA_DMAV(sv);
#pragma unroll 1
        for (int g = 0; g < ntot; ++g) {
            const int qi = (g >= nblk) ? 1 : 0, blk = g - qi * nblk;
            const bool more1 = g + 1 < ntot, qlast = (blk == nblk - 1);
            asm volatile("s_waitcnt vmcnt(8)" ::: "memory");
            bf16x8 kc[4][2];
#pragma unroll
            for (int t = 0; t < 4; ++t) { kc[t][0] = *(const LAS bf16x8*)(kfr0 + 2048 * t); kc[t][1] = *(const LAS bf16x8*)(kfr1 + 2048 * t); }
            if (more1) { const LAS unsigned short* sp_ = DSA_SELP(g + 1);
#pragma unroll
                for (int i = 0; i < 8; ++i) sv[i] = sp_[8 * i + (lane >> 3)]; }
            asm volatile("s_waitcnt lgkmcnt(0)" ::: "memory");
            if (more1) DSA_DMAK(sv);
            f32x4 s[4];
#pragma unroll
            for (int t = 0; t < 4; ++t) { f32x4 acc = negB4; acc = MFMA16(kc[t][0], qf[0], acc); acc = MFMA16(kc[t][1], qf[1], acc); s[t] = acc; }
            if (more1) asm volatile("s_waitcnt vmcnt(8)" ::: "memory"); else asm volatile("s_waitcnt vmcnt(0)" ::: "memory");
            s16x4 lo0[4], hi0[4], lo1[4], hi1[4];
            tr_issue_off<0>(ta0[0], ta1[0], lo0, hi0); tr_issue_off<0>(ta0[1], ta1[1], lo1, hi1);
#pragma unroll
            for (int t = 0; t < 4; ++t) { s[t].x = __builtin_amdgcn_exp2f(s[t].x); s[t].y = __builtin_amdgcn_exp2f(s[t].y); s[t].z = __builtin_amdgcn_exp2f(s[t].z); s[t].w = __builtin_amdgcn_exp2f(s[t].w); lsum += (s[t].x + s[t].y) + (s[t].z + s[t].w); }
            tr_wait16(lo0, hi0, lo1, hi1);
            if (more1) DSA_DMAV(sv);
            { const bf16x8 pf = as_bf16x8(pack8(s[0], s[1]));
#pragma unroll
              for (int mt = 0; mt < 4; ++mt) o[mt] = MFMA16(join8(lo0[mt], hi0[mt]), pf, o[mt]); }
            { const bf16x8 pf = as_bf16x8(pack8(s[2], s[3]));
#pragma unroll
              for (int mt = 0; mt < 4; ++mt) o[mt] = MFMA16(join8(lo1[mt], hi1[mt]), pf, o[mt]); }
            if (qlast) {
                float ls = lsum; ls += __shfl_xor(ls, 16); ls += __shfl_xor(ls, 32);
                const float inv = 1.f / ls;
                const size_t row = row0 + 2 * wave + qi;
                if (l15 < 8) {
#pragma unroll
                    for (int mt = 0; mt < 4; ++mt) *(u32x2*)(A2 + row * 1024 + l15 * 64 + 16 * mt + 4 * kb) = (u32x2){cvt_pk_bf16(o[mt].x * inv, o[mt].y * inv), cvt_pk_bf16(o[mt].z * inv, o[mt].w * inv)};
                }
#pragma unroll
                for (int mt = 0; mt < 4; ++mt) o[mt] = (f32x4){0.f, 0.f, 0.f, 0.f};
                lsum = 0.f; qf[0] = qfn[0]; qf[1] = qfn[1];
            }
        }
        asm volatile("s_waitcnt vmcnt(0)" ::: "memory");
    }
#undef DSA_SELP
#undef DSA_DMAK
#undef DSA_DMAV
#undef DSA_LOADQ
    }
    __syncthreads();
}

__device__ __forceinline__ unsigned off_b(unsigned row, unsigned ch) { return 256u * row + 16u * (ch ^ (((row & 3) << 2) | ((row >> 2) & 3))); }
__device__ __forceinline__ void xattn_wg(const Params& P, LAS unsigned char* lds, int layer, int wg, int wave, int lane) {
    const bf16_t* MKV = (const bf16_t*)(P.ws + WS_MEMKV) + (size_t)layer * MEMTOK * 1024; const bf16_t* QX = (const bf16_t*)(P.ws + WS_R + R_QX); bf16_t* OX = (bf16_t*)(P.ws + WS_R + R_OX);
    const float* MSS = (const float*)(P.ws + WS_MEMSS) + (size_t)layer * MEMTOK * 8; const float* QSS = (const float*)(P.ws + WS_QSS);
    const float* gkn = P.in[I_XKN] + layer * 128; const float* gqn = P.in[I_XQN] + layer * 128;
    const int tid = wave * 64 + lane, l15 = lane & 15, kb = lane >> 4, qd = l15 >> 2, pp = lane & 3;
    f32x4 negB4;
    { const float gq = wave_max(fmaxf(fabsf(gqn[lane]), fabsf(gqn[lane + 64]))), gk = wave_max(fmaxf(fabsf(gkn[lane]), fabsf(gkn[lane + 64])));
      const float nb = -fminf(40.f, 128.f * 0.08838834764831845f * 1.4426950408889634f * 1.002f * gq * gk); negB4 = (f32x4){nb, nb, nb, nb}; }
    LAS unsigned char* KI = lds; LAS unsigned char* VI = lds + 65536;
    const unsigned vi_addr = (unsigned)(uintptr_t)VI;
    const int bh = (2 * wg) >> 4, b = bh >> 2, head = bh & 3;
#pragma unroll
    for (int i = 0; i < 8; ++i) {
        const int id = tid + 512 * i, rw = id >> 4, ch = id & 15;
        const bf16_t* src = MKV + ((size_t)b * NMEM + rw) * 1024 + head * 128 + 8 * ch;
        const f32x2 kp = *(const f32x2*)(MSS + ((size_t)b * NMEM + rw) * 8 + head * 2);
        const float rk = rsqrtf((kp.x + kp.y) * (1.f / 128.f) + EPS);
        const f32x4 ga = *(const f32x4*)(gkn + 8 * ch) * rk, gb = *(const f32x4*)(gkn + 8 * ch + 4) * rk;
        const u32x4 kr = *(const u32x4*)src;
        *(LAS u32x4*)(KI + off_b(rw, ch)) = pack8((f32x4){bflo(kr.x), bfhi(kr.x), bflo(kr.y), bfhi(kr.y)} * ga, (f32x4){bflo(kr.z), bfhi(kr.z), bflo(kr.w), bfhi(kr.w)} * gb);
        *(LAS u32x4*)(VI + off_b(rw, ch)) = *(const u32x4*)(src + 512);
    }
    __syncthreads();
    unsigned kadr[4], vadr0[2][2][4], vadr1[2][2][4];
#pragma unroll
    for (int ks = 0; ks < 4; ++ks) kadr[ks] = off_b(l15, 4 * ks + kb);
#pragma unroll
    for (int s2 = 0; s2 < 2; ++s2) { const unsigned r0 = 32 * s2 + 4 * kb + qd, r1 = r0 + 16;
#pragma unroll
        for (int mq = 0; mq < 2; ++mq)
#pragma unroll
            for (int k = 0; k < 4; ++k) { const int mt = 4 * mq + k; vadr0[s2][mq][k] = vi_addr + off_b(r0, 2 * mt + (pp >> 1)) + 8 * (pp & 1); vadr1[s2][mq][k] = vi_addr + off_b(r1, 2 * mt + (pp >> 1)) + 8 * (pp & 1); } }
#define XA_ROW(gi_) ((size_t)b * SEQ + ((2 * wg + ((gi_) >> 1)) & 15) * 256 + 16 * (2 * wave + ((gi_) & 1)) + l15)
#define XA_LOADQ(gi_) do { const size_t r_ = XA_ROW(gi_); qp = *(const f32x2*)(QSS + r_ * 8 + head * 2); _Pragma("unroll") for (int ks = 0; ks < 4; ++ks) qr[ks] = *(const u32x4*)(QX + r_ * 512 + head * 128 + 32 * ks + 8 * kb); } while (0)
    u32x4 qr[4]; f32x2 qp;
    XA_LOADQ(0);
#pragma unroll 1
    for (int gi = 0; gi < 4; ++gi) {
        {
            const size_t r = XA_ROW(gi);
            bf16x8 qf[4];
            {
                const float rn = rsqrtf((qp.x + qp.y) * (1.f / 128.f) + EPS) * (0.08838834764831845f * 1.4426950408889634f);
#pragma unroll
                for (int ks = 0; ks < 4; ++ks) {
                    const f32x4 ga = *(const f32x4*)(gqn + 32 * ks + 8 * kb) * rn, gb = *(const f32x4*)(gqn + 32 * ks + 8 * kb + 4) * rn;
                    qf[ks] = as_bf16x8(pack8((f32x4){bflo(qr[ks].x), bfhi(qr[ks].x), bflo(qr[ks].y), bfhi(qr[ks].y)} * ga, (f32x4){bflo(qr[ks].z), bfhi(qr[ks].z), bflo(qr[ks].w), bfhi(qr[ks].w)} * gb));
                }
            }
            if (gi < 3) XA_LOADQ(gi + 1);
            f32x4 o[8];
#pragma unroll
            for (int mt = 0; mt < 8; ++mt) o[mt] = (f32x4){0.f, 0.f, 0.f, 0.f};
            float lsum = 0.f;
#pragma unroll
            for (int blk = 0; blk < 4; ++blk) {
                f32x4 s[4];
#pragma unroll
                for (int t = 0; t < 4; ++t) {
                    f32x4 acc = negB4;
#pragma unroll
                    for (int ks = 0; ks < 4; ++ks) { const bf16x8 a = *(const LAS bf16x8*)(KI + kadr[ks] + 256 * (64 * blk + 16 * t)); acc = MFMA16(a, qf[ks], acc); }
                    s[t] = acc;
                }
#pragma unroll
                for (int t = 0; t < 4; ++t) { s[t].x = __builtin_amdgcn_exp2f(s[t].x); s[t].y = __builtin_amdgcn_exp2f(s[t].y); s[t].z = __builtin_amdgcn_exp2f(s[t].z); s[t].w = __builtin_amdgcn_exp2f(s[t].w); lsum += (s[t].x + s[t].y) + (s[t].z + s[t].w); }
#pragma unroll
                for (int s2 = 0; s2 < 2; ++s2) {
                    const bf16x8 pf = as_bf16x8(pack8(s[2 * s2], s[2 * s2 + 1]));
#pragma unroll
                    for (int mq = 0; mq < 2; ++mq) {
                        s16x4 lo[4], hi[4];
                        if (blk == 0) tr_quad_off<256 * (0 + 0)>(vadr0[s2][mq], vadr1[s2][mq], lo, hi);
                        if (blk == 1) tr_quad_off<256 * 64>(vadr0[s2][mq], vadr1[s2][mq], lo, hi);
                        if (blk == 2) tr_quad_off<256 * 128>(vadr0[s2][mq], vadr1[s2][mq], lo, hi);
                        if (blk == 3) tr_quad_off<256 * 192>(vadr0[s2][mq], vadr1[s2][mq], lo, hi);
#pragma unroll
                        for (int k = 0; k < 4; ++k) o[4 * mq + k] = MFMA16(join8(lo[k], hi[k]), pf, o[4 * mq + k]);
                    }
                }
            }
            lsum += __shfl_xor(lsum, 16); lsum += __shfl_xor(lsum, 32);
            const float inv = 1.f / lsum;
#pragma unroll
            for (int mt = 0; mt < 8; ++mt) *(u32x2*)(OX + r * 512 + head * 128 + 16 * mt + 4 * kb) = (u32x2){cvt_pk_bf16(o[mt].x * inv, o[mt].y * inv), cvt_pk_bf16(o[mt].z * inv, o[mt].w * inv)};
        }
    }
#undef XA_ROW
#undef XA_LOADQ
    __syncthreads();
}

#ifndef MK_MASK
#define MK_MASK 0xFFFFF
#endif
#define MKON(n) (((MK_MASK) >> (n)) & 1)
#ifndef MK_DUP
#define MK_DUP 0
#endif
#ifndef MK_DMASK
#define MK_DMASK 15
#endif
#ifndef MK_HI
#define MK_HI (1 << 20)
#endif
#define NREP(n) ((((MK_DUP) >> (n)) & 1) ? 2 : 1)
constexpr int LAST_PHASE = 2 + 16 * 3 + 9;
__global__ void __launch_bounds__(NTHREADS, 2) __attribute__((target("no-packed-fp32-ops"))) mk_fwd(Params P) {
    extern __shared__ __attribute__((aligned(16))) unsigned char lds_raw[];
    LAS unsigned char* lds = (LAS unsigned char*)lds_raw;
    const int tid = threadIdx.x, lane = tid & 63, wave = __builtin_amdgcn_readfirstlane(tid >> 6);
    const int G = gridDim.x, bx = blockIdx.x;
    const int NGW = G * NWAVES; (void)lane; (void)wave;
    volatile LAS unsigned* MISC = (volatile LAS unsigned*)(lds + LDSCTL_OFF);
    if (tid < 64) MISC[tid] = 0u;
    __syncthreads();
    unsigned* ctl = (unsigned*)(P.ws + WS_CTL);
    XcdBarrier bar = xcd_barrier_post(ctl + CW_BAR, MISC + 8);
    const int lo = P.ph_lo, hi = P.ph_hi;
#define IN(k) (lo <= (k) && (k) < hi)
#define FRESH const int ftid = fresh_tid(), flane = ftid & 63, fwave = __builtin_amdgcn_readfirstlane(ftid >> 6), fgw = bx * NWAVES + fwave; (void)fgw; (void)flane
#define SEAM(k) do { if ((k) < LAST_PHASE && (k) + 1 < hi) xcd_barrier(bar); } while (0)
    unsigned char* ws = P.ws;
    bf16_t* wb = (bf16_t*)(ws + WS_W);
    bf16_t* XB = (bf16_t*)(ws + WS_XB); float* SSQ = (float*)(ws + WS_SSQ16);

    if (MKON(0) && IN(0)) { FRESH; _Pragma("unroll 1") for (int rep = 0; rep < NREP(0); ++rep) prologue(P, lds, fgw, NGW, fwave, flane); SEAM(0);
#ifdef MK_BAR2
        { const unsigned long long t0 = __builtin_amdgcn_s_memrealtime(); while (__builtin_amdgcn_s_memrealtime() - t0 < 20000ull) __builtin_amdgcn_s_sleep(8); } xcd_barrier(bar); xcd_barrier(bar);
#endif
    }
    if (MKON(1) && IN(1)) {
        pg8::Gemm g{(const bf16_t*)(ws + WS_MEMB), (const bf16_t*)((char*)wb + W_XKV), DM, DM, DM}; pg8::StaticOrder S; S.init(MEMTOK, 4096, G, bx);
        EpiHead128<1> E{nullptr, (const float*)(ws + WS_MEMRS), (bf16_t*)(ws + WS_MEMKV), (float*)(ws + WS_MEMSS), lds};
        _Pragma("unroll 1") for (int rep = 0; rep < NREP(1); ++rep) pg8::gemm_phase<false>(lds, g, S, E); SEAM(1);
    }
#pragma unroll 1
    for (int layer = 0; layer < 4; ++layer) {
        const int pb = 2 + 16 * layer, j = layer >> 1;
        if ((layer & 1) == 0) {
            if (MKON(2) && IN(pb + 0)) {
                pg8::Gemm g{XB, (const bf16_t*)((char*)wb + W_EIN + j * 3 * MiB), DM, DM, DM}; pg8::StaticOrder S; S.init(NTOK, 1536, G, bx);
#ifdef MK_PLAIN_G1
                EpiPlain E{(bf16_t*)(ws + WS_R), 1536};
#else
                EpiEvenIn E{SSQ, P.in[I_AQN] + j * 64, P.in[I_AKN] + j * 64, (bf16_t*)(ws + WS_R + R_Q), (bf16_t*)(ws + WS_R + R_KV), (bf16_t*)(ws + WS_R + R_IK), (bf16_t*)(ws + WS_R + R_IQ), (bf16_t*)(ws + WS_R + R_U), (float*)(ws + WS_R + R_IW), lds};
#endif
                #ifdef MK_NOALIGN_G1
                pg8::gemm_phase<false>(lds, g, S, E); SEAM(pb + 0);
#else
                _Pragma("unroll 1") for (int rep = 0; rep < NREP(2); ++rep) pg8::gemm_phase<false>(lds, g, S, E); SEAM(pb + 0);
#endif
            }
            if (MKON(3) && IN(pb + 1)) {
                FRESH;
                _Pragma("unroll 1") for (int rep = 0; rep < NREP(15); ++rep)
                for (int task = bx; task < 256; task += G) s5_unit(P, lds, j, task & 7, task >> 3, fwave, flane);
                float negB;
                { const float gq = wave_max(fabsf(P.in[I_AQN][j * 64 + flane])), gk = wave_max(fabsf(P.in[I_AKN][j * 64 + flane]));
                  negB = -fminf(40.f, 64.f * 0.125f * 1.4426950408889634f * 1.002f * gq * gk); negB = __builtin_bit_cast(float, __builtin_amdgcn_readfirstlane(__builtin_bit_cast(int, negB))); }
                _Pragma("unroll 1") for (int rep = 0; rep < NREP(3); ++rep)
                for (int w2 = bx; w2 < 256; w2 += G) {
                    const int b = w2 & 7, r = w2 >> 3;
#pragma unroll 1
                    for (int k = 0; k < 8; ++k) { const int cc = (k < 4) ? r : 63 - r; dsa_unit(P, lds, b, 64 * cc + 16 * (k & 3), 64 * (cc + 1), fwave, flane, negB); }
                }
                SEAM(pb + 1);
            }
            if (MKON(4) && IN(pb + 2)) {
                pg8::Gemm g{(const bf16_t*)(ws + WS_R + R_YG), (const bf16_t*)((char*)wb + W_GLU + j * (MiB / 2)), 512, 512, 512}; pg8::StaticOrder S; S.init(NTOK, 512, G, bx);
                EpiGlu E{(const bf16_t*)(ws + WS_R + R_YG), P.in[I_BGLU] + j * 512, (bf16_t*)(ws + WS_R + R_A2)};
                _Pragma("unroll 1") for (int rep = 0; rep < NREP(4); ++rep) pg8::gemm_phase<false>(lds, g, S, E); SEAM(pb + 2);
            }
            if (MKON(5) && IN(pb + 3)) {
                pg8::Gemm g{(const bf16_t*)(ws + WS_R + R_A2), (const bf16_t*)((char*)wb + W_EOUT + j * 2 * MiB), DM, DM, DM}; pg8::StaticOrder S; S.init(NTOK, DM, G, bx);
                EpiResidual E{nullptr, XB, SSQ, 1.f};
                _Pragma("unroll 1") for (int rep = 0; rep < 2 * NREP(5) - 1; ++rep) { E.sign = (rep == 1) ? -1.f : 1.f; pg8::gemm_phase<false>(lds, g, S, E); } SEAM(pb + 3);
            }
        } else {
            if (MKON(6) && IN(pb + 0)) {
                pg8::Gemm g{XB, (const bf16_t*)((char*)wb + W_OIN + j * 8 * MiB), DM, DM, DM}; pg8::StaticOrder S; S.init(NTOK, 4096, G, bx);
                EpiOddIn E{SSQ, P.in[I_OCONV_W] + (size_t)j * 3 * 1024, P.in[I_OCONV_B] + (size_t)j * 1024, (bf16_t*)(ws + WS_R + R_MIX), (float*)(ws + WS_HALO2 + HALO_OT), (float*)(ws + WS_HALO2 + HALO_OH), lds};
                _Pragma("unroll 1") for (int rep = 0; rep < NREP(6); ++rep) pg8::gemm_phase<true>(lds, g, S, E); SEAM(pb + 0);
            }
            if (MKON(7) && IN(pb + 1)) { FRESH; fixup_odd(P, j, bx * NTHREADS + ftid, G * NTHREADS); SEAM(pb + 1); }
            if (MKON(8) && IN(pb + 2)) {
                pg8::Gemm g{(const bf16_t*)(ws + WS_R + R_MIX), (const bf16_t*)((char*)wb + W_OOUT + j * 2 * MiB), DM, DM, DM}; pg8::StaticOrder S; S.init(NTOK, DM, G, bx);
                EpiResidual E{nullptr, XB, SSQ, 1.f};
                _Pragma("unroll 1") for (int rep = 0; rep < 2 * NREP(8) - 1; ++rep) { E.sign = (rep == 1) ? -1.f : 1.f; pg8::gemm_phase<false>(lds, g, S, E); } SEAM(pb + 2);
            }
        }
        if (MKON(9) && IN(pb + 4)) {
            pg8::Gemm g{XB, (const bf16_t*)((char*)wb + W_XQ + layer * MiB), DM, DM, DM}; pg8::StaticOrder S; S.init(NTOK, 512, G, bx);
            EpiHead128<0> E{SSQ, nullptr, (bf16_t*)(ws + WS_R + R_QX), (float*)(ws + WS_QSS), lds};
            _Pragma("unroll 1") for (int rep = 0; rep < NREP(9); ++rep) pg8::gemm_phase<false>(lds, g, S, E); SEAM(pb + 4);
        }
        if (MKON(10) && IN(pb + 5)) { FRESH; _Pragma("unroll 1") for (int rep = 0; rep < NREP(10); ++rep) for (int w2 = bx; w2 < 256; w2 += G) xattn_wg(P, lds, layer, w2, fwave, flane); SEAM(pb + 5); }
        if (MKON(11) && IN(pb + 6)) {
            pg8::Gemm g{(const bf16_t*)(ws + WS_R + R_OX), (const bf16_t*)((char*)wb + W_XO + layer * MiB), 512, 512, 512}; pg8::StaticOrder S; S.init(NTOK, DM, G, bx);
            EpiResidual E{nullptr, XB, SSQ, 1.f};
            _Pragma("unroll 1") for (int rep = 0; rep < 2 * NREP(11) - 1; ++rep) { E.sign = (rep == 1) ? -1.f : 1.f; pg8::gemm_phase<false>(lds, g, S, E); } SEAM(pb + 6);
        }
        if (MKON(12) && IN(pb + 7)) {
            pg8::Gemm g{XB, (const bf16_t*)((char*)wb + W_UP + layer * 11 * MiB), DM, DM, DM}; pg8::StaticOrder S; S.init(NTOK, 2 * DFF, G, bx);
            EpiFfnUp E{SSQ, P.in[I_FCONV_W] + (size_t)layer * 3 * DFF, P.in[I_FCONV_B] + (size_t)layer * DFF, (bf16_t*)(ws + WS_R + R_ACT), (float*)(ws + WS_HALO2 + HALO_FT), (float*)(ws + WS_HALO2 + HALO_FH), lds};
            _Pragma("unroll 1") for (int rep = 0; rep < NREP(12); ++rep) pg8::gemm_phase<MK_ALIGN6>(lds, g, S, E);
#ifdef MK_NULL6
            { EpiNull EN; pg8::gemm_phase<false>(lds, g, S, EN); }
#endif
            SEAM(pb + 7);
        }
        if (MKON(13) && IN(pb + 8)) { FRESH; fixup_ffn(P, layer, bx * NTHREADS + ftid, G * NTHREADS); SEAM(pb + 8); }
        if (MKON(14) && IN(pb + 9)) {
            pg8::Gemm g{(const bf16_t*)(ws + WS_R + R_ACT), (const bf16_t*)((char*)wb + W_DN + layer * (11 * MiB / 2)), DFF, DFF, DFF}; pg8::StaticOrder S; S.init(NTOK, DM, G, bx);
            EpiResidual E{layer == 3 ? P.out : nullptr, XB, SSQ, 1.f};
            _Pragma("unroll 1") for (int rep = 0; rep < 2 * NREP(14) - 1; ++rep) { E.sign = (rep == 1) ? -1.f : 1.f; pg8::gemm_phase<false>(lds, g, S, E); } SEAM(pb + 9);
        }
    }
#ifdef MK_DUMP
    {
        xcd_barrier(bar);
        const bf16_t* s0; const bf16_t* s1; const bf16_t* s2; const bf16_t* s3; int n0, n1, n2, n3;
#if MK_DUMP == 1
        s0 = (const bf16_t*)(ws + WS_R + R_A2); n0 = 1024; s1 = s0; n1 = 0; s2 = s0; n2 = 0; s3 = s0; n3 = 0;
#elif MK_DUMP == 2
        s0 = (const bf16_t*)(ws + WS_R + R_YG); n0 = 512; s1 = (const bf16_t*)(ws + WS_R + R_U); n1 = 512; s2 = s0; n2 = 0; s3 = s0; n3 = 0;
#elif MK_DUMP == 8
        s0 = (const bf16_t*)(ws + WS_R + R_QX); n0 = 512; s1 = (const bf16_t*)(ws + WS_R + R_OX); n1 = 512; s2 = s0; n2 = 0; s3 = s0; n3 = 0;
#elif MK_DUMP == 4 || MK_DUMP == 6 || MK_DUMP == 7
        s0 = (const bf16_t*)(ws + WS_XB); n0 = 1024; s1 = s0; n1 = 0; s2 = s0; n2 = 0; s3 = s0; n3 = 0;
#else
        s0 = (const bf16_t*)(ws + WS_R + R_Q); n0 = 512; s1 = (const bf16_t*)(ws + WS_R + R_IQ); n1 = 256; s2 = (const bf16_t*)(ws + WS_R + R_KV); n2 = 128; s3 = (const bf16_t*)(ws + WS_R + R_IK); n3 = 64;
#endif
        for (size_t idx = (size_t)bx * NTHREADS + threadIdx.x; idx < (size_t)NTOK * 1024; idx += (size_t)G * NTHREADS) {
            const size_t row = idx >> 10; int c = (int)(idx & 1023); float v = 0.f;
            if (c < n0) { if (MK_DMASK & 1) v = bf2f(s0[row * n0 + c]); } else { c -= n0; if (c < n1) { if (MK_DMASK & 2) v = bf2f(s1[row * n1 + c]); } else { c -= n1; if (c < n2) { if (MK_DMASK & 4) v = bf2f(s2[row * n2 + c]); } else { c -= n2; if (c < n3) { if (MK_DMASK & 8) v = bf2f(s3[row * n3 + c]); } } } }
#ifdef MK_KEEP
            if (!(MK_KEEP)) v = 0.f;
#endif
#if MK_DUMP == 7
            v = bf2f(((const bf16_t*)(ws + WS_R))[row * 1536 + (idx & 1023)]);
#endif
#if MK_DUMP == 6
            if (row < 8192) v = bf2f(((const bf16_t*)(ws + WS_MEMKV))[row * 1024 + (idx & 1023)]);
#endif
#if MK_DUMP == 4
            if (row < 1536) v = bf2f(((const bf16_t*)((char*)wb + W_EIN))[row * 1024 + (idx & 1023)]);
            else if (row < 1536 + 8192) v = SSQ[(row - 1536) * 64 + (idx & 63)];
#endif
            P.out[idx] = v;
        }
    }
#endif
#undef IN
#undef SEAM
}

extern "C" void kernel_launch(void* const* d_in, const int* in_sizes, int n_in, void* d_out, int out_size, void* d_ws, size_t ws_size, hipStream_t stream) {
    static int grid = 0;
    if (grid == 0) {
        if (n_in != 33 || out_size != NTOK * DM || ws_size < WS_END) { fprintf(stderr, "kernel_launch: unexpected problem (n_in %d out %d ws %zu)\n", n_in, out_size, ws_size); grid = -1; return; }
        int dev = 0, cus = 0, per_cu = 0;
        if (hipGetDevice(&dev) != hipSuccess || hipDeviceGetAttribute(&cus, hipDeviceAttributeMultiprocessorCount, dev) != hipSuccess) { grid = -1; return; }
        if (hipFuncSetAttribute((const void*)mk_fwd, hipFuncAttributeMaxDynamicSharedMemorySize, LDS_BYTES) != hipSuccess) { fprintf(stderr, "kernel_launch: hipFuncSetAttribute failed\n"); grid = -1; return; }
        if (hipOccupancyMaxActiveBlocksPerMultiprocessor(&per_cu, (const void*)mk_fwd, NTHREADS, LDS_BYTES) != hipSuccess || per_cu < 1) { fprintf(stderr, "kernel_launch: occupancy query reports %d\n", per_cu); }
        (void)hipGetLastError();
        grid = cus < 256 ? cus : 256;
    }
    if (grid < 0) return;
    (void)hipMemsetAsync((char*)d_ws + WS_CTL, 0, CTL_ZERO_BYTES, stream);
    Params p{};
    for (int i = 0; i < 33; ++i) p.in[i] = (const float*)d_in[i];
    p.out = (float*)d_out; p.ws = (unsigned char*)d_ws;
#ifdef MK_PER_PHASE
    for (int ph = 0; ph <= LAST_PHASE; ++ph) { p.ph_lo = ph; p.ph_hi = ph + 1; hipLaunchKernelGGL(mk_fwd, dim3(grid), dim3(NTHREADS), LDS_BYTES, stream, p); }
#else
    p.ph_lo = 0; p.ph_hi = MK_HI;
    hipLaunchKernelGGL(mk_fwd, dim3(grid), dim3(NTHREADS), LDS_BYTES, stream, p);
#endif
}
```

```cpp
#include <hip/hip_runtime.h>
#include <cstdio>
#include <cstdint>

#define LAS __attribute__((address_space(3)))
#ifndef MK_ALIGN6
#define MK_ALIGN6 true
#endif
#ifndef MK_DSA_REP
#define MK_DSA_REP 0
#endif
#ifndef MK_SSQ_AUX
#define MK_SSQ_AUX 0
#endif
#ifndef MK_SSQ_ST_AUX
#define MK_SSQ_ST_AUX 0
#endif
typedef unsigned short bf16_t;
typedef short bf16x8 __attribute__((ext_vector_type(8)));
typedef short s16x4 __attribute__((ext_vector_type(4)));
typedef float f32x4 __attribute__((ext_vector_type(4)));
typedef float f32x2 __attribute__((ext_vector_type(2)));
typedef unsigned u32x4 __attribute__((ext_vector_type(4)));
typedef unsigned u32x2 __attribute__((ext_vector_type(2)));

constexpr int DM = 1024, NBATCH = 8, SEQ = 4096, NTOK = NBATCH * SEQ, NMEM = 256, MEMTOK = NBATCH * NMEM, DFF = 2816;
constexpr float EPS = 1e-6f;
constexpr int NWAVES = 8, NTHREADS = 512;

constexpr size_t MiB = 1u << 20;
constexpr size_t WS_CTL = 0, CTL_ZERO_BYTES = 65536;
constexpr size_t WS_W = 1 * MiB;
constexpr size_t W_EIN = 0, W_EOUT = 6 * MiB, W_GLU = 10 * MiB, W_OIN = 11 * MiB, W_OOUT = 27 * MiB, W_XQ = 31 * MiB, W_XKV = 35 * MiB, W_XO = 43 * MiB, W_UP = 47 * MiB, W_DN = 91 * MiB;
constexpr size_t WS_XB = 115 * MiB, WS_SSQ = 179 * MiB, WS_MEMB = 180 * MiB, WS_MEMRS = 184 * MiB, WS_MEMKV = 185 * MiB, WS_S5OP = 201 * MiB, WS_HALO = 211 * MiB, WS_R = 224 * MiB, WS_SSQ16 = 416 * MiB, WS_QSS = 418 * MiB, WS_MEMSS = 419 * MiB, WS_HALO2 = 420 * MiB, WS_END = 468 * MiB;
constexpr size_t S5OP_STRIDE = 160 * 1024, S5OP_PM = 16 * 1024, S5OP_QM = 80 * 1024, S5OP_A16 = 144 * 1024;
constexpr size_t HALO_FT = 0, HALO_FH = 12 * MiB, HALO_OT = 36 * MiB, HALO_OH = 40 * MiB;
constexpr size_t R_ACT = 0, R_Q = 0, R_KV = 32 * MiB, R_IK = 40 * MiB, R_IQ = 44 * MiB, R_IW = 60 * MiB, R_U = 61 * MiB, R_A2 = 93 * MiB, R_YG = 157 * MiB, R_MIX = 0, R_QX = 0, R_OX = 32 * MiB;
constexpr int CW_BAR = 4096;

constexpr int RING_BYTES = 131072, EPI_OFF = 131072, LDS_BYTES = 163840, LDSCTL_OFF = 143360;

__device__ __forceinline__ unsigned f2bf(float f) { unsigned u = __builtin_bit_cast(unsigned, f); return (u + 0x7fffu + ((u >> 16) & 1u)) >> 16; }
__device__ __forceinline__ unsigned pk2(float lo, float hi) { return f2bf(lo) | (f2bf(hi) << 16); }
__device__ __forceinline__ unsigned cvt_pk_bf16(float lo, float hi) { unsigned r; asm volatile("v_cvt_pk_bf16_f32 %0, %1, %2" : "=v"(r) : "v"(lo), "v"(hi)); return r; }
__device__ __forceinline__ float bf2f(unsigned short b) { return __builtin_bit_cast(float, (unsigned)b << 16); }
__device__ __forceinline__ float bflo(unsigned w) { return __builtin_bit_cast(float, w << 16); }
__device__ __forceinline__ float bfhi(unsigned w) { return __builtin_bit_cast(float, w & 0xffff0000u); }
__device__ __forceinline__ int fresh_tid() { int t = threadIdx.x; asm volatile("" : "+v"(t)); return t; }
#define LDS_WAIT() asm volatile("s_waitcnt lgkmcnt(0)" ::: "memory")
#define VM_WAIT() asm volatile("s_waitcnt vmcnt(0)" ::: "memory")
__device__ __forceinline__ float wave_sum(float v) {
#pragma unroll
    for (int o = 1; o < 64; o <<= 1) v += __shfl_xor(v, o);
    return v;
}
__device__ __forceinline__ float wave_max(float v) {
#pragma unroll
    for (int o = 1; o < 64; o <<= 1) v = fmaxf(v, __shfl_xor(v, o));
    return v;
}
__device__ __forceinline__ int wave_sum_i(int v) {
#pragma unroll
    for (int o = 1; o < 64; o <<= 1) v += __shfl_xor(v, o);
    return v;
}
__device__ __forceinline__ float silu_f(float x) { return x * __builtin_amdgcn_rcpf(1.f + __expf(-x)); }
__device__ __forceinline__ float sigmoid_f(float x) { return __builtin_amdgcn_rcpf(1.f + __expf(-x)); }
__device__ __forceinline__ float gelu_tanh_f(float y) { const float a = 0.7978845608f * (y + 0.044715f * y * y * y); const float t = 1.f - 2.f * __builtin_amdgcn_rcpf(__expf(2.f * a) + 1.f); return 0.5f * y * (1.f + t); }
__device__ __forceinline__ float rs_from_ssq(const float* ssq, int row) { const f32x4 s = *(const f32x4*)(ssq + 4 * (size_t)row); return rsqrtf(((s.x + s.y) + (s.z + s.w)) * (1.f / DM) + EPS); }
__device__ __forceinline__ bf16x8 as_bf16x8(u32x4 v) { return __builtin_bit_cast(bf16x8, v); }

namespace pg8 {
constexpr int BM = 256, BK = 64, HALF = 128, HTB = HALF * BK * 2, STAGE_BYTES = 8 * HTB, NXCD = 8, WGM = 8;
__host__ __device__ __forceinline__ int lds_byte(int r, int c) { const int st = (r >> 4) * 2 + (c >> 5), rr = r & 15, cc = c & 31, ob = rr * 64 + cc * 2; return st * 1024 + (ob ^ (((ob >> 9) & 1) << 5)); }
__host__ __device__ __forceinline__ void stage_rc(int b, int& R, int& C) { const int st = b / 1024, sb = b % 1024, swz = sb ^ (((sb >> 9) & 1) << 5); R = (st >> 1) * 16 + swz / 64; C = (st & 1) * 32 + (swz % 64) / 2; }
struct Unit { int pm, pn; };
struct Gemm { const bf16_t* A; const bf16_t* Bt; int lda, ldb, K; };
struct StaticOrder {
    int nM, nN, nwg, G, c;
    __device__ __forceinline__ void init(int M, int N, int G_, int c_) { nM = M / BM; nN = N / BM; nwg = nM * nN; G = G_; c = c_; }
    __device__ __forceinline__ bool next(int i, Unit& u) const {
        const long L = (long)i * G + c; if (L >= nwg) return false;
        int wgid = (int)L; { const int q = nwg / NXCD, r = nwg % NXCD, xcd = wgid % NXCD, off = wgid / NXCD; wgid = (xcd < r ? xcd * (q + 1) : r * (q + 1) + (xcd - r) * q) + off; }
        const int nig = WGM * nN, gid = wgid / nig, fm = gid * WGM, gsz = (nM - fm) < WGM ? (nM - fm) : WGM;
        u.pm = fm + ((wgid % nig) % gsz); u.pn = (wgid % nig) / gsz; return true;
    }
};
template <bool ALIGN_EPI = false, class Epi>
__device__ __forceinline__ void gemm_phase(LAS unsigned char* lds, const Gemm g, const StaticOrder& S, const Epi& E) {
    const int tid = fresh_tid(), wid = __builtin_amdgcn_readfirstlane(tid >> 6), lane = tid & 63, wr = wid >> 2, wc = wid & 3, fr = lane & 15, fq = lane >> 4;
    const int K = g.K, nt = K / BK;
    unsigned voffA[2], voffB[2];
#pragma unroll
    for (int i = 0; i < 2; ++i) { int R, C; stage_rc(tid * 16 + i * 8192, R, C); voffA[i] = (unsigned)(R * g.lda + C) * 2u; voffB[i] = (unsigned)(R * g.ldb + C) * 2u; }
    const size_t kstep = (size_t)(BK * 2);
    const size_t hstepA = (size_t)HALF * g.lda * 2, hstepB = (size_t)HALF * g.ldb * 2, tstepA = 2 * hstepA, tstepB = 2 * hstepB;
    const unsigned ldsw = (unsigned)wid * 1024u;
    const int aoff = lds_byte(wr * 64 + fr, fq * 8), boff = lds_byte(wc * 32 + fr, fq * 8);
#define PG8_SA(b, h) (((b) * 2 + (h)) * HTB)
#define PG8_SB(b, h) ((4 + (b) * 2 + (h)) * HTB)
#define PG8_STAGE(bufoff, gbase, voff) do { _Pragma("unroll") for (int _i = 0; _i < 2; ++_i) \
        __builtin_amdgcn_global_load_lds((const unsigned*)((const char*)(gbase) + (voff)[_i]), (LAS unsigned*)(lds + (bufoff) + ldsw + _i * 8192), 16, 0, 0); } while (0)
#define PG8_LDA(dst, b, h) do { _Pragma("unroll") for (int m = 0; m < 4; ++m) _Pragma("unroll") for (int k = 0; k < 2; ++k) dst[m][k] = *(const LAS bf16x8*)(lds + PG8_SA(b, h) + aoff + m * 2048 + k * 1024); } while (0)
#define PG8_LDB(dst, b, h) do { _Pragma("unroll") for (int n = 0; n < 2; ++n) _Pragma("unroll") for (int k = 0; k < 2; ++k) dst[n][k] = *(const LAS bf16x8*)(lds + PG8_SB(b, h) + boff + n * 2048 + k * 1024); } while (0)
#define PG8_MMA(ai, bj, At, Bt) do { __builtin_amdgcn_s_setprio(1); _Pragma("unroll") for (int m = 0; m < 4; ++m) _Pragma("unroll") for (int n = 0; n < 2; ++n) _Pragma("unroll") for (int k = 0; k < 2; ++k) \
        acc[ai][bj][m][n] = __builtin_amdgcn_mfma_f32_16x16x32_bf16(Bt[n][k], At[m][k], acc[ai][bj][m][n], 0, 0, 0); __builtin_amdgcn_s_setprio(0); } while (0)
#define PG8_WAIT_V(n) asm volatile("s_waitcnt vmcnt(" #n ")" ::: "memory")
#define PG8_WAIT_L(n) asm volatile("s_waitcnt lgkmcnt(" #n ")" ::: "memory")
#define PG8_BAR __builtin_amdgcn_s_barrier()
#define PG8_SCHED __builtin_amdgcn_sched_barrier(0)
    Unit cur, nxt; int ui = 0;
    if (!S.next(0, cur)) return;
    f32x4 acc[2][2][4][2];
#pragma unroll
    for (int a = 0; a < 2; ++a)
#pragma unroll
        for (int b = 0; b < 2; ++b)
#pragma unroll
            for (int m = 0; m < 4; ++m)
#pragma unroll
                for (int n = 0; n < 2; ++n) acc[a][b][m][n] = (f32x4){0.f, 0.f, 0.f, 0.f};
    bf16x8 At[4][2], B0[2][2], B1[2][2];
    const char* cA = (const char*)g.A + (size_t)cur.pm * tstepA; const char* cB = (const char*)g.Bt + (size_t)cur.pn * tstepB;
    PG8_STAGE(PG8_SB(0, 0), cB, voffB); PG8_STAGE(PG8_SB(0, 1), cB + hstepB, voffB); PG8_STAGE(PG8_SA(0, 0), cA, voffA); PG8_STAGE(PG8_SA(0, 1), cA + hstepA, voffA);
    if (wr == 1) PG8_BAR;
    PG8_WAIT_V(2); PG8_BAR;
    PG8_STAGE(PG8_SB(1, 0), cB + kstep, voffB); PG8_STAGE(PG8_SA(1, 0), cA + kstep, voffA); PG8_STAGE(PG8_SB(1, 1), cB + hstepB + kstep, voffB);
    PG8_WAIT_V(6); PG8_BAR;
    for (;;) {
        const bool has_next = S.next(ui + 1, nxt);
        const char* nA = has_next ? (const char*)g.A + (size_t)nxt.pm * tstepA : cA; const char* nB = has_next ? (const char*)g.Bt + (size_t)nxt.pn * tstepB : cB;
        for (int t = 0; t < nt; t += 2) {
            const bool last = (t == nt - 2);
            const char* a1 = cA + (size_t)(t + 1) * kstep;
            const char* a2 = last ? nA : cA + (size_t)(t + 2) * kstep; const char* b2 = last ? nB : cB + (size_t)(t + 2) * kstep;
            const char* a3 = a2 + kstep; const char* b3 = b2 + kstep;
            PG8_LDB(B0, 0, 0); PG8_LDB(B1, 0, 1); PG8_SCHED; PG8_LDA(At, 0, 0); PG8_STAGE(PG8_SA(1, 1), a1 + hstepA, voffA);
            PG8_WAIT_V(8); PG8_WAIT_L(0); PG8_BAR; PG8_MMA(0, 0, At, B0); PG8_MMA(0, 1, At, B1); PG8_BAR; PG8_SCHED;
            PG8_LDA(At, 0, 1); PG8_STAGE(PG8_SB(0, 0), b2, voffB); PG8_STAGE(PG8_SB(0, 1), b2 + hstepB, voffB); PG8_STAGE(PG8_SA(0, 0), a2, voffA);
            PG8_WAIT_V(8); PG8_WAIT_L(0); PG8_BAR; PG8_MMA(1, 0, At, B0); PG8_MMA(1, 1, At, B1); PG8_BAR; PG8_SCHED;
            PG8_LDB(B0, 1, 0); PG8_LDB(B1, 1, 1); PG8_SCHED; PG8_LDA(At, 1, 0); PG8_STAGE(PG8_SA(0, 1), a2 + hstepA, voffA);
            PG8_WAIT_V(8); PG8_WAIT_L(0); PG8_BAR; PG8_MMA(0, 0, At, B0); PG8_MMA(0, 1, At, B1); PG8_BAR; PG8_SCHED;
            PG8_LDA(At, 1, 1); PG8_STAGE(PG8_SB(1, 0), b3, voffB); PG8_STAGE(PG8_SB(1, 1), b3 + hstepB, voffB); PG8_STAGE(PG8_SA(1, 0), a3, voffA);
            PG8_WAIT_V(8); PG8_WAIT_L(0); PG8_BAR; PG8_MMA(1, 0, At, B0); PG8_MMA(1, 1, At, B1); PG8_BAR; PG8_SCHED;
        }
        if constexpr (ALIGN_EPI) { if (wr == 0) PG8_BAR; }
#ifdef MK_FENCE_EPI
        PG8_SCHED; asm volatile("s_waitcnt vmcnt(0) lgkmcnt(0)\n\ts_nop 15" ::: "memory"); PG8_SCHED;
#endif
        E(acc, cur, wr, wc, fr, fq);
#ifdef MK_FENCE_EPI
        PG8_SCHED; asm volatile("s_waitcnt vmcnt(0) lgkmcnt(0)\n\ts_nop 15" ::: "memory"); PG8_SCHED;
#endif
        if (!has_next) break;
#pragma unroll
        for (int a = 0; a < 2; ++a)
#pragma unroll
            for (int b = 0; b < 2; ++b)
#pragma unroll
                for (int m = 0; m < 4; ++m)
#pragma unroll
                    for (int n = 0; n < 2; ++n) acc[a][b][m][n] = (f32x4){0.f, 0.f, 0.f, 0.f};
        cur = nxt; cA = nA; cB = nB; ++ui;
        if constexpr (ALIGN_EPI) { if (wr == 1) PG8_BAR; }
    }
    PG8_WAIT_V(0);
    if constexpr (!ALIGN_EPI) { if (wr == 0) PG8_BAR; }
    PG8_BAR;
#undef PG8_SA
#undef PG8_SB
#undef PG8_STAGE
#undef PG8_LDA
#undef PG8_LDB
#undef PG8_MMA
#undef PG8_WAIT_V
#undef PG8_WAIT_L
#undef PG8_SCHED
}
}
#define WG_BAR() do { asm volatile("s_waitcnt lgkmcnt(0)" ::: "memory"); __builtin_amdgcn_s_barrier(); asm volatile("" ::: "memory"); } while (0)

#define XB_TMO      128
#define XB_XCNT(j)  (256  + 64 * (j))
#define XB_XSUB(j)  (1280 + 64 * (j))
#define XB_XGEN(j)  (2304 + 64 * (j))
#define XB_TOP      3328
#define XB_TOPGEN   3392
#define XCD_BAR_WORDS 3456
#define XB_SPIN_CAP (1u << 18)
__device__ __forceinline__ unsigned xb_ld(unsigned* p)              { return __hip_atomic_load(p, __ATOMIC_RELAXED, __HIP_MEMORY_SCOPE_AGENT); }
__device__ __forceinline__ unsigned xb_add(unsigned* p, unsigned v) { return __hip_atomic_fetch_add(p, v, __ATOMIC_RELAXED, __HIP_MEMORY_SCOPE_AGENT); }
__device__ __forceinline__ unsigned xb_xcc_id() { return (unsigned)__builtin_amdgcn_s_getreg((3 << 11) | 20) & 0xFu; }
#define XB_SPIN(cond, bar) do { unsigned _sp = 0; while (cond) { __builtin_amdgcn_s_sleep(1); \
    if ((++_sp & 255u) == 0u) { if (xb_ld(&(bar)[XB_TMO])) break; if (_sp > XB_SPIN_CAP) { atomicAdd(&(bar)[XB_TMO], 1u); break; } } } } while (0)
struct XcdBarrier { unsigned* bar; unsigned x; volatile LAS unsigned* st; };
__device__ __forceinline__ XcdBarrier xcd_barrier_post(unsigned* bar, volatile LAS unsigned* st) {
    XcdBarrier b; b.bar = bar; b.x = xb_xcc_id(); b.st = st;
    if (threadIdx.x == 0) (void)xb_add(&bar[XB_XCNT(b.x)], 1u);
    return b;
}
__device__ __forceinline__ void xcd_barrier_complete(unsigned* bar, unsigned x, unsigned& nloc, unsigned& nx) {
    const unsigned G = gridDim.x * gridDim.y * gridDim.z;
    unsigned sum, cnt, mine, sp = 0u;
    for (;;) {
        sum = 0u; cnt = 0u; mine = 0u;
#pragma unroll
        for (unsigned j = 0; j < 16; ++j) { const unsigned c = xb_ld(&bar[XB_XCNT(j)]); sum += c; cnt += (c > 0u) ? 1u : 0u; mine = (j == x) ? c : mine; }
        if (sum == G) break;
        __builtin_amdgcn_s_sleep(1);
        if ((++sp & 255u) == 0u) { if (xb_ld(&bar[XB_TMO])) break; if (sp > XB_SPIN_CAP) { atomicAdd(&bar[XB_TMO], 1u); break; } }
    }
    nloc = mine > 0u ? mine : 1u; nx = cnt > 0u ? cnt : 1u;
}
__device__ __forceinline__ void xcd_barrier(const XcdBarrier& b) {
    asm volatile("s_waitcnt vmcnt(0)" ::: "memory");
    __syncthreads();
    if (threadIdx.x == 0) {
        unsigned* bar = b.bar;
        __builtin_amdgcn_s_waitcnt(0);
        unsigned nloc = b.st[0], nx = b.st[1];
        if (nloc == 0u) { xcd_barrier_complete(bar, b.x, nloc, nx); b.st[0] = nloc; b.st[1] = nx; }
        const unsigned old = xb_add(&bar[XB_XSUB(b.x)], 1u);
        const unsigned gen = old / nloc;
        if (old + 1u == (gen + 1u) * nloc) {
            __builtin_amdgcn_fence(__ATOMIC_RELEASE, "agent");
            asm volatile("s_waitcnt vmcnt(0)" ::: "memory");
            const unsigned og = xb_add(&bar[XB_TOP], 1u);
            const unsigned tg = og / nx;
            if (og + 1u == (tg + 1u) * nx) xb_add(&bar[XB_TOPGEN], 1u);
            else XB_SPIN(xb_ld(&bar[XB_TOPGEN]) == tg, bar);
            __builtin_amdgcn_fence(__ATOMIC_ACQUIRE, "agent");
            xb_add(&bar[XB_XGEN(b.x)], 1u);
            asm volatile("s_waitcnt vmcnt(0)" ::: "memory");
        } else {
            XB_SPIN(xb_ld(&bar[XB_XGEN(b.x)]) == gen, bar);
            __builtin_amdgcn_fence(__ATOMIC_ACQUIRE, "agent");
            asm volatile("s_waitcnt vmcnt(0)" ::: "memory");
        }
    }
    __syncthreads();
}

enum MapId { MAP_STD = 0, MAP_EVEN_IN = 1, MAP_XQ = 2, MAP_XKV = 3, MAP_FFN_UP = 4, MAP_ODD_IN = 5 };
__device__ __forceinline__ int colmap(int mapid, int n) {
    const int pn = n >> 8, s = n & 255, bj = s >> 7, wc = (s >> 5) & 3, nn = (s >> 4) & 1, fq = (s >> 2) & 3, i = s & 3;
    const int d32 = 8 * fq + 4 * nn + i, hd = 32 * bj + d32;
    switch (mapid) {
    case MAP_STD: return 256 * pn + 128 * bj + 32 * wc + d32;
    case MAP_EVEN_IN:
        if (pn <= 1) return (4 * pn + wc) * 64 + hd;
        if (pn == 2) { if (wc == 0) return 512 + hd; if (wc == 1) return 576 + hd; if (wc == 2) return 896 + hd; return hd < 4 ? 960 + hd : -1; }
        if (pn == 3) return 640 + wc * 64 + hd;
        return 964 + 256 * (pn - 4) + 128 * bj + 32 * wc + d32;
    case MAP_XQ: return (2 * pn + (wc >> 1)) * 128 + 64 * (wc & 1) + hd;
    case MAP_XKV:
        if (pn <= 1) return (2 * pn + (wc >> 1)) * 128 + 64 * (wc & 1) + hd;
        return 512 + 256 * (pn - 2) + 128 * bj + 32 * wc + d32;
    case MAP_FFN_UP: { const int ch = 128 * pn + 32 * wc + d32; return bj ? DFF + ch : ch; }
    default: { const int ch = 64 * pn + 16 * wc + 4 * fq + i, q = 2 * bj + nn; return q == 3 ? -1 : q * 1024 + ch; }
    }
}
struct PrepJob { const float* W; const float* gain; bf16_t* dst; int K, N, npad, mapid; };
__device__ __forceinline__ void prep_item(const PrepJob& J, LAS float* scr, int item, int lane) {
    const int nblk = J.npad / 32, kb = item / nblk, nb = item % nblk, k0 = 64 * kb, n0 = 32 * nb;
    const int col = colmap(J.mapid, n0 + (lane & 31));
    float wv[32];
#pragma unroll
    for (int i = 0; i < 32; ++i) { const int kk = 2 * i + (lane >> 5); wv[i] = (col >= 0) ? J.W[(size_t)(k0 + kk) * J.N + col] : 0.f; }
#pragma unroll
    for (int i = 0; i < 32; ++i) { const int kk = 2 * i + (lane >> 5); float v = wv[i]; if (J.gain) v *= J.gain[k0 + kk]; scr[kk * 33 + (lane & 31)] = v; }
    LDS_WAIT();
    const int c = lane & 7;
#pragma unroll
    for (int j = 0; j < 4; ++j) { const int n = (lane >> 3) + 8 * j; const LAS float* s = scr + (8 * c) * 33 + n;
        u32x4 o; o.x = pk2(s[0 * 33], s[1 * 33]); o.y = pk2(s[2 * 33], s[3 * 33]); o.z = pk2(s[4 * 33], s[5 * 33]); o.w = pk2(s[6 * 33], s[7 * 33]);
        *(u32x4*)(J.dst + (size_t)(n0 + n) * J.K + k0 + 8 * c) = o; }
    LDS_WAIT();
}

struct Params { const float* in[33]; float* out; unsigned char* ws; int ph_lo, ph_hi; };
enum InIdx { I_X = 0, I_MEM, I_NORM_MIX, I_NORM_X, I_NORM_MEM, I_NORM_FFN, I_EW_IN, I_EW_OUT, I_AQN, I_AKN, I_LAM_RE, I_LAM_IM, I_LOGSTEP, I_B_RE, I_B_IM, I_C_RE, I_C_IM, I_S5D, I_WGLU, I_BGLU,
             I_OW_IN, I_OCONV_W, I_OCONV_B, I_OW_OUT, I_XWQ, I_XWKV, I_XWO, I_XQN, I_XKN, I_FWUP, I_FCONV_W, I_FCONV_B, I_FWDN };

__device__ __forceinline__ bool get_job(const Params& P, int job, PrepJob& J) {
    bf16_t* wb = (bf16_t*)(P.ws + WS_W);
    if (job < 6) { const int j = job & 1, k = job >> 1;
        if (k == 0) { J = PrepJob{P.in[I_EW_IN] + (size_t)j * DM * 1476, P.in[I_NORM_MIX] + (2 * j) * DM, (bf16_t*)((char*)wb + W_EIN + j * 3 * MiB), DM, 1476, 1536, MAP_EVEN_IN}; return true; }
        if (k == 1) { J = PrepJob{P.in[I_EW_OUT] + (size_t)j * DM * DM, nullptr, (bf16_t*)((char*)wb + W_EOUT + j * 2 * MiB), DM, DM, DM, MAP_STD}; return true; }
        J = PrepJob{P.in[I_WGLU] + (size_t)j * 512 * 512, nullptr, (bf16_t*)((char*)wb + W_GLU + j * (MiB / 2)), 512, 512, 512, MAP_STD}; return true; }
    job -= 6;
    if (job < 4) { const int j = job & 1, k = job >> 1;
        if (k == 0) { J = PrepJob{P.in[I_OW_IN] + (size_t)j * DM * 3072, P.in[I_NORM_MIX] + (2 * j + 1) * DM, (bf16_t*)((char*)wb + W_OIN + j * 8 * MiB), DM, 3072, 4096, MAP_ODD_IN}; return true; }
        J = PrepJob{P.in[I_OW_OUT] + (size_t)j * DM * DM, nullptr, (bf16_t*)((char*)wb + W_OOUT + j * 2 * MiB), DM, DM, DM, MAP_STD}; return true; }
    job -= 4;
    if (job < 20) { const int i = job & 3, k = job >> 2;
        if (k == 0) { J = PrepJob{P.in[I_XWQ] + (size_t)i * DM * 512, P.in[I_NORM_X] + i * DM, (bf16_t*)((char*)wb + W_XQ + i * MiB), DM, 512, 512, MAP_XQ}; return true; }
        if (k == 1) { J = PrepJob{P.in[I_XWKV] + (size_t)i * DM * 1024, P.in[I_NORM_MEM] + i * DM, (bf16_t*)((char*)wb + W_XKV + i * 2 * MiB), DM, 1024, 1024, MAP_XKV}; return true; }
        if (k == 2) { J = PrepJob{P.in[I_XWO] + (size_t)i * 512 * DM, nullptr, (bf16_t*)((char*)wb + W_XO + i * MiB), 512, DM, DM, MAP_STD}; return true; }
        if (k == 3) { J = PrepJob{P.in[I_FWUP] + (size_t)i * DM * 2 * DFF, P.in[I_NORM_FFN] + i * DM, (bf16_t*)((char*)wb + W_UP + i * 11 * MiB), DM, 2 * DFF, 2 * DFF, MAP_FFN_UP}; return true; }
        J = PrepJob{P.in[I_FWDN] + (size_t)i * DFF * DM, nullptr, (bf16_t*)((char*)wb + W_DN + i * (11 * MiB / 2)), DFF, DM, DM, MAP_STD}; return true; }
    return false;
}
constexpr int NJOBS = 30;

__device__ __forceinline__ f32x2 cmul(f32x2 a, f32x2 b) { return (f32x2){a.x * b.x - a.y * b.y, a.x * b.y + a.y * b.x}; }
__device__ __forceinline__ void s5_precompute(const Params& P, LAS unsigned char* lds, int task) {
    const int tid = fresh_tid(), jg = task;
    LAS f32x2* PW = (LAS f32x2*)lds;
    LAS f32x2* BB = PW + 17 * 64;
    LAS f32x2* CC = BB + 64 * 16;
    unsigned char* op = P.ws + WS_S5OP + (size_t)jg * S5OP_STRIDE;
    if (tid < 64) {
        const int p = tid;
        const float delta = expf(P.in[I_LOGSTEP][jg]);
        const float lre = P.in[I_LAM_RE][jg * 64 + p], lim = P.in[I_LAM_IM][jg * 64 + p];
        for (int n = 0; n <= 16; ++n) { const float mag = expf((float)n * lre * delta); float sn, cs; sincosf((float)n * lim * delta, &sn, &cs); PW[n * 64 + p] = (f32x2){mag * cs, mag * sn}; }
        const f32x2 lb = PW[64 + p]; const float nr = lb.x - 1.f, ni = lb.y, den = lre * lre + lim * lim;
        const f32x2 coef = (f32x2){(nr * lre + ni * lim) / den, (ni * lre - nr * lim) / den};
        for (int c = 0; c < 16; ++c) { const f32x2 b = (f32x2){P.in[I_B_RE][((size_t)jg * 64 + p) * 16 + c], P.in[I_B_IM][((size_t)jg * 64 + p) * 16 + c]}; BB[p * 16 + c] = cmul(coef, b); }
        for (int c = 0; c < 16; ++c) CC[c * 64 + p] = (f32x2){P.in[I_C_RE][((size_t)jg * 16 + c) * 64 + p], P.in[I_C_IM][((size_t)jg * 16 + c) * 64 + p]};
        ((f32x2*)(op + S5OP_A16))[p] = PW[16 * 64 + p];
    }
    __syncthreads();
    bf16_t* Km = (bf16_t*)op; bf16_t* Pm = (bf16_t*)(op + S5OP_PM); bf16_t* Qm = (bf16_t*)(op + S5OP_QM);
    for (int idx = tid; idx < 17 * 256; idx += NTHREADS) {
        const int dd = idx >> 8, c1 = (idx >> 4) & 15, c = idx & 15; float v = 0.f;
        if (dd > 0) { const int d = dd - 1; for (int p = 0; p < 64; ++p) { const f32x2 m = cmul(cmul(CC[c1 * 64 + p], PW[d * 64 + p]), BB[p * 16 + c]); v += m.x; } }
        Km[idx] = (bf16_t)f2bf(v);
    }
    for (int idx = tid; idx < 128 * 256; idx += NTHREADS) {
        const int row = idx >> 8, col = idx & 255, p = row >> 1, ri = row & 1, tau = col >> 4, c = col & 15;
        const f32x2 m = cmul(PW[(15 - tau) * 64 + p], BB[p * 16 + c]);
        Pm[((((row >> 4) * 8 + (col >> 5)) * 64 + ((col >> 3) & 3) * 16 + (row & 15)) << 3) + (col & 7)] = (bf16_t)f2bf(ri ? m.y : m.x);
    }
    for (int idx = tid; idx < 256 * 128; idx += NTHREADS) {
        const int row = idx >> 7, col = idx & 127, tau = row >> 4, c1 = row & 15, p = col >> 1, ri = col & 1;
        const f32x2 m = cmul(CC[c1 * 64 + p], PW[(tau + 1) * 64 + p]);
        Qm[((((row >> 4) * 4 + (col >> 5)) * 64 + ((col >> 3) & 3) * 16 + (row & 15)) << 3) + (col & 7)] = (bf16_t)f2bf(ri ? -m.y : m.x);
    }
    __syncthreads();
}

__device__ __forceinline__ void prologue(const Params& P, LAS unsigned char* lds, int gw, int NGW, int wave, int lane) {
    for (int task = blockIdx.x; task < 64; task += gridDim.x) s5_precompute(P, lds, task);
    LAS float* scr = (LAS float*)(lds + wave * 16384);
    {
        int base = 0;
        for (int job = 0; job < NJOBS; ++job) {
            PrepJob J; get_job(P, job, J);
            const int nitems = (J.npad / 32) * (J.K / 64);
            int first = gw - (base % NGW); if (first < 0) first += NGW;
            for (int it = first; it < nitems; it += NGW) prep_item(J, scr, it, lane);
            base += nitems;
        }
    }
    {
        const float* x = P.in[I_X]; bf16_t* xb = (bf16_t*)(P.ws + WS_XB); float* ssq = (float*)(P.ws + WS_SSQ16);
        for (int m = gw; m < NTOK; m += NGW) {
            const f32x4* xr = (const f32x4*)(x + (size_t)m * DM) + lane; u32x2* bo = (u32x2*)(xb + (size_t)m * DM) + lane;
            float sq[4];
#pragma unroll
            for (int j = 0; j < 4; ++j) { const f32x4 v = xr[64 * j]; bo[64 * j] = (u32x2){pk2(v.x, v.y), pk2(v.z, v.w)}; sq[j] = wave_sum((v.x * v.x + v.y * v.y) + (v.z * v.z + v.w * v.w)); }
            if (lane < 16) ssq[16 * (size_t)m + lane] = (lane & 3) ? 0.f : ((lane >> 2) == 0 ? sq[0] : (lane >> 2) == 1 ? sq[1] : (lane >> 2) == 2 ? sq[2] : sq[3]);
        }
    }
    {
        const float* mem = P.in[I_MEM]; bf16_t* mb = (bf16_t*)(P.ws + WS_MEMB); float* mrs = (float*)(P.ws + WS_MEMRS);
        for (int m = gw; m < MEMTOK; m += NGW) {
            const f32x4* xr = (const f32x4*)(mem + (size_t)m * DM) + lane; u32x2* bo = (u32x2*)(mb + (size_t)m * DM) + lane;
            float s = 0.f;
#pragma unroll
            for (int j = 0; j < 4; ++j) { const f32x4 v = xr[64 * j]; bo[64 * j] = (u32x2){pk2(v.x, v.y), pk2(v.z, v.w)}; s += (v.x * v.x + v.y * v.y) + (v.z * v.z + v.w * v.w); }
            s = wave_sum(s);
            if (lane == 0) mrs[m] = rsqrtf(s * (1.f / DM) + EPS);
        }
    }
}

typedef const f32x4 (&AccRef)[2][2][4][2];
__device__ __forceinline__ u32x4 pack8(f32x4 a, f32x4 b) { u32x4 w; w.x = cvt_pk_bf16(a.x, a.y); w.y = cvt_pk_bf16(a.z, a.w); w.z = cvt_pk_bf16(b.x, b.y); w.w = cvt_pk_bf16(b.z, b.w); return w; }
typedef __amdgpu_buffer_rsrc_t rsrc_t;
__device__ __forceinline__ rsrc_t mkrsrc(const void* p) { return __builtin_amdgcn_make_buffer_rsrc((void*)p, 0, 0x7fffffff, 0x00020000); }
#define BLD128(r, vo, so) __builtin_amdgcn_raw_buffer_load_b128((r), (vo), (so), 0)
#define BLD64(r, vo, so) __builtin_amdgcn_raw_buffer_load_b64((r), (vo), (so), 0)
#define BST128(v, r, vo, so) __builtin_amdgcn_raw_buffer_store_b128((v), (r), (vo), (so), 0)
#define BST64(v, r, vo, so) __builtin_amdgcn_raw_buffer_store_b64((v), (r), (vo), (so), 0)
__device__ __forceinline__ f32x4 asf4(u32x4 v) { return __builtin_bit_cast(f32x4, v); }
__device__ __forceinline__ u32x4 asu4(f32x4 v) { return __builtin_bit_cast(u32x4, v); }
#define RFL(x) __builtin_amdgcn_readfirstlane(x)
__device__ __forceinline__ float rs_sum16(u32x4 a, u32x4 b, u32x4 c, u32x4 d) { const f32x4 s = (asf4(a) + asf4(b)) + (asf4(c) + asf4(d)); return rsqrtf(((s.x + s.y) + (s.z + s.w)) * (1.f / DM) + EPS); }
__device__ __forceinline__ LAS float* rs_stage(rsrc_t rq, LAS unsigned char* lds, int wr, int wc, int fr, int fq) {
    LAS float* sl = (LAS float*)(lds + EPI_OFF + (wr * 4 + wc) * 512);
    const int l = fq * 16 + fr;
    u32x4 t[2][4];
#pragma unroll
    for (int j = 0; j < 2; ++j) { const int rl = 128 * j + 64 * wr + l;
#pragma unroll
        for (int k = 0; k < 4; ++k) t[j][k] = BLD128(rq, rl * 64, 16 * k); }
#pragma unroll
    for (int j = 0; j < 2; ++j) sl[l + 64 * j] = rs_sum16(t[j][0], t[j][1], t[j][2], t[j][3]);
    LDS_WAIT();
    return sl;
}
__device__ __forceinline__ float xrow_sum(float v) {
    float a = v, b = v;
    asm("s_nop 1\n\tv_permlane32_swap_b32_e32 %0, %1\n\ts_nop 1\n\tv_add_f32_e32 %0, %0, %1\n\tv_mov_b32_e32 %1, %0\n\ts_nop 1\n\tv_permlane16_swap_b32_e32 %0, %1\n\ts_nop 1\n\tv_add_f32_e32 %0, %0, %1" : "+v"(a), "+v"(b));
    return a;
}
__device__ __forceinline__ float row_ror1(float v) { return __builtin_bit_cast(float, __builtin_amdgcn_update_dpp(0, __builtin_bit_cast(int, v), 0x121, 0xf, 0xf, true)); }
__device__ __forceinline__ float row_ror2(float v) { return __builtin_bit_cast(float, __builtin_amdgcn_update_dpp(0, __builtin_bit_cast(int, v), 0x122, 0xf, 0xf, true)); }
__device__ __forceinline__ float row_shr1(float v) { return __builtin_bit_cast(float, __builtin_amdgcn_update_dpp(0, __builtin_bit_cast(int, v), 0x111, 0xf, 0xf, true)); }
__device__ __forceinline__ float row_shr2(float v) { return __builtin_bit_cast(float, __builtin_amdgcn_update_dpp(0, __builtin_bit_cast(int, v), 0x112, 0xf, 0xf, true)); }
__device__ __forceinline__ f32x4 shr1_4(f32x4 v) { return (f32x4){row_shr1(v.x), row_shr1(v.y), row_shr1(v.z), row_shr1(v.w)}; }
__device__ __forceinline__ f32x4 shr2_4(f32x4 v) { return (f32x4){row_shr2(v.x), row_shr2(v.y), row_shr2(v.z), row_shr2(v.w)}; }
__device__ __forceinline__ void conv_taps(f32x4& c, f32x4 x, f32x4 w1, f32x4 w0) {
    asm("s_nop 1\n\t"
        "v_fmac_f32_dpp %0, %4, %8 row_shr:1 row_mask:0xf bank_mask:0xf\n\tv_fmac_f32_dpp %1, %5, %9 row_shr:1 row_mask:0xf bank_mask:0xf\n\t"
        "v_fmac_f32_dpp %2, %6, %10 row_shr:1 row_mask:0xf bank_mask:0xf\n\tv_fmac_f32_dpp %3, %7, %11 row_shr:1 row_mask:0xf bank_mask:0xf\n\t"
        "v_fmac_f32_dpp %0, %4, %12 row_shr:2 row_mask:0xf bank_mask:0xf\n\tv_fmac_f32_dpp %1, %5, %13 row_shr:2 row_mask:0xf bank_mask:0xf\n\t"
        "v_fmac_f32_dpp %2, %6, %14 row_shr:2 row_mask:0xf bank_mask:0xf\n\tv_fmac_f32_dpp %3, %7, %15 row_shr:2 row_mask:0xf bank_mask:0xf"
        : "+v"(c.x), "+v"(c.y), "+v"(c.z), "+v"(c.w)
        : "v"(x.x), "v"(x.y), "v"(x.z), "v"(x.w), "v"(w1.x), "v"(w1.y), "v"(w1.z), "v"(w1.w), "v"(w0.x), "v"(w0.y), "v"(w0.z), "v"(w0.w));
}
__device__ __forceinline__ void conv_taps_prev(f32x4& c, f32x4 xp, f32x4 w1a, f32x4 w0a) {
    asm("s_nop 1\n\t"
        "v_fmac_f32_dpp %0, %4, %8 row_ror:1 row_mask:0xf bank_mask:0xf\n\tv_fmac_f32_dpp %1, %5, %9 row_ror:1 row_mask:0xf bank_mask:0xf\n\t"
        "v_fmac_f32_dpp %2, %6, %10 row_ror:1 row_mask:0xf bank_mask:0xf\n\tv_fmac_f32_dpp %3, %7, %11 row_ror:1 row_mask:0xf bank_mask:0xf\n\t"
        "v_fmac_f32_dpp %0, %4, %12 row_ror:2 row_mask:0xf bank_mask:0xf\n\tv_fmac_f32_dpp %1, %5, %13 row_ror:2 row_mask:0xf bank_mask:0xf\n\t"
        "v_fmac_f32_dpp %2, %6, %14 row_ror:2 row_mask:0xf bank_mask:0xf\n\tv_fmac_f32_dpp %3, %7, %15 row_ror:2 row_mask:0xf bank_mask:0xf"
        : "+v"(c.x), "+v"(c.y), "+v"(c.z), "+v"(c.w)
        : "v"(xp.x), "v"(xp.y), "v"(xp.z), "v"(xp.w), "v"(w1a.x), "v"(w1a.y), "v"(w1a.z), "v"(w1a.w), "v"(w0a.x), "v"(w0a.y), "v"(w0a.z), "v"(w0a.w));
}
__device__ __forceinline__ f32x4 ror1_4(f32x4 v) { return (f32x4){row_ror1(v.x), row_ror1(v.y), row_ror1(v.z), row_ror1(v.w)}; }
__device__ __forceinline__ f32x4 ror2_4(f32x4 v) { return (f32x4){row_ror2(v.x), row_ror2(v.y), row_ror2(v.z), row_ror2(v.w)}; }

struct EpiResidual {
    float* XF; bf16_t* XB; float* SSQ; float sign;
    __device__ __forceinline__ void operator()(AccRef acc, const pg8::Unit& u, int wr, int wc, int fr, int fq) const {
        const int pm = RFL(u.pm), pn = RFL(u.pn);
        const rsrc_t rb = mkrsrc(XB + (size_t)pm * 256 * DM + pn * 256), rs = mkrsrc(SSQ + (size_t)pm * 256 * 16 + pn * 4 + wc);
        const bool fin = XF != nullptr;
        const rsrc_t rx = mkrsrc((fin ? XF : (float*)XB) + (size_t)pm * 256 * DM + pn * 256);
        const int vx = ((wr * 64 + fr) * DM + wc * 32 + 8 * fq) * 4, vb = vx >> 1, vs = (wr * 64 + fr) * 64;
        u32x4 xin[2][4][2];
#pragma unroll
        for (int ai = 0; ai < 2; ++ai)
#pragma unroll
            for (int m = 0; m < 4; ++m)
#pragma unroll
                for (int bj = 0; bj < 2; ++bj) xin[ai][m][bj] = BLD128(rb, vb, (((ai * 128 + m * 16) * DM + bj * 128) * 4) >> 1);
#pragma unroll
        for (int ai = 0; ai < 2; ++ai) {
#pragma unroll
            for (int m = 0; m < 4; ++m) {
                float s = 0.f;
#pragma unroll
                for (int bj = 0; bj < 2; ++bj) {
                    const int so = ((ai * 128 + m * 16) * DM + bj * 128) * 4;
                    const u32x4 xo = xin[ai][m][bj];
                    f32x4 a = (f32x4){bflo(xo.x), bfhi(xo.x), bflo(xo.y), bfhi(xo.y)}, b = (f32x4){bflo(xo.z), bfhi(xo.z), bflo(xo.w), bfhi(xo.w)};
#if MK_DUP
                    a += acc[ai][bj][m][0] * sign; b += acc[ai][bj][m][1] * sign;
#else
                    a += acc[ai][bj][m][0]; b += acc[ai][bj][m][1];
#endif
                    BST128(pack8(a, b), rb, vb, so >> 1);
                    if (fin) { BST128(asu4(a), rx, vx, so); BST128(asu4(b), rx, vx, so + 16); }
                    s += (a.x * a.x + a.y * a.y) + (a.z * a.z + a.w * a.w) + (b.x * b.x + b.y * b.y) + (b.z * b.z + b.w * b.w);
                }
                s = xrow_sum(s);
                if (fq == 0) __builtin_amdgcn_raw_buffer_store_b32(__builtin_bit_cast(unsigned, s), rs, vs, (ai * 128 + m * 16) * 64, 0);
            }
        }
    }
};

struct EpiEvenIn {
    const float* SSQ; const float* qg; const float* kg;
    bf16_t *Q, *KV, *IK, *IQ, *U; float* IW; LAS unsigned char* lds;
    __device__ __forceinline__ void operator()(AccRef acc, const pg8::Unit& u, int wr, int wc, int fr, int fq) const {
        const int pm = RFL(u.pm), pn = RFL(u.pn);
        int kind;
        bf16_t* dst; int rowstride, bjoff; const float* gain = qg; float post = 1.f;
        if (pn <= 1) { kind = 0; dst = Q + (4 * pn + wc) * 64; rowstride = 512; bjoff = 32; gain = qg; post = 0.125f * 1.4426950408889634f; }
        else if (pn == 2) {
            if (wc == 0) { kind = 0; dst = KV; rowstride = 128; bjoff = 32; gain = kg; }
            else if (wc == 1) { kind = 1; dst = KV + 64; rowstride = 128; bjoff = 32; }
            else if (wc == 2) { kind = 1; dst = IK; rowstride = 64; bjoff = 32; }
            else { kind = 2; dst = (bf16_t*)IW; rowstride = 8; bjoff = 0; }
        }
        else if (pn == 3) { kind = 1; dst = IQ + wc * 64; rowstride = 256; bjoff = 32; }
        else { kind = 3; dst = U + 256 * (pn - 4) + 32 * wc; rowstride = 512; bjoff = 128; }
        const rsrc_t rd = mkrsrc(dst + (size_t)pm * 256 * rowstride), rq = mkrsrc(SSQ + (size_t)pm * 256 * 16);
        const int vq = (wr * 64 + fr) * 64;
        int vd = ((wr * 64 + fr) * rowstride + 8 * fq) * 2;
        int rsb = rowstride * 2, bjb = bjoff * 2;
        if (pn == 2 && wc == 2) { vd = fq * 256 + fr * 16 + wr * 8192; bjb = 1024; }
        f32x4 gn[2][2];
#pragma unroll
        for (int bj = 0; bj < 2; ++bj) { gn[bj][0] = (f32x4){1.f, 1.f, 1.f, 1.f}; gn[bj][1] = gn[bj][0]; if (kind == 0) { gn[bj][0] = *(const f32x4*)(gain + 32 * bj + 8 * fq); gn[bj][1] = *(const f32x4*)(gain + 32 * bj + 8 * fq + 4); } }
        const LAS float* rsl = rs_stage(rq, lds, wr, wc, fr, fq);
#pragma unroll
        for (int ai = 0; ai < 2; ++ai) {
#pragma unroll
            for (int m = 0; m < 4; ++m) {
                float r = rsl[64 * ai + 16 * m + fr];
                if (kind == 0) {
                    float ss = 0.f;
#pragma unroll
                    for (int bj = 0; bj < 2; ++bj)
#pragma unroll
                        for (int n = 0; n < 2; ++n) { const f32x4 v = acc[ai][bj][m][n]; ss += (v.x * v.x + v.y * v.y) + (v.z * v.z + v.w * v.w); }
                    ss = xrow_sum(ss);
                    ss *= r * r;
                    r *= rsqrtf(ss * (1.f / 64.f) + EPS) * post;
                }
                if (kind == 2) {
                    if (fq == 0) BST128(asu4(acc[ai][0][m][0] * (r * 0.0625f)), rd, (wr * 64 + fr) * 16, (ai * 128 + m * 16) * 16);
                } else {
#pragma unroll
                    for (int bj = 0; bj < 2; ++bj) {
                        const f32x4 g0 = gn[bj][0], g1 = gn[bj][1];
                        BST128(pack8(acc[ai][bj][m][0] * r * g0, acc[ai][bj][m][1] * r * g1), rd, vd, (ai * 128 + m * 16) * rsb + bj * bjb);
                    }
                }
            }
        }
    }
};

template <int mode> struct EpiHead128 {
    const float* SSQ;
    const float* RS;
    bf16_t* dst; float* HSS; LAS unsigned char* lds;
    __device__ __forceinline__ void operator()(AccRef acc, const pg8::Unit& u, int wr, int wc, int fr, int fq) const {
        const int pm = RFL(u.pm), pn = RFL(u.pn);
        const int layer = (mode == 1) ? (pn >> 2) : 0, jt = (mode == 1) ? (pn & 3) : pn;
        const bool khead = (mode == 0) || (jt < 2);
        const rsrc_t rq = (mode == 0) ? mkrsrc(SSQ + (size_t)pm * 256 * 16) : mkrsrc(RS + (size_t)pm * 256);
        const int vq = (wr * 64 + fr) * 64, vr = (wr * 64 + fr) * 4;
        int rowstride, bjoff; bf16_t* d0; size_t hrow0;
        if (mode == 0) { rowstride = 512; bjoff = 32; d0 = dst + (size_t)pm * 256 * 512 + (2 * jt + (wc >> 1)) * 128 + 64 * (wc & 1); hrow0 = (size_t)pm * 256; }
        else if (jt < 2) { rowstride = 1024; bjoff = 32; d0 = dst + ((size_t)layer * MEMTOK + pm * 256) * 1024 + (2 * jt + (wc >> 1)) * 128 + 64 * (wc & 1); hrow0 = (size_t)layer * MEMTOK + pm * 256; }
        else { rowstride = 1024; bjoff = 128; d0 = dst + ((size_t)layer * MEMTOK + pm * 256) * 1024 + 512 + 256 * (jt - 2) + 32 * wc; hrow0 = 0; }
        const rsrc_t rd = mkrsrc(d0), rh = mkrsrc(HSS + hrow0 * 8 + (2 * (khead ? jt : 0) + (wc >> 1)) * 2 + (wc & 1));
        const int vd = ((wr * 64 + fr) * rowstride + 8 * fq) * 2, rsb = rowstride * 2, bjb = bjoff * 2, vh = (wr * 64 + fr) * 32;
        const LAS float* rsl = nullptr; if constexpr (mode == 0) rsl = rs_stage(rq, lds, wr, wc, fr, fq);
#pragma unroll
        for (int ai = 0; ai < 2; ++ai) {
            float rr[4];
            if constexpr (mode == 0) {
#pragma unroll
                for (int m = 0; m < 4; ++m) rr[m] = rsl[64 * ai + 16 * m + fr];
            } else {
#pragma unroll
                for (int m = 0; m < 4; ++m) rr[m] = __builtin_bit_cast(float, __builtin_amdgcn_raw_buffer_load_b32(rq, vr, (ai * 128 + m * 16) * 4, 0));
            }
#pragma unroll
            for (int m = 0; m < 4; ++m) {
                const float r = rr[m];
                if (khead) {
                    float ss = 0.f;
#pragma unroll
                    for (int bj = 0; bj < 2; ++bj)
#pragma unroll
                        for (int n = 0; n < 2; ++n) { const f32x4 v = acc[ai][bj][m][n]; ss += (v.x * v.x + v.y * v.y) + (v.z * v.z + v.w * v.w); }
                    ss = xrow_sum(ss);
                    if (fq == 0) __builtin_amdgcn_raw_buffer_store_b32(__builtin_bit_cast(unsigned, ss * r * r), rh, vh, (ai * 128 + m * 16) * 32, 0);
                }
#pragma unroll
                for (int bj = 0; bj < 2; ++bj) BST128(pack8(acc[ai][bj][m][0] * r, acc[ai][bj][m][1] * r), rd, vd, (ai * 128 + m * 16) * rsb + bj * bjb);
            }
        }
    }
};

struct EpiGlu {
    const bf16_t* YG; const float* bias; bf16_t* A2;
    __device__ __forceinline__ void operator()(AccRef acc, const pg8::Unit& u, int wr, int wc, int fr, int fq) const {
        const int pm = RFL(u.pm), pn = RFL(u.pn);
        const int col0 = pn * 256 + wc * 32 + 8 * fq;
        const rsrc_t ry = mkrsrc(YG + (size_t)pm * 256 * 512 + pn * 256), ro = mkrsrc(A2 + (size_t)pm * 256 * 1024 + 512 + pn * 256);
        const int vy = ((wr * 64 + fr) * 512 + wc * 32 + 8 * fq) * 2, vo = ((wr * 64 + fr) * 1024 + wc * 32 + 8 * fq) * 2;
        f32x4 bv[2][2];
#pragma unroll
        for (int bj = 0; bj < 2; ++bj) { bv[bj][0] = *(const f32x4*)(bias + col0 + bj * 128); bv[bj][1] = *(const f32x4*)(bias + col0 + bj * 128 + 4); }
#pragma unroll
        for (int ai = 0; ai < 2; ++ai) {
            u32x4 yin[4][2];
#pragma unroll
            for (int m = 0; m < 4; ++m)
#pragma unroll
                for (int bj = 0; bj < 2; ++bj) yin[m][bj] = BLD128(ry, vy, ((ai * 128 + m * 16) * 512 + bj * 128) * 2);
#pragma unroll
            for (int m = 0; m < 4; ++m) {
#pragma unroll
                for (int bj = 0; bj < 2; ++bj) {
                    const u32x4 y = yin[m][bj];
                    const f32x4 a = acc[ai][bj][m][0] + bv[bj][0], b = acc[ai][bj][m][1] + bv[bj][1];
                    f32x4 o0, o1;
                    o0.x = bflo(y.x) * sigmoid_f(a.x); o0.y = bfhi(y.x) * sigmoid_f(a.y); o0.z = bflo(y.y) * sigmoid_f(a.z); o0.w = bfhi(y.y) * sigmoid_f(a.w);
                    o1.x = bflo(y.z) * sigmoid_f(b.x); o1.y = bfhi(y.z) * sigmoid_f(b.y); o1.z = bflo(y.w) * sigmoid_f(b.z); o1.w = bfhi(y.w) * sigmoid_f(b.w);
                    BST128(pack8(o0, o1), ro, vo, ((ai * 128 + m * 16) * 1024 + bj * 128) * 2);
                }
            }
        }
    }
};

__device__ __forceinline__ f32x4 shfl4(f32x4 v, int src) { f32x4 r; r.x = __shfl(v.x, src); r.y = __shfl(v.y, src); r.z = __shfl(v.z, src); r.w = __shfl(v.w, src); return r; }
__device__ __forceinline__ f32x4 sel4(bool c, f32x4 a, f32x4 b) { return c ? a : b; }

struct EpiFfnUp {
    const float* SSQ; const float* cw; const float* cb;
    bf16_t* ACT; float* TAIL; float* HEAD; LAS unsigned char* lds;
    __device__ __forceinline__ void operator()(AccRef acc, const pg8::Unit& u, int wr, int wc, int fr, int fq) const {
        const int pm = RFL(u.pm), pn = RFL(u.pn);
        const int chl = 32 * wc + 8 * fq, ch0 = 128 * pn + chl;
        const size_t tix = (size_t)pm * 22 + pn;
        const rsrc_t rq = mkrsrc(SSQ + (size_t)pm * 256 * 16), ra = mkrsrc(ACT + (size_t)pm * 256 * DFF + 128 * pn);
        const int vq = (wr * 64 + fr) * 64, va = ((wr * 64 + fr) * DFF + chl) * 2;
        f32x4 w0v[2], w1v[2], w2v[2], bbv[2], w0a[2], w1a[2];
#pragma unroll
        for (int n = 0; n < 2; ++n) { w0v[n] = *(const f32x4*)(cw + ch0 + 4 * n); w1v[n] = *(const f32x4*)(cw + DFF + ch0 + 4 * n); w2v[n] = *(const f32x4*)(cw + 2 * DFF + ch0 + 4 * n); bbv[n] = *(const f32x4*)(cb + ch0 + 4 * n); }
        const LAS float* rsl = rs_stage(rq, lds, wr, wc, fr, fq);
        const f32x4 z4 = (f32x4){0.f, 0.f, 0.f, 0.f};
#pragma unroll
        for (int n = 0; n < 2; ++n) { w1a[n] = (fr == 0) ? w1v[n] : z4; w0a[n] = (fr < 2) ? w0v[n] : z4; }
#pragma unroll
        for (int ai = 0; ai < 2; ++ai) {
            float rr[4];
#pragma unroll
            for (int m = 0; m < 4; ++m) rr[m] = rsl[64 * ai + 16 * m + fr];
            f32x4 gp[2] = {z4, z4};
#pragma unroll
            for (int m = 0; m < 4; ++m) {
                const float r = rr[m];
                unsigned pk[4];
#pragma unroll
                for (int n = 0; n < 2; ++n) {
                    float* hd = HEAD + ((tix * 4 + 2 * ai + wr) * 4) * 128 + chl + 4 * n; float* tl = TAIL + ((tix * 4 + 2 * ai + wr) * 2) * 128 + chl + 4 * n;
                    const f32x4 g = acc[ai][0][m][n] * r, uu = acc[ai][1][m][n] * r;
                    f32x4 cg = w2v[n] * g + bbv[n];
                    conv_taps(cg, g, w1v[n], w0v[n]);
                    if (m > 0) conv_taps_prev(cg, gp[n], w1a[n], w0a[n]);
                    f32x4 o;
                    o.x = (cg.x * uu.x) * __builtin_amdgcn_rcpf(1.f + __builtin_amdgcn_exp2f(cg.x * -1.4426950408889634f));
                    o.y = (cg.y * uu.y) * __builtin_amdgcn_rcpf(1.f + __builtin_amdgcn_exp2f(cg.y * -1.4426950408889634f));
                    o.z = (cg.z * uu.z) * __builtin_amdgcn_rcpf(1.f + __builtin_amdgcn_exp2f(cg.z * -1.4426950408889634f));
                    o.w = (cg.w * uu.w) * __builtin_amdgcn_rcpf(1.f + __builtin_amdgcn_exp2f(cg.w * -1.4426950408889634f));
                    if (m == 0 && fr < 2) { *(f32x4*)(hd + fr * 128) = g; *(f32x4*)(hd + (2 + fr) * 128) = uu; }
                    if (m == 3 && fr >= 14) *(f32x4*)(tl + (fr - 14) * 128) = g;
                    pk[2 * n] = cvt_pk_bf16(o.x, o.y); pk[2 * n + 1] = cvt_pk_bf16(o.z, o.w);
                    gp[n] = g;
                }
                BST128(((u32x4){pk[0], pk[1], pk[2], pk[3]}), ra, va, ((ai * 128 + m * 16) * DFF) * 2);
            }
        }
    }
};

struct EpiOddIn {
    const float* SSQ; const float* cw; const float* cb;
    bf16_t* MIX; float* TAIL; float* HEAD; LAS unsigned char* lds;
    __device__ __forceinline__ void operator()(AccRef acc, const pg8::Unit& u, int wr, int wc, int fr, int fq) const {
        const int pm = RFL(u.pm), pn = RFL(u.pn);
        const int chl = 16 * wc + 4 * fq, ch0 = 64 * pn + chl;
        const size_t tix = (size_t)pm * 16 + pn;
        const rsrc_t rq = mkrsrc(SSQ + (size_t)pm * 256 * 16), ra = mkrsrc(MIX + (size_t)pm * 256 * DM + 64 * pn);
        const int vq = (wr * 64 + fr) * 64, va = ((wr * 64 + fr) * DM + chl) * 2;
        const f32x4 w0 = *(const f32x4*)(cw + ch0), w1 = *(const f32x4*)(cw + 1024 + ch0), w2 = *(const f32x4*)(cw + 2048 + ch0), bb = *(const f32x4*)(cb + ch0);
        const LAS float* rsl = rs_stage(rq, lds, wr, wc, fr, fq);
        const f32x4 z4 = (f32x4){0.f, 0.f, 0.f, 0.f};
        const f32x4 w1a = (fr == 0) ? w1 : z4, w0a = (fr < 2) ? w0 : z4;
#pragma unroll
        for (int ai = 0; ai < 2; ++ai) {
            float rr[4];
#pragma unroll
            for (int m = 0; m < 4; ++m) rr[m] = rsl[64 * ai + 16 * m + fr];
            float* hd = HEAD + ((tix * 4 + 2 * ai + wr) * 4) * 64 + chl; float* tl = TAIL + ((tix * 4 + 2 * ai + wr) * 2) * 64 + chl;
            f32x4 pprev = (f32x4){0.f, 0.f, 0.f, 0.f};
#pragma unroll
            for (int m = 0; m < 4; ++m) {
                const float r = rr[m];
                const f32x4 gb = acc[ai][0][m][0] * r, p = acc[ai][0][m][1] * acc[ai][1][m][0] * (r * r);
                f32x4 cv = w2 * p + bb;
                conv_taps(cv, p, w1, w0);
                if (m > 0) conv_taps_prev(cv, pprev, w1a, w0a);
                const f32x4 y = gb * cv;
                if (m == 0 && fr < 2) { *(f32x4*)(hd + fr * 64) = p; *(f32x4*)(hd + (2 + fr) * 64) = gb; }
                if (m == 3 && fr >= 14) *(f32x4*)(tl + (fr - 14) * 64) = p;
                BST64(((u32x2){cvt_pk_bf16(y.x, y.y), cvt_pk_bf16(y.z, y.w)}), ra, va, (ai * 128 + m * 16) * DM * 2);
                pprev = p;
            }
        }
    }
};


struct EpiNull {
    __device__ __forceinline__ void operator()(AccRef acc, const pg8::Unit& u, int wr, int wc, int fr, int fq) const {
#pragma unroll
        for (int ai = 0; ai < 2; ++ai)
#pragma unroll
            for (int bj = 0; bj < 2; ++bj)
#pragma unroll
                for (int m = 0; m < 4; ++m)
#pragma unroll
                    for (int n = 0; n < 2; ++n) asm volatile("" :: "v"(acc[ai][bj][m][n]));
    }
};

struct EpiPlain {
    bf16_t* O; int ldc;
    __device__ __forceinline__ void operator()(AccRef acc, const pg8::Unit& u, int wr, int wc, int fr, int fq) const {
        const int pm = RFL(u.pm), pn = RFL(u.pn);
        const rsrc_t rd = mkrsrc(O + (size_t)pm * 256 * ldc + pn * 256);
        const int vd = ((wr * 64 + fr) * ldc + wc * 32 + 8 * fq) * 2;
#pragma unroll
        for (int ai = 0; ai < 2; ++ai)
#pragma unroll
            for (int m = 0; m < 4; ++m)
#pragma unroll
                for (int bj = 0; bj < 2; ++bj) BST128(pack8(acc[ai][bj][m][0], acc[ai][bj][m][1]), rd, vd, ((ai * 128 + m * 16) * ldc + bj * 128) * 2);
    }
};

__device__ __forceinline__ void fixup_ffn(const Params& P, int layer, int gtid, int gthreads) {
    const float* TAIL = (const float*)(P.ws + WS_HALO2 + HALO_FT); const float* HEAD = (const float*)(P.ws + WS_HALO2 + HALO_FH);
    const float* cw = P.in[I_FCONV_W] + (size_t)layer * 3 * DFF; const float* cb = P.in[I_FCONV_B] + (size_t)layer * DFF; bf16_t* ACT = (bf16_t*)(P.ws + WS_R + R_ACT);
    constexpr int NIT = 128 * 22 * 4 * 2 * 32, NB = 3;
#pragma unroll 1
    for (int base = gtid; base < NIT; base += NB * gthreads) {
        f32x4 w0[NB], w1[NB], w2[NB], bb[NB], gm2[NB], gm1[NB], g0[NB], g1[NB], uu[NB]; bool ok[NB]; size_t dst[NB]; int rr[NB];
#pragma unroll
        for (int k = 0; k < NB; ++k) {
            const int idx = base + k * gthreads;
            const int ch = 4 * (idx & 31), r = (idx >> 5) & 1, q4 = (idx >> 6) & 3, t = idx >> 8, pn = t % 22, pm = t / 22;
            ok[k] = idx < NIT && !((pm & 15) == 0 && q4 == 0); rr[k] = r;
            if (ok[k]) {
                const size_t bcur = ((size_t)pm * 22 + pn) * 4 + q4, bprev = q4 ? bcur - 1 : ((size_t)(pm - 1) * 22 + pn) * 4 + 3;
                const float* Tl = TAIL + bprev * 256 + ch; const float* H = HEAD + bcur * 512 + ch; const int c = 128 * pn + ch;
                w0[k] = *(const f32x4*)(cw + c); w1[k] = *(const f32x4*)(cw + DFF + c); w2[k] = *(const f32x4*)(cw + 2 * DFF + c); bb[k] = *(const f32x4*)(cb + c);
                gm2[k] = *(const f32x4*)Tl; gm1[k] = *(const f32x4*)(Tl + 128); g0[k] = *(const f32x4*)H; g1[k] = *(const f32x4*)(H + 128); uu[k] = *(const f32x4*)(H + (2 + r) * 128);
                dst[k] = ((size_t)pm * 256 + q4 * 64 + r) * DFF + c;
            }
        }
#pragma unroll
        for (int k = 0; k < NB; ++k) if (ok[k]) {
            const f32x4 cg = rr[k] == 0 ? (w0[k] * gm2[k] + w1[k] * gm1[k] + w2[k] * g0[k] + bb[k]) : (w0[k] * gm1[k] + w1[k] * g0[k] + w2[k] * g1[k] + bb[k]);
            *(u32x2*)(ACT + dst[k]) = (u32x2){cvt_pk_bf16(silu_f(cg.x) * uu[k].x, silu_f(cg.y) * uu[k].y), cvt_pk_bf16(silu_f(cg.z) * uu[k].z, silu_f(cg.w) * uu[k].w)};
        }
    }
}
__device__ __forceinline__ void fixup_odd(const Params& P, int j, int gtid, int gthreads) {
    const float* TAIL = (const float*)(P.ws + WS_HALO2 + HALO_OT); const float* HEAD = (const float*)(P.ws + WS_HALO2 + HALO_OH);
    const float* cw = P.in[I_OCONV_W] + (size_t)j * 3 * 1024; const float* cb = P.in[I_OCONV_B] + (size_t)j * 1024; bf16_t* MIX = (bf16_t*)(P.ws + WS_R + R_MIX);
    constexpr int NIT = 128 * 16 * 4 * 2 * 16, NB = 2;
#pragma unroll 1
    for (int base = gtid; base < NIT; base += NB * gthreads) {
        f32x4 w0[NB], w1[NB], w2[NB], bb[NB], pm2[NB], pm1[NB], p0[NB], p1[NB], gb[NB]; bool ok[NB]; size_t dst[NB]; int rr[NB];
#pragma unroll
        for (int k = 0; k < NB; ++k) {
            const int idx = base + k * gthreads;
            const int ch = 4 * (idx & 15), r = (idx >> 4) & 1, q4 = (idx >> 5) & 3, t = idx >> 7, pn = t & 15, pm = t >> 4;
            ok[k] = idx < NIT && !((pm & 15) == 0 && q4 == 0); rr[k] = r;
            if (ok[k]) {
                const size_t bcur = ((size_t)pm * 16 + pn) * 4 + q4, bprev = q4 ? bcur - 1 : ((size_t)(pm - 1) * 16 + pn) * 4 + 3;
                const float* Tl = TAIL + bprev * 128 + ch; const float* H = HEAD + bcur * 256 + ch; const int c = 64 * pn + ch;
                w0[k] = *(const f32x4*)(cw + c); w1[k] = *(const f32x4*)(cw + 1024 + c); w2[k] = *(const f32x4*)(cw + 2048 + c); bb[k] = *(const f32x4*)(cb + c);
                pm2[k] = *(const f32x4*)Tl; pm1[k] = *(const f32x4*)(Tl + 64); p0[k] = *(const f32x4*)H; p1[k] = *(const f32x4*)(H + 64); gb[k] = *(const f32x4*)(H + (2 + r) * 64);
                dst[k] = ((size_t)pm * 256 + q4 * 64 + r) * DM + c;
            }
        }
#pragma unroll
        for (int k = 0; k < NB; ++k) if (ok[k]) {
            const f32x4 cv = rr[k] == 0 ? (w0[k] * pm2[k] + w1[k] * pm1[k] + w2[k] * p0[k] + bb[k]) : (w0[k] * pm1[k] + w1[k] * p0[k] + w2[k] * p1[k] + bb[k]);
            const f32x4 y = gb[k] * cv;
            *(u32x2*)(MIX + dst[k]) = (u32x2){cvt_pk_bf16(y.x, y.y), cvt_pk_bf16(y.z, y.w)};
        }
    }
}

#define MFMA16(a, b, c) __builtin_amdgcn_mfma_f32_16x16x32_bf16((a), (b), (c), 0, 0, 0)
constexpr int EH_STRIDE = 132;
__device__ __forceinline__ void s5_unit(const Params& P, LAS unsigned char* lds, int j, int b, int g, int wave, int lane) {
    const unsigned char* op = P.ws + WS_S5OP + (size_t)(j * 32 + g) * S5OP_STRIDE;
    const bf16_t* Km = (const bf16_t*)op; const bf16_t* Pm = (const bf16_t*)(op + S5OP_PM); const bf16_t* Qm = (const bf16_t*)(op + S5OP_QM); const f32x2* A16 = (const f32x2*)(op + S5OP_A16);
    const bf16_t* U = (const bf16_t*)(P.ws + WS_R + R_U); bf16_t* YG = (bf16_t*)(P.ws + WS_R + R_YG);
    const float* Dv = P.in[I_S5D] + (size_t)j * 512 + 16 * g;
    LAS float* EH = (LAS float*)lds;
    const int l15 = lane & 15, kb = lane >> 4;
    bf16x8 ub[2][8];
#pragma unroll
    for (int q = 0; q < 2; ++q) { const int chunk = 16 * (2 * wave + q) + l15;
#pragma unroll
        for (int ks = 0; ks < 8; ++ks) ub[q][ks] = *(const bf16x8*)(U + ((size_t)(b * SEQ + chunk * 16 + 2 * ks + (kb >> 1))) * 512 + 16 * g + 8 * (kb & 1)); }
#pragma unroll 2
    for (int mt = 0; mt < 8; ++mt) {
        f32x4 acc0 = (f32x4){0.f, 0.f, 0.f, 0.f}, acc1 = acc0;
#pragma unroll
        for (int ks = 0; ks < 8; ++ks) { const bf16x8 a = *(const bf16x8*)(Pm + (mt * 8 + ks) * 512 + 8 * lane); acc0 = MFMA16(a, ub[0][ks], acc0); acc1 = MFMA16(a, ub[1][ks], acc1); }
        *(LAS f32x4*)(EH + (16 * (2 * wave) + l15) * EH_STRIDE + 16 * mt + 4 * kb) = acc0;
        *(LAS f32x4*)(EH + (16 * (2 * wave + 1) + l15) * EH_STRIDE + 16 * mt + 4 * kb) = acc1;
    }
    __syncthreads();
    {
        const f32x2 a16 = A16[lane];
        LAS f32x2* HL = (LAS f32x2*)(lds + 256 * EH_STRIDE * 4);
        f32x2 h = (f32x2){0.f, 0.f};
#pragma unroll 4
        for (int k = 0; k < 32; ++k) {
            LAS f32x2* e = (LAS f32x2*)(EH + (32 * wave + k) * EH_STRIDE) + lane;
            const f32x2 ev = *e; *e = h;
            h = (f32x2){a16.x * h.x - a16.y * h.y + ev.x, a16.x * h.y + a16.y * h.x + ev.y};
        }
        HL[wave * 64 + lane] = h;
        f32x2 p32 = a16;
#pragma unroll
        for (int i = 0; i < 5; ++i) p32 = cmul(p32, p32);
        __syncthreads();
        f32x2 hin = (f32x2){0.f, 0.f};
        for (int v = 0; v < wave; ++v) { const f32x2 ev = HL[v * 64 + lane]; hin = (f32x2){p32.x * hin.x - p32.y * hin.y + ev.x, p32.x * hin.y + p32.y * hin.x + ev.y}; }
        if (wave > 0) {
            f32x2 t = hin;
#pragma unroll 4
            for (int k = 0; k < 32; ++k) {
                LAS f32x2* e = (LAS f32x2*)(EH + (32 * wave + k) * EH_STRIDE) + lane;
                const f32x2 ev = *e; *e = (f32x2){ev.x + t.x, ev.y + t.y};
                t = cmul(a16, t);
            }
        }
    }
    __syncthreads();
    {
        bf16x8 hb[2][4];
#pragma unroll
        for (int q = 0; q < 2; ++q) { const int chunk = 16 * (2 * wave + q) + l15;
#pragma unroll
            for (int ks = 0; ks < 4; ++ks) { const f32x4 h0 = *(const LAS f32x4*)(EH + chunk * EH_STRIDE + 32 * ks + 8 * kb), h1 = *(const LAS f32x4*)(EH + chunk * EH_STRIDE + 32 * ks + 8 * kb + 4); hb[q][ks] = as_bf16x8(pack8(h0, h1)); } }
        const f32x4 dv = *(const f32x4*)(Dv + 4 * kb);
#pragma unroll 2
        for (int mt = 0; mt < 16; ++mt) {
            f32x4 acc[2]; acc[0] = (f32x4){0.f, 0.f, 0.f, 0.f}; acc[1] = acc[0];
#pragma unroll
            for (int ks = 0; ks < 4; ++ks) { const bf16x8 a = *(const bf16x8*)(Qm + (mt * 4 + ks) * 512 + 8 * lane); acc[0] = MFMA16(a, hb[0][ks], acc[0]); acc[1] = MFMA16(a, hb[1][ks], acc[1]); }
#pragma unroll
            for (int ks = 0; ks < 8; ++ks) {
                if (2 * ks <= mt) { const int dd = mt - 2 * ks - (kb >> 1) + 1; const bf16x8 a = *(const bf16x8*)(Km + (dd * 16 + l15) * 16 + 8 * (kb & 1)); acc[0] = MFMA16(a, ub[0][ks], acc[0]); acc[1] = MFMA16(a, ub[1][ks], acc[1]); }
            }
#pragma unroll
            for (int q = 0; q < 2; ++q) {
                const int chunk = 16 * (2 * wave + q) + l15;
                const size_t off = ((size_t)(b * SEQ + chunk * 16 + mt)) * 512 + 16 * g + 4 * kb;
                const u32x2 uw = *(const u32x2*)(U + off);
                f32x4 y; y.x = acc[q].x + dv.x * bflo(uw.x); y.y = acc[q].y + dv.y * bfhi(uw.x); y.z = acc[q].z + dv.z * bflo(uw.y); y.w = acc[q].w + dv.w * bfhi(uw.y);
                *(u32x2*)(YG + off) = (u32x2){cvt_pk_bf16(gelu_tanh_f(y.x), gelu_tanh_f(y.y)), cvt_pk_bf16(gelu_tanh_f(y.z), gelu_tanh_f(y.w))};
            }
        }
    }
    __syncthreads();
}

constexpr int SROW = 8208;
constexpr int SEL_OFF = 16 * SROW;
__device__ __forceinline__ unsigned tr_pair_lo_hi(unsigned a0, unsigned a1, s16x4& lo, s16x4& hi) {
    asm volatile("ds_read_b64_tr_b16 %0, %2\n\tds_read_b64_tr_b16 %1, %3\n\ts_waitcnt lgkmcnt(0)" : "=&v"(lo), "=&v"(hi) : "v"(a0), "v"(a1) : "memory");
    return 0;
}
__device__ __forceinline__ void tr_quad(const unsigned (&a0)[4], const unsigned (&a1)[4], s16x4 (&lo)[4], s16x4 (&hi)[4]) {
    asm volatile("ds_read_b64_tr_b16 %0, %8\n\tds_read_b64_tr_b16 %1, %9\n\tds_read_b64_tr_b16 %2, %10\n\tds_read_b64_tr_b16 %3, %11\n\t"
                 "ds_read_b64_tr_b16 %4, %12\n\tds_read_b64_tr_b16 %5, %13\n\tds_read_b64_tr_b16 %6, %14\n\tds_read_b64_tr_b16 %7, %15\n\ts_waitcnt lgkmcnt(0)"
                 : "=&v"(lo[0]), "=&v"(lo[1]), "=&v"(lo[2]), "=&v"(lo[3]), "=&v"(hi[0]), "=&v"(hi[1]), "=&v"(hi[2]), "=&v"(hi[3])
                 : "v"(a0[0]), "v"(a0[1]), "v"(a0[2]), "v"(a0[3]), "v"(a1[0]), "v"(a1[1]), "v"(a1[2]), "v"(a1[3]) : "memory");
}
template <int OFF>
__device__ __forceinline__ void tr_quad_off(const unsigned (&a0)[4], const unsigned (&a1)[4], s16x4 (&lo)[4], s16x4 (&hi)[4]) {
    asm volatile("ds_read_b64_tr_b16 %0, %8 offset:%16\n\tds_read_b64_tr_b16 %1, %9 offset:%16\n\tds_read_b64_tr_b16 %2, %10 offset:%16\n\tds_read_b64_tr_b16 %3, %11 offset:%16\n\t"
                 "ds_read_b64_tr_b16 %4, %12 offset:%16\n\tds_read_b64_tr_b16 %5, %13 offset:%16\n\tds_read_b64_tr_b16 %6, %14 offset:%16\n\tds_read_b64_tr_b16 %7, %15 offset:%16\n\ts_waitcnt lgkmcnt(0)"
                 : "=&v"(lo[0]), "=&v"(lo[1]), "=&v"(lo[2]), "=&v"(lo[3]), "=&v"(hi[0]), "=&v"(hi[1]), "=&v"(hi[2]), "=&v"(hi[3])
                 : "v"(a0[0]), "v"(a0[1]), "v"(a0[2]), "v"(a0[3]), "v"(a1[0]), "v"(a1[1]), "v"(a1[2]), "v"(a1[3]), "n"(OFF) : "memory");
}
template <int OFF>
__device__ __forceinline__ void tr_issue_off(const unsigned (&a0)[4], const unsigned (&a1)[4], s16x4 (&lo)[4], s16x4 (&hi)[4]) {
    asm volatile("ds_read_b64_tr_b16 %0, %8 offset:%16\n\tds_read_b64_tr_b16 %1, %9 offset:%16\n\tds_read_b64_tr_b16 %2, %10 offset:%16\n\tds_read_b64_tr_b16 %3, %11 offset:%16\n\t"
                 "ds_read_b64_tr_b16 %4, %12 offset:%16\n\tds_read_b64_tr_b16 %5, %13 offset:%16\n\tds_read_b64_tr_b16 %6, %14 offset:%16\n\tds_read_b64_tr_b16 %7, %15 offset:%16"
                 : "=&v"(lo[0]), "=&v"(lo[1]), "=&v"(lo[2]), "=&v"(lo[3]), "=&v"(hi[0]), "=&v"(hi[1]), "=&v"(hi[2]), "=&v"(hi[3])
                 : "v"(a0[0]), "v"(a0[1]), "v"(a0[2]), "v"(a0[3]), "v"(a1[0]), "v"(a1[1]), "v"(a1[2]), "v"(a1[3]), "n"(OFF) : "memory");
}
__device__ __forceinline__ void tr_wait16(s16x4 (&l0)[4], s16x4 (&h0)[4], s16x4 (&l1)[4], s16x4 (&h1)[4]) {
    asm volatile("s_waitcnt lgkmcnt(0)" : "+v"(l0[0]), "+v"(l0[1]), "+v"(l0[2]), "+v"(l0[3]), "+v"(h0[0]), "+v"(h0[1]), "+v"(h0[2]), "+v"(h0[3]),
                 "+v"(l1[0]), "+v"(l1[1]), "+v"(l1[2]), "+v"(l1[3]), "+v"(h1[0]), "+v"(h1[1]), "+v"(h1[2]), "+v"(h1[3]) :: "memory");
}
__device__ __forceinline__ bf16x8 join8(s16x4 lo, s16x4 hi) { bf16x8 r; r[0] = lo[0]; r[1] = lo[1]; r[2] = lo[2]; r[3] = lo[3]; r[4] = hi[0]; r[5] = hi[1]; r[6] = hi[2]; r[7] = hi[3]; return r; }

struct Mask8 { unsigned long long m[8]; };
__device__ __forceinline__ Mask8 ge_masks8(unsigned t, unsigned k0, unsigned k1, unsigned k2, unsigned k3, unsigned k4, unsigned k5, unsigned k6, unsigned k7) {
    Mask8 r;
    asm("v_cmp_le_u32_e64 %0, %8, %9\n\tv_cmp_le_u32_e64 %1, %8, %10\n\tv_cmp_le_u32_e64 %2, %8, %11\n\tv_cmp_le_u32_e64 %3, %8, %12\n\t"
        "v_cmp_le_u32_e64 %4, %8, %13\n\tv_cmp_le_u32_e64 %5, %8, %14\n\tv_cmp_le_u32_e64 %6, %8, %15\n\tv_cmp_le_u32_e64 %7, %8, %16"
        : "=&s"(r.m[0]), "=&s"(r.m[1]), "=&s"(r.m[2]), "=&s"(r.m[3]), "=&s"(r.m[4]), "=&s"(r.m[5]), "=&s"(r.m[6]), "=&s"(r.m[7])
        : "s"(t), "v"(k0), "v"(k1), "v"(k2), "v"(k3), "v"(k4), "v"(k5), "v"(k6), "v"(k7));
    return r;
}
__device__ __forceinline__ int cnt_ge8(unsigned t, unsigned k0, unsigned k1, unsigned k2, unsigned k3, unsigned k4, unsigned k5, unsigned k6, unsigned k7) {
    const Mask8 r = ge_masks8(t, k0, k1, k2, k3, k4, k5, k6, k7);
    return (__popcll(r.m[0]) + __popcll(r.m[1])) + (__popcll(r.m[2]) + __popcll(r.m[3])) + (__popcll(r.m[4]) + __popcll(r.m[5])) + (__popcll(r.m[6]) + __popcll(r.m[7]));
}
__device__ __forceinline__ int mbcnt64(unsigned long long m, int base) { return __builtin_amdgcn_mbcnt_hi((unsigned)(m >> 32), __builtin_amdgcn_mbcnt_lo((unsigned)m, base)); }
__device__ __forceinline__ float relu_i(float x) { const int i = __builtin_bit_cast(int, x); return __builtin_bit_cast(float, i > 0 ? i : 0); }
typedef _Float16 f16x2 __attribute__((ext_vector_type(2)));
typedef short i16x2 __attribute__((ext_vector_type(2)));
__device__ __forceinline__ unsigned sortkey2(float a, float b) {
    const f16x2 h = (f16x2){(_Float16)a, (_Float16)b};
    const i16x2 m = __builtin_bit_cast(i16x2, h) >> 15;
    const unsigned u = __builtin_bit_cast(unsigned, h);
    return u ^ (__builtin_bit_cast(unsigned, m) | 0x80008000u);
}
__device__ __forceinline__ float xrow_max(float v) {
    float a = v, b = v;
    asm("s_nop 1\n\tv_permlane32_swap_b32_e32 %0, %1\n\ts_nop 1\n\tv_max_f32_e32 %0, %0, %1\n\tv_mov_b32_e32 %1, %0\n\ts_nop 1\n\tv_permlane16_swap_b32_e32 %0, %1\n\ts_nop 1\n\tv_max_f32_e32 %0, %0, %1" : "+v"(a), "+v"(b));
    return a;
}
__device__ __forceinline__ int cnt_ge4(unsigned t, unsigned k0, unsigned k1, unsigned k2, unsigned k3) {
    unsigned long long m0, m1, m2, m3;
    asm("v_cmp_le_u32_e64 %0, %4, %5\n\tv_cmp_le_u32_e64 %1, %4, %6\n\tv_cmp_le_u32_e64 %2, %4, %7\n\tv_cmp_le_u32_e64 %3, %4, %8"
        : "=&s"(m0), "=&s"(m1), "=&s"(m2), "=&s"(m3) : "s"(t), "v"(k0), "v"(k1), "v"(k2), "v"(k3));
    return (__popcll(m0) + __popcll(m1)) + (__popcll(m2) + __popcll(m3));
}
template <int NR, int SH>
__device__ __forceinline__ void dsa_pick(const unsigned (&kk)[NR], LAS unsigned short* sel, int lane, int cge0, unsigned floorT) {
    unsigned T = 0; int cge = cge0;
#pragma unroll 1
    for (int bit = 15; bit >= 0; --bit) {
        const unsigned trial = T | (1u << bit); int cnt = 0;
        if (trial <= floorT) { T = trial; cge = cge0; continue; }
#pragma unroll
        for (int i = 0; i < NR; i += 8) cnt += cnt_ge8(trial << SH, kk[i], kk[i + 1], kk[i + 2], kk[i + 3], kk[i + 4], kk[i + 5], kk[i + 6], kk[i + 7]);
        if (cnt >= 256) { T = trial; cge = cnt; }
    }
    const unsigned tge = T << SH, tgt = (SH && T >= 0xffffu) ? 0xffffffffu : ((T + 1u) << SH);
    int out_base = 0;
    if (cge == 256) {
#pragma unroll
        for (int i = 0; i < NR; i += 8) {
            const Mask8 ge = ge_masks8(tge, kk[i], kk[i + 1], kk[i + 2], kk[i + 3], kk[i + 4], kk[i + 5], kk[i + 6], kk[i + 7]);
#pragma unroll
            for (int j = 0; j < 8; ++j) {
                const unsigned long long tm = ge.m[j];
                const int pos = mbcnt64(tm, out_base);
                if (__builtin_amdgcn_inverse_ballot_w64(tm)) sel[pos] = (unsigned short)(SH ? (kk[i + j] & 0xffffu) : (unsigned)(64 * (i + j) + lane));
                out_base += __popcll(tm);
            }
        }
    } else {
        int room;
        { int cgt = 0;
#pragma unroll
          for (int i = 0; i < NR; i += 8) cgt += cnt_ge8(tgt, kk[i], kk[i + 1], kk[i + 2], kk[i + 3], kk[i + 4], kk[i + 5], kk[i + 6], kk[i + 7]);
          room = 256 - cgt; }
#pragma unroll
        for (int i = 0; i < NR; i += 8) {
            const Mask8 ge = ge_masks8(tge, kk[i], kk[i + 1], kk[i + 2], kk[i + 3], kk[i + 4], kk[i + 5], kk[i + 6], kk[i + 7]);
            const Mask8 gt = ge_masks8(tgt, kk[i], kk[i + 1], kk[i + 2], kk[i + 3], kk[i + 4], kk[i + 5], kk[i + 6], kk[i + 7]);
#pragma unroll
            for (int j = 0; j < 8; ++j) {
                unsigned long long tm = gt.m[j], eqm = ge.m[j] & ~gt.m[j];
                if (eqm != 0ull) {
                    const int ec = __popcll(eqm);
                    if (ec <= room) { tm |= eqm; room -= ec; }
                    else { while (room > 0) { const unsigned long long low = eqm & (0ull - eqm); tm |= low; eqm ^= low; --room; } }
                }
                const int pos = mbcnt64(tm, out_base);
                if (__builtin_amdgcn_inverse_ballot_w64(tm)) sel[pos] = (unsigned short)(SH ? (kk[i + j] & 0xffffu) : (unsigned)(64 * (i + j) + lane));
                out_base += __popcll(tm);
            }
        }
    }
}
template <int NR>
__device__ __forceinline__ void dsa_select(LAS unsigned char* lds, int q, int L, int lane) {
    const LAS unsigned short* srow = (const LAS unsigned short*)(lds + q * SROW);
    LAS unsigned short* sel = (LAS unsigned short*)(lds + SEL_OFF + q * 512);
    const int nreg = L >> 6;
    unsigned kk[NR];
#pragma unroll
    for (int i = 0; i < NR; ++i) kk[i] = (i < nreg) ? (unsigned)srow[64 * i + lane] : 0u;
    if constexpr (NR >= 32) {
        const int c0 = min(500, (448 * 512) / L + 8);
        unsigned Ts = 0;
#pragma unroll 1
        for (int bit = 15; bit >= 6; --bit) { const unsigned trial = Ts | (1u << bit);
            if (cnt_ge8(trial, kk[0], kk[NR / 8], kk[2 * NR / 8], kk[3 * NR / 8], kk[4 * NR / 8], kk[5 * NR / 8], kk[6 * NR / 8], kk[7 * NR / 8]) >= c0) Ts = trial; }
        int ncand = 0;
#pragma unroll
        for (int i = 0; i < NR; i += 8) ncand += cnt_ge8(Ts, kk[i], kk[i + 1], kk[i + 2], kk[i + 3], kk[i + 4], kk[i + 5], kk[i + 6], kk[i + 7]);
        if (Ts >= 1u && ncand >= 256 && ncand <= 2048) {
            LAS unsigned* cand = (LAS unsigned*)(lds + q * SROW);
            int base = 0;
#pragma unroll
            for (int i = 0; i < NR; i += 8) {
                const Mask8 ge = ge_masks8(Ts, kk[i], kk[i + 1], kk[i + 2], kk[i + 3], kk[i + 4], kk[i + 5], kk[i + 6], kk[i + 7]);
#pragma unroll
                for (int j = 0; j < 8; ++j) {
                    const unsigned long long tm = ge.m[j];
                    const int pos = mbcnt64(tm, base);
                    if (__builtin_amdgcn_inverse_ballot_w64(tm)) cand[pos] = (kk[i + j] << 16) | (unsigned)(64 * (i + j) + lane);
                    base += __popcll(tm);
                }
            }
            LDS_WAIT();
            if (ncand <= 512) {
                unsigned cc[8];
#pragma unroll
                for (int i = 0; i < 8; ++i) cc[i] = (64 * i + lane < ncand) ? cand[64 * i + lane] : 0u;
                dsa_pick<8, 16>(cc, sel, lane, ncand, Ts);
            } else if (ncand <= 1024) {
                unsigned cc[16];
#pragma unroll
                for (int i = 0; i < 16; ++i) cc[i] = (64 * i + lane < ncand) ? cand[64 * i + lane] : 0u;
                dsa_pick<16, 16>(cc, sel, lane, ncand, Ts);
            } else {
                unsigned cc[32];
#pragma unroll
                for (int i = 0; i < 32; ++i) cc[i] = (64 * i + lane < ncand) ? cand[64 * i + lane] : 0u;
                dsa_pick<32, 16>(cc, sel, lane, ncand, Ts);
            }
            return;
        }
    }
    dsa_pick<NR, 0>(kk, sel, lane, NR * 64, 0u);
}

__device__ __forceinline__ void dsa_unit(const Params& P, LAS unsigned char* lds, int b, int t0, int L, int wave, int lane, float negB) {
    const bf16_t* Q = (const bf16_t*)(P.ws + WS_R + R_Q); const bf16_t* KV = (const bf16_t*)(P.ws + WS_R + R_KV); const bf16_t* IK = (const bf16_t*)(P.ws + WS_R + R_IK);
    const bf16_t* IQ = (const bf16_t*)(P.ws + WS_R + R_IQ); const float* IW = (const float*)(P.ws + WS_R + R_IW); bf16_t* A2 = (bf16_t*)(P.ws + WS_R + R_A2);
    lane = fresh_tid() & 63;
    const int l15 = lane & 15, kb = lane >> 4;
    const size_t row0 = (size_t)b * SEQ + t0;
#pragma unroll 1
    for (int rep_ = 0; rep_ < ((MK_DSA_REP & 1) ? 2 : 1); ++rep_)
    if (L > 256) {
        bf16x8 iqf[4][2];
#pragma unroll
        for (int h = 0; h < 4; ++h)
#pragma unroll
            for (int ks = 0; ks < 2; ++ks) iqf[h][ks] = *(const bf16x8*)(IQ + (row0 + l15) * 256 + h * 64 + 32 * ks + 8 * kb);
        const f32x4 iw = *(const f32x4*)(IW + (row0 + l15) * 4);
        const int ntile = L >> 4;
        bf16x8 a0[4], a1[4], b0[4], b1[4];
        const bf16_t* ikb = IK + (size_t)b * SEQ * 64 + 8 * lane;
#define DSA_LOAD4(x0, x1, tb_) do { const int tb__ = ((tb_) < ntile) ? (tb_) : wave; _Pragma("unroll") for (int j = 0; j < 4; ++j) { const int t = (tb__ + 8 * j < ntile) ? tb__ + 8 * j : tb__; \
            const bf16_t* kp = ikb + (size_t)t * 1024; x0[j] = *(const bf16x8*)kp; x1[j] = *(const bf16x8*)(kp + 512); } } while (0)
#define DSA_SCORE4(x0, x1, tb_) do { _Pragma("unroll") for (int j = 0; j < 4; ++j) { const int t = (tb_) + 8 * j; if (t < ntile) { \
            f32x4 s = (f32x4){0.f, 0.f, 0.f, 0.f}; \
            _Pragma("unroll") for (int h = 0; h < 4; ++h) { f32x4 acc = (f32x4){0.f, 0.f, 0.f, 0.f}; acc = MFMA16(x0[j], iqf[h][0], acc); acc = MFMA16(x1[j], iqf[h][1], acc); const float w = iw[h]; \
                s.x += w * relu_i(acc.x); s.y += w * relu_i(acc.y); s.z += w * relu_i(acc.z); s.w += w * relu_i(acc.w); } \
            *(LAS u32x2*)(lds + l15 * SROW + 2 * (16 * t + 4 * kb)) = (u32x2){sortkey2(s.x, s.y), sortkey2(s.z, s.w)}; } } } while (0)
        DSA_LOAD4(a0, a1, wave);
#pragma unroll 1
        for (int t0 = wave; t0 < ntile; t0 += 64) {
            DSA_LOAD4(b0, b1, t0 + 32);
            DSA_SCORE4(a0, a1, t0);
            if (t0 + 32 >= ntile) break;
            DSA_LOAD4(a0, a1, t0 + 64);
            DSA_SCORE4(b0, b1, t0 + 32);
        }
#undef DSA_LOAD4
#undef DSA_SCORE4
    }
    __syncthreads();
    const int nsel = L < 256 ? L : 256;
#pragma unroll 1
    for (int rep_ = 0; rep_ < ((MK_DSA_REP & 2) ? 2 : 1); ++rep_)
#pragma unroll 1
    for (int qq = 0; qq < 2; ++qq) {
        const int q = 2 * wave + qq;
        LAS unsigned short* sel = (LAS unsigned short*)(lds + SEL_OFF + q * 512);
        if (L <= 256) {
#pragma unroll
            for (int i = 0; i < 4; ++i) { const int jx = 64 * i + lane; sel[jx] = (unsigned short)(jx < L ? jx : 0); }
        } else if (L <= 1024) dsa_select<16>(lds, q, L, lane);
        else if (L <= 2048) dsa_select<32>(lds, q, L, lane);
        else if (L <= 3072) dsa_select<48>(lds, q, L, lane);
        else dsa_select<64>(lds, q, L, lane);
    }
    LDS_WAIT();
    {
    const int lane = fresh_tid() & 63, l15 = lane & 15, kb = lane >> 4;
    LAS unsigned char* KBUF = lds + (2 * wave) * SROW; LAS unsigned char* VBUF = KBUF + 8192;
    const unsigned vb_addr = (unsigned)(uintptr_t)VBUF;
    const int qd = l15 >> 2, pp = lane & 3;
    const int nblk = nsel >> 6, ntot = 2 * nblk;
    const bf16_t* KVb = KV + (size_t)b * SEQ * 128;
    const __amdgpu_buffer_rsrc_t rkv = __builtin_amdgcn_make_buffer_rsrc((void*)KVb, 0, 0x7fffffff, 0x00020000);
    const unsigned klane0 = 16u * ((lane & 7) ^ (lane >> 4)), klane1 = 16u * ((lane & 7) ^ (4 + (lane >> 4)));
    const unsigned vlane = 128u + 16u * ((lane & 7) ^ (2 * kb));
    const LAS unsigned char* kfr0 = KBUF + 128 * l15 + 16 * ((0 + kb) ^ ((l15 >> 1) & 7));
    const LAS unsigned char* kfr1 = KBUF + 128 * l15 + 16 * ((4 + kb) ^ ((l15 >> 1) & 7));
    unsigned ta0[2][4], ta1[2][4];
#pragma unroll
    for (int s2 = 0; s2 < 2; ++s2) { const int r0 = 32 * s2 + 4 * kb + qd, r1 = r0 + 16;
#pragma unroll
        for (int mt = 0; mt < 4; ++mt) {
            ta0[s2][mt] = vb_addr + 128 * r0 + 16 * ((2 * mt + (pp >> 1)) ^ (2 * ((r0 >> 1) & 3))) + 8 * (pp & 1);
            ta1[s2][mt] = vb_addr + 128 * r1 + 16 * ((2 * mt + (pp >> 1)) ^ (2 * ((r1 >> 1) & 3))) + 8 * (pp & 1); } }
    const LAS unsigned short* selw = (const LAS unsigned short*)(lds + SEL_OFF + (2 * wave) * 512);
#define DSA_SELP(g_) (selw + (((g_) >= nblk) ? 256 + 64 * ((g_) - nblk) : 64 * (g_)))
#define DSA_DMAK(sv) do { _Pragma("unroll") for (int i = 0; i < 8; ++i) __builtin_amdgcn_raw_ptr_buffer_load_lds(rkv, (LAS void*)(KBUF + 1024 * i), 16, (int)(sv[i] * 256u + ((i & 1) ? klane1 : klane0)), 0, 0, 0); } while (0)
#define DSA_DMAV(sv) do { _Pragma("unroll") for (int i = 0; i < 8; ++i) __builtin_amdgcn_raw_ptr_buffer_load_lds(rkv, (LAS void*)(VBUF + 1024 * i), 16, (int)(sv[i] * 256u + vlane), 0, 0, 0); } while (0)
#define DSA_LOADQ(qx, qi_) do { const size_t row_ = row0 + 2 * wave + (qi_); _Pragma("unroll") for (int ks = 0; ks < 2; ++ks) { u32x4 z = (u32x4){0u, 0u, 0u, 0u}; if (l15 < 8) z = *(const u32x4*)(Q + row_ * 512 + l15 * 64 + 32 * ks + 8 * kb); qx[ks] = as_bf16x8(z); } } while (0)
#pragma unroll 1
    for (int rep_ = 0; rep_ < ((MK_DSA_REP & 4) ? 2 : 1); ++rep_) {
        bf16x8 qf[2], qfn[2];
        f32x4 o[4];
#pragma unroll
        for (int mt = 0; mt < 4; ++mt) o[mt] = (f32x4){0.f, 0.f, 0.f, 0.f};
        float lsum = 0.f;
        const f32x4 negB4 = (f32x4){negB, negB, negB, negB};
        DSA_LOADQ(qf, 0); DSA_LOADQ(qfn, 1);
        unsigned sv[8];
        { const LAS unsigned short* sp_ = DSA_SELP(0);
#pragma unroll
          for (int i = 0; i < 8; ++i) sv[i] = sp_[8 * i + (lane >> 3)]; }
        DSA_DMAK(sv); DSA_DMAV(sv);
#pragma unroll 1
        for (int g = 0; g < ntot; ++g) {
            const int qi = (g >= nblk) ? 1 : 0, blk = g - qi * nblk;
            const bool more1 = g + 1 < ntot, qlast = (blk == nblk - 1);
            asm volatile("s_waitcnt vmcnt(8)" ::: "memory");
            bf16x8 kc[4][2];
#pragma unroll
            for (int t = 0; t < 4; ++t) { kc[t][0] = *(const LAS bf16x8*)(kfr0 + 2048 * t); kc[t][1] = *(const LAS bf16x8*)(kfr1 + 2048 * t); }
            if (more1) { const LAS unsigned short* sp_ = DSA_SELP(g + 1);
#pragma unroll
                for (int i = 0; i < 8; ++i) sv[i] = sp_[8 * i + (lane >> 3)]; }
            asm volatile("s_waitcnt lgkmcnt(0)" ::: "memory");
            if (more1) DSA_DMAK(sv);
            f32x4 s[4];
#pragma unroll
            for (int t = 0; t < 4; ++t) { f32x4 acc = negB4; acc = MFMA16(kc[t][0], qf[0], acc); acc = MFMA16(kc[t][1], qf[1], acc); s[t] = acc; }
            if (more1) asm volatile("s_waitcnt vmcnt(8)" ::: "memory"); else asm volatile("s_waitcnt vmcnt(0)" ::: "memory");
            s16x4 lo0[4], hi0[4], lo1[4], hi1[4];
            tr_issue_off<0>(ta0[0], ta1[0], lo0, hi0); tr_issue_off<0>(ta0[1], ta1[1], lo1, hi1);
#pragma unroll
            for (int t = 0; t < 4; ++t) { s[t].x = __builtin_amdgcn_exp2f(s[t].x); s[t].y = __builtin_amdgcn_exp2f(s[t].y); s[t].z = __builtin_amdgcn_exp2f(s[t].z); s[t].w = __builtin_amdgcn_exp2f(s[t].w); lsum += (s[t].x + s[t].y) + (s[t].z + s[t].w); }
            tr_wait16(lo0, hi0, lo1, hi1);
            if (more1) DSA_DMAV(sv);
            { const bf16x8 pf = as_bf16x8(pack8(s[0], s[1]));
#pragma unroll
              for (int mt = 0; mt < 4; ++mt) o[mt] = MFMA16(join8(lo0[mt], hi0[mt]), pf, o[mt]); }
            { const bf16x8 pf = as_bf16x8(pack8(s[2], s[3]));
#pragma unroll
              for (int mt = 0; mt < 4; ++mt) o[mt] = MFMA16(join8(lo1[mt], hi1[mt]), pf, o[mt]); }
            if (qlast) {
                float ls = lsum; ls += __shfl_xor(ls, 16); ls += __shfl_xor(ls, 32);
                const float inv = 1.f / ls;
                const size_t row = row0 + 2 * wave + qi;
                if (l15 < 8) {
#pragma unroll
                    for (int mt = 0; mt < 4; ++mt) *(u32x2*)(A2 + row * 1024 + l15 * 64 + 16 * mt + 4 * kb) = (u32x2){cvt_pk_bf16(o[mt].x * inv, o[mt].y * inv), cvt_pk_bf16(o[mt].z * inv, o[mt].w * inv)};
                }
#pragma unroll
                for (int mt = 0; mt < 4; ++mt) o[mt] = (f32x4){0.f, 0.f, 0.f, 0.f};
                lsum = 0.f; qf[0] = qfn[0]; qf[1] = qfn[1];
            }
        }
        asm volatile("s_waitcnt vmcnt(0)" ::: "memory");
    }
#undef DSA_SELP
#undef DSA_DMAK
#undef DSA_DMAV
#undef DSA_LOADQ
    }
    __syncthreads();
}

__device__ __forceinline__ unsigned off_b(unsigned row, unsigned ch) { return 256u * row + 16u * (ch ^ (((row & 3) << 2) | ((row >> 2) & 3))); }
__device__ __forceinline__ void xattn_wg(const Params& P, LAS unsigned char* lds, int layer, int wg, int wave, int lane) {
    const bf16_t* MKV = (const bf16_t*)(P.ws + WS_MEMKV) + (size_t)layer * MEMTOK * 1024; const bf16_t* QX = (const bf16_t*)(P.ws + WS_R + R_QX); bf16_t* OX = (bf16_t*)(P.ws + WS_R + R_OX);
    const float* MSS = (const float*)(P.ws + WS_MEMSS) + (size_t)layer * MEMTOK * 8; const float* QSS = (const float*)(P.ws + WS_QSS);
    const float* gkn = P.in[I_XKN] + layer * 128; const float* gqn = P.in[I_XQN] + layer * 128;
    const int tid = wave * 64 + lane, l15 = lane & 15, kb = lane >> 4, qd = l15 >> 2, pp = lane & 3;
    f32x4 negB4;
    { const float gq = wave_max(fmaxf(fabsf(gqn[lane]), fabsf(gqn[lane + 64]))), gk = wave_max(fmaxf(fabsf(gkn[lane]), fabsf(gkn[lane + 64])));
      const float nb = -fminf(40.f, 128.f * 0.08838834764831845f * 1.4426950408889634f * 1.002f * gq * gk); negB4 = (f32x4){nb, nb, nb, nb}; }
    LAS unsigned char* KI = lds; LAS unsigned char* VI = lds + 65536;
    const unsigned vi_addr = (unsigned)(uintptr_t)VI;
    const int bh = (2 * wg) >> 4, b = bh >> 2, head = bh & 3;
#pragma unroll
    for (int i = 0; i < 8; ++i) {
        const int id = tid + 512 * i, rw = id >> 4, ch = id & 15;
        const bf16_t* src = MKV + ((size_t)b * NMEM + rw) * 1024 + head * 128 + 8 * ch;
        const f32x2 kp = *(const f32x2*)(MSS + ((size_t)b * NMEM + rw) * 8 + head * 2);
        const float rk = rsqrtf((kp.x + kp.y) * (1.f / 128.f) + EPS);
        const f32x4 ga = *(const f32x4*)(gkn + 8 * ch) * rk, gb = *(const f32x4*)(gkn + 8 * ch + 4) * rk;
        const u32x4 kr = *(const u32x4*)src;
        *(LAS u32x4*)(KI + off_b(rw, ch)) = pack8((f32x4){bflo(kr.x), bfhi(kr.x), bflo(kr.y), bfhi(kr.y)} * ga, (f32x4){bflo(kr.z), bfhi(kr.z), bflo(kr.w), bfhi(kr.w)} * gb);
        *(LAS u32x4*)(VI + off_b(rw, ch)) = *(const u32x4*)(src + 512);
    }
    __syncthreads();
    unsigned kadr[4], vadr0[2][2][4], vadr1[2][2][4];
#pragma unroll
    for (int ks = 0; ks < 4; ++ks) kadr[ks] = off_b(l15, 4 * ks + kb);
#pragma unroll
    for (int s2 = 0; s2 < 2; ++s2) { const unsigned r0 = 32 * s2 + 4 * kb + qd, r1 = r0 + 16;
#pragma unroll
        for (int mq = 0; mq < 2; ++mq)
#pragma unroll
            for (int k = 0; k < 4; ++k) { const int mt = 4 * mq + k; vadr0[s2][mq][k] = vi_addr + off_b(r0, 2 * mt + (pp >> 1)) + 8 * (pp & 1); vadr1[s2][mq][k] = vi_addr + off_b(r1, 2 * mt + (pp >> 1)) + 8 * (pp & 1); } }
#define XA_ROW(gi_) ((size_t)b * SEQ + ((2 * wg + ((gi_) >> 1)) & 15) * 256 + 16 * (2 * wave + ((gi_) & 1)) + l15)
#define XA_LOADQ(gi_) do { const size_t r_ = XA_ROW(gi_); qp = *(const f32x2*)(QSS + r_ * 8 + head * 2); _Pragma("unroll") for (int ks = 0; ks < 4; ++ks) qr[ks] = *(const u32x4*)(QX + r_ * 512 + head * 128 + 32 * ks + 8 * kb); } while (0)
    u32x4 qr[4]; f32x2 qp;
    XA_LOADQ(0);
#pragma unroll 1
    for (int gi = 0; gi < 4; ++gi) {
        {
            const size_t r = XA_ROW(gi);
            bf16x8 qf[4];
            {
                const float rn = rsqrtf((qp.x + qp.y) * (1.f / 128.f) + EPS) * (0.08838834764831845f * 1.4426950408889634f);
#pragma unroll
                for (int ks = 0; ks < 4; ++ks) {
                    const f32x4 ga = *(const f32x4*)(gqn + 32 * ks + 8 * kb) * rn, gb = *(const f32x4*)(gqn + 32 * ks + 8 * kb + 4) * rn;
                    qf[ks] = as_bf16x8(pack8((f32x4){bflo(qr[ks].x), bfhi(qr[ks].x), bflo(qr[ks].y), bfhi(qr[ks].y)} * ga, (f32x4){bflo(qr[ks].z), bfhi(qr[ks].z), bflo(qr[ks].w), bfhi(qr[ks].w)} * gb));
                }
            }
            if (gi < 3) XA_LOADQ(gi + 1);
            f32x4 o[8];
#pragma unroll
            for (int mt = 0; mt < 8; ++mt) o[mt] = (f32x4){0.f, 0.f, 0.f, 0.f};
            float lsum = 0.f;
#pragma unroll
            for (int blk = 0; blk < 4; ++blk) {
                f32x4 s[4];
#pragma unroll
                for (int t = 0; t < 4; ++t) {
                    f32x4 acc = negB4;
#pragma unroll
                    for (int ks = 0; ks < 4; ++ks) { const bf16x8 a = *(const LAS bf16x8*)(KI + kadr[ks] + 256 * (64 * blk + 16 * t)); acc = MFMA16(a, qf[ks], acc); }
                    s[t] = acc;
                }
#pragma unroll
                for (int t = 0; t < 4; ++t) { s[t].x = __builtin_amdgcn_exp2f(s[t].x); s[t].y = __builtin_amdgcn_exp2f(s[t].y); s[t].z = __builtin_amdgcn_exp2f(s[t].z); s[t].w = __builtin_amdgcn_exp2f(s[t].w); lsum += (s[t].x + s[t].y) + (s[t].z + s[t].w); }
#pragma unroll
                for (int s2 = 0; s2 < 2; ++s2) {
                    const bf16x8 pf = as_bf16x8(pack8(s[2 * s2], s[2 * s2 + 1]));
#pragma unroll
                    for (int mq = 0; mq < 2; ++mq) {
                        s16x4 lo[4], hi[4];
                        if (blk == 0) tr_quad_off<256 * (0 + 0)>(vadr0[s2][mq], vadr1[s2][mq], lo, hi);
                        if (blk == 1) tr_quad_off<256 * 64>(vadr0[s2][mq], vadr1[s2][mq], lo, hi);
                        if (blk == 2) tr_quad_off<256 * 128>(vadr0[s2][mq], vadr1[s2][mq], lo, hi);
                        if (blk == 3) tr_quad_off<256 * 192>(vadr0[s2][mq], vadr1[s2][mq], lo, hi);
#pragma unroll
                        for (int k = 0; k < 4; ++k) o[4 * mq + k] = MFMA16(join8(lo[k], hi[k]), pf, o[4 * mq + k]);
                    }
                }
            }
            lsum += __shfl_xor(lsum, 16); lsum += __shfl_xor(lsum, 32);
            const float inv = 1.f / lsum;
#pragma unroll
            for (int mt = 0; mt < 8; ++mt) *(u32x2*)(OX + r * 512 + head * 128 + 16 * mt + 4 * kb) = (u32x2){cvt_pk_bf16(o[mt].x * inv, o[mt].y * inv), cvt_pk_bf16(o[mt].z * inv, o[mt].w * inv)};
        }
    }
#undef XA_ROW
#undef XA_LOADQ
    __syncthreads();
}

#ifndef MK_MASK
#define MK_MASK 0xFFFFF
#endif
#define MKON(n) (((MK_MASK) >> (n)) & 1)
#ifndef MK_DUP
#define MK_DUP 0
#endif
#ifndef MK_DMASK
#define MK_DMASK 15
#endif
#ifndef MK_HI
#define MK_HI (1 << 20)
#endif
#define NREP(n) ((((MK_DUP) >> (n)) & 1) ? 2 : 1)
constexpr int LAST_PHASE = 2 + 16 * 3 + 9;
__global__ void __launch_bounds__(NTHREADS, 2) __attribute__((target("no-packed-fp32-ops"))) mk_fwd(Params P) {
    extern __shared__ __attribute__((aligned(16))) unsigned char lds_raw[];
    LAS unsigned char* lds = (LAS unsigned char*)lds_raw;
    const int tid = threadIdx.x, lane = tid & 63, wave = __builtin_amdgcn_readfirstlane(tid >> 6);
    const int G = gridDim.x, bx = blockIdx.x;
    const int NGW = G * NWAVES; (void)lane; (void)wave;
    volatile LAS unsigned* MISC = (volatile LAS unsigned*)(lds + LDSCTL_OFF);
    if (tid < 64) MISC[tid] = 0u;
    __syncthreads();
    unsigned* ctl = (unsigned*)(P.ws + WS_CTL);
    XcdBarrier bar = xcd_barrier_post(ctl + CW_BAR, MISC + 8);
    const int lo = P.ph_lo, hi = P.ph_hi;
#define IN(k) (lo <= (k) && (k) < hi)
#define FRESH const int ftid = fresh_tid(), flane = ftid & 63, fwave = __builtin_amdgcn_readfirstlane(ftid >> 6), fgw = bx * NWAVES + fwave; (void)fgw; (void)flane
#define SEAM(k) do { if ((k) < LAST_PHASE && (k) + 1 < hi) xcd_barrier(bar); } while (0)
    unsigned char* ws = P.ws;
    bf16_t* wb = (bf16_t*)(ws + WS_W);
    bf16_t* XB = (bf16_t*)(ws + WS_XB); float* SSQ = (float*)(ws + WS_SSQ16);

    if (MKON(0) && IN(0)) { FRESH; _Pragma("unroll 1") for (int rep = 0; rep < NREP(0); ++rep) prologue(P, lds, fgw, NGW, fwave, flane); SEAM(0);
#ifdef MK_BAR2
        { const unsigned long long t0 = __builtin_amdgcn_s_memrealtime(); while (__builtin_amdgcn_s_memrealtime() - t0 < 20000ull) __builtin_amdgcn_s_sleep(8); } xcd_barrier(bar); xcd_barrier(bar);
#endif
    }
    if (MKON(1) && IN(1)) {
        pg8::Gemm g{(const bf16_t*)(ws + WS_MEMB), (const bf16_t*)((char*)wb + W_XKV), DM, DM, DM}; pg8::StaticOrder S; S.init(MEMTOK, 4096, G, bx);
        EpiHead128<1> E{nullptr, (const float*)(ws + WS_MEMRS), (bf16_t*)(ws + WS_MEMKV), (float*)(ws + WS_MEMSS), lds};
        _Pragma("unroll 1") for (int rep = 0; rep < NREP(1); ++rep) pg8::gemm_phase<false>(lds, g, S, E); SEAM(1);
    }
#pragma unroll 1
    for (int layer = 0; layer < 4; ++layer) {
        const int pb = 2 + 16 * layer, j = layer >> 1;
        if ((layer & 1) == 0) {
            if (MKON(2) && IN(pb + 0)) {
                pg8::Gemm g{XB, (const bf16_t*)((char*)wb + W_EIN + j * 3 * MiB), DM, DM, DM}; pg8::StaticOrder S; S.init(NTOK, 1536, G, bx);
#ifdef MK_PLAIN_G1
                EpiPlain E{(bf16_t*)(ws + WS_R), 1536};
#else
                EpiEvenIn E{SSQ, P.in[I_AQN] + j * 64, P.in[I_AKN] + j * 64, (bf16_t*)(ws + WS_R + R_Q), (bf16_t*)(ws + WS_R + R_KV), (bf16_t*)(ws + WS_R + R_IK), (bf16_t*)(ws + WS_R + R_IQ), (bf16_t*)(ws + WS_R + R_U), (float*)(ws + WS_R + R_IW), lds};
#endif
                #ifdef MK_NOALIGN_G1
                pg8::gemm_phase<false>(lds, g, S, E); SEAM(pb + 0);
#else
                _Pragma("unroll 1") for (int rep = 0; rep < NREP(2); ++rep) pg8::gemm_phase<false>(lds, g, S, E); SEAM(pb + 0);
#endif
            }
            if (MKON(3) && IN(pb + 1)) {
                FRESH;
                _Pragma("unroll 1") for (int rep = 0; rep < NREP(15); ++rep)
                for (int task = bx; task < 256; task += G) s5_unit(P, lds, j, task & 7, task >> 3, fwave, flane);
                float negB;
                { const float gq = wave_max(fabsf(P.in[I_AQN][j * 64 + flane])), gk = wave_max(fabsf(P.in[I_AKN][j * 64 + flane]));
                  negB = -fminf(40.f, 64.f * 0.125f * 1.4426950408889634f * 1.002f * gq * gk); negB = __builtin_bit_cast(float, __builtin_amdgcn_readfirstlane(__builtin_bit_cast(int, negB))); }
                _Pragma("unroll 1") for (int rep = 0; rep < NREP(3); ++rep)
                for (int w2 = bx; w2 < 256; w2 += G) {
                    const int b = w2 & 7, r = w2 >> 3;
#pragma unroll 1
                    for (int k = 0; k < 8; ++k) { const int cc = (k < 4) ? r : 63 - r; dsa_unit(P, lds, b, 64 * cc + 16 * (k & 3), 64 * (cc + 1), fwave, flane, negB); }
                }
                SEAM(pb + 1);
            }
            if (MKON(4) && IN(pb + 2)) {
                pg8::Gemm g{(const bf16_t*)(ws + WS_R + R_YG), (const bf16_t*)((char*)wb + W_GLU + j * (MiB / 2)), 512, 512, 512}; pg8::StaticOrder S; S.init(NTOK, 512, G, bx);
                EpiGlu E{(const bf16_t*)(ws + WS_R + R_YG), P.in[I_BGLU] + j * 512, (bf16_t*)(ws + WS_R + R_A2)};
                _Pragma("unroll 1") for (int rep = 0; rep < NREP(4); ++rep) pg8::gemm_phase<false>(lds, g, S, E); SEAM(pb + 2);
            }
            if (MKON(5) && IN(pb + 3)) {
                pg8::Gemm g{(const bf16_t*)(ws + WS_R + R_A2), (const bf16_t*)((char*)wb + W_EOUT + j * 2 * MiB), DM, DM, DM}; pg8::StaticOrder S; S.init(NTOK, DM, G, bx);
                EpiResidual E{nullptr, XB, SSQ, 1.f};
                _Pragma("unroll 1") for (int rep = 0; rep < 2 * NREP(5) - 1; ++rep) { E.sign = (rep == 1) ? -1.f : 1.f; pg8::gemm_phase<false>(lds, g, S, E); } SEAM(pb + 3);
            }
        } else {
            if (MKON(6) && IN(pb + 0)) {
                pg8::Gemm g{XB, (const bf16_t*)((char*)wb + W_OIN + j * 8 * MiB), DM, DM, DM}; pg8::StaticOrder S; S.init(NTOK, 4096, G, bx);
                EpiOddIn E{SSQ, P.in[I_OCONV_W] + (size_t)j * 3 * 1024, P.in[I_OCONV_B] + (size_t)j * 1024, (bf16_t*)(ws + WS_R + R_MIX), (float*)(ws + WS_HALO2 + HALO_OT), (float*)(ws + WS_HALO2 + HALO_OH), lds};
                _Pragma("unroll 1") for (int rep = 0; rep < NREP(6); ++rep) pg8::gemm_phase<true>(lds, g, S, E); SEAM(pb + 0);
            }
            if (MKON(7) && IN(pb + 1)) { FRESH; fixup_odd(P, j, bx * NTHREADS + ftid, G * NTHREADS); SEAM(pb + 1); }
            if (MKON(8) && IN(pb + 2)) {
                pg8::Gemm g{(const bf16_t*)(ws + WS_R + R_MIX), (const bf16_t*)((char*)wb + W_OOUT + j * 2 * MiB), DM, DM, DM}; pg8::StaticOrder S; S.init(NTOK, DM, G, bx);
                EpiResidual E{nullptr, XB, SSQ, 1.f};
                _Pragma("unroll 1") for (int rep = 0; rep < 2 * NREP(8) - 1; ++rep) { E.sign = (rep == 1) ? -1.f : 1.f; pg8::gemm_phase<false>(lds, g, S, E); } SEAM(pb + 2);
            }
        }
        if (MKON(9) && IN(pb + 4)) {
            pg8::Gemm g{XB, (const bf16_t*)((char*)wb + W_XQ + layer * MiB), DM, DM, DM}; pg8::StaticOrder S; S.init(NTOK, 512, G, bx);
            EpiHead128<0> E{SSQ, nullptr, (bf16_t*)(ws + WS_R + R_QX), (float*)(ws + WS_QSS), lds};
            _Pragma("unroll 1") for (int rep = 0; rep < NREP(9); ++rep) pg8::gemm_phase<false>(lds, g, S, E); SEAM(pb + 4);
        }
        if (MKON(10) && IN(pb + 5)) { FRESH; _Pragma("unroll 1") for (int rep = 0; rep < NREP(10); ++rep) for (int w2 = bx; w2 < 256; w2 += G) xattn_wg(P, lds, layer, w2, fwave, flane); SEAM(pb + 5); }
        if (MKON(11) && IN(pb + 6)) {
            pg8::Gemm g{(const bf16_t*)(ws + WS_R + R_OX), (const bf16_t*)((char*)wb + W_XO + layer * MiB), 512, 512, 512}; pg8::StaticOrder S; S.init(NTOK, DM, G, bx);
            EpiResidual E{nullptr, XB, SSQ, 1.f};
            _Pragma("unroll 1") for (int rep = 0; rep < 2 * NREP(11) - 1; ++rep) { E.sign = (rep == 1) ? -1.f : 1.f; pg8::gemm_phase<false>(lds, g, S, E); } SEAM(pb + 6);
        }
        if (MKON(12) && IN(pb + 7)) {
            pg8::Gemm g{XB, (const bf16_t*)((char*)wb + W_UP + layer * 11 * MiB), DM, DM, DM}; pg8::StaticOrder S; S.init(NTOK, 2 * DFF, G, bx);
            EpiFfnUp E{SSQ, P.in[I_FCONV_W] + (size_t)layer * 3 * DFF, P.in[I_FCONV_B] + (size_t)layer * DFF, (bf16_t*)(ws + WS_R + R_ACT), (float*)(ws + WS_HALO2 + HALO_FT), (float*)(ws + WS_HALO2 + HALO_FH), lds};
            _Pragma("unroll 1") for (int rep = 0; rep < NREP(12); ++rep) pg8::gemm_phase<MK_ALIGN6>(lds, g, S, E);
#ifdef MK_NULL6
            { EpiNull EN; pg8::gemm_phase<false>(lds, g, S, EN); }
#endif
            SEAM(pb + 7);
        }
        if (MKON(13) && IN(pb + 8)) { FRESH; fixup_ffn(P, layer, bx * NTHREADS + ftid, G * NTHREADS); SEAM(pb + 8); }
        if (MKON(14) && IN(pb + 9)) {
            pg8::Gemm g{(const bf16_t*)(ws + WS_R + R_ACT), (const bf16_t*)((char*)wb + W_DN + layer * (11 * MiB / 2)), DFF, DFF, DFF}; pg8::StaticOrder S; S.init(NTOK, DM, G, bx);
            EpiResidual E{layer == 3 ? P.out : nullptr, XB, SSQ, 1.f};
            _Pragma("unroll 1") for (int rep = 0; rep < 2 * NREP(14) - 1; ++rep) { E.sign = (rep == 1) ? -1.f : 1.f; pg8::gemm_phase<false>(lds, g, S, E); } SEAM(pb + 9);
        }
    }
#ifdef MK_DUMP
    {
        xcd_barrier(bar);
        const bf16_t* s0; const bf16_t* s1; const bf16_t* s2; const bf16_t* s3; int n0, n1, n2, n3;
#if MK_DUMP == 1
        s0 = (const bf16_t*)(ws + WS_R + R_A2); n0 = 1024; s1 = s0; n1 = 0; s2 = s0; n2 = 0; s3 = s0; n3 = 0;
#elif MK_DUMP == 2
        s0 = (const bf16_t*)(ws + WS_R + R_YG); n0 = 512; s1 = (const bf16_t*)(ws + WS_R + R_U); n1 = 512; s2 = s0; n2 = 0; s3 = s0; n3 = 0;
#elif MK_DUMP == 8
        s0 = (const bf16_t*)(ws + WS_R + R_QX); n0 = 512; s1 = (const bf16_t*)(ws + WS_R + R_OX); n1 = 512; s2 = s0; n2 = 0; s3 = s0; n3 = 0;
#elif MK_DUMP == 4 || MK_DUMP == 6 || MK_DUMP == 7
        s0 = (const bf16_t*)(ws + WS_XB); n0 = 1024; s1 = s0; n1 = 0; s2 = s0; n2 = 0; s3 = s0; n3 = 0;
#else
        s0 = (const bf16_t*)(ws + WS_R + R_Q); n0 = 512; s1 = (const bf16_t*)(ws + WS_R + R_IQ); n1 = 256; s2 = (const bf16_t*)(ws + WS_R + R_KV); n2 = 128; s3 = (const bf16_t*)(ws + WS_R + R_IK); n3 = 64;
#endif
        for (size_t idx = (size_t)bx * NTHREADS + threadIdx.x; idx < (size_t)NTOK * 1024; idx += (size_t)G * NTHREADS) {
            const size_t row = idx >> 10; int c = (int)(idx & 1023); float v = 0.f;
            if (c < n0) { if (MK_DMASK & 1) v = bf2f(s0[row * n0 + c]); } else { c -= n0; if (c < n1) { if (MK_DMASK & 2) v = bf2f(s1[row * n1 + c]); } else { c -= n1; if (c < n2) { if (MK_DMASK & 4) v = bf2f(s2[row * n2 + c]); } else { c -= n2; if (c < n3) { if (MK_DMASK & 8) v = bf2f(s3[row * n3 + c]); } } } }
#ifdef MK_KEEP
            if (!(MK_KEEP)) v = 0.f;
#endif
#if MK_DUMP == 7
            v = bf2f(((const bf16_t*)(ws + WS_R))[row * 1536 + (idx & 1023)]);
#endif
#if MK_DUMP == 6
            if (row < 8192) v = bf2f(((const bf16_t*)(ws + WS_MEMKV))[row * 1024 + (idx & 1023)]);
#endif
#if MK_DUMP == 4
            if (row < 1536) v = bf2f(((const bf16_t*)((char*)wb + W_EIN))[row * 1024 + (idx & 1023)]);
            else if (row < 1536 + 8192) v = SSQ[(row - 1536) * 64 + (idx & 63)];
#endif
            P.out[idx] = v;
        }
    }
#endif
#undef IN
#undef SEAM
}

extern "C" void kernel_launch(void* const* d_in, const int* in_sizes, int n_in, void* d_out, int out_size, void* d_ws, size_t ws_size, hipStream_t stream) {
    static int grid = 0;
    if (grid == 0) {
        if (n_in != 33 || out_size != NTOK * DM || ws_size < WS_END) { fprintf(stderr, "kernel_launch: unexpected problem (n_in %d out %d ws %zu)\n", n_in, out_size, ws_size); grid = -1; return; }
        int dev = 0, cus = 0, per_cu = 0;
        if (hipGetDevice(&dev) != hipSuccess || hipDeviceGetAttribute(&cus, hipDeviceAttributeMultiprocessorCount, dev) != hipSuccess) { grid = -1; return; }
        if (hipFuncSetAttribute((const void*)mk_fwd, hipFuncAttributeMaxDynamicSharedMemorySize, LDS_BYTES) != hipSuccess) { fprintf(stderr, "kernel_launch: hipFuncSetAttribute failed\n"); grid = -1; return; }
        if (hipOccupancyMaxActiveBlocksPerMultiprocessor(&per_cu, (const void*)mk_fwd, NTHREADS, LDS_BYTES) != hipSuccess || per_cu < 1) { fprintf(stderr, "kernel_launch: occupancy query reports %d\n", per_cu); }
        (void)hipGetLastError();
        grid = cus < 256 ? cus : 256;
    }
    if (grid < 0) return;
    (void)hipMemsetAsync((char*)d_ws + WS_CTL, 0, CTL_ZERO_BYTES, stream);
    Params p{};
    for (int i = 0; i < 33; ++i) p.in[i] = (const float*)d_in[i];
    p.out = (float*)d_out; p.ws = (unsigned char*)d_ws;
#ifdef MK_PER_PHASE
    for (int ph = 0; ph <= LAST_PHASE; ++ph) { p.ph_lo = ph; p.ph_hi = ph + 1; hipLaunchKernelGGL(mk_fwd, dim3(grid), dim3(NTHREADS), LDS_BYTES, stream, p); }
#else
    p.ph_lo = 0; p.ph_hi = MK_HI;
    hipLaunchKernelGGL(mk_fwd, dim3(grid), dim3(NTHREADS), LDS_BYTES, stream, p);
#endif
}
```

```cpp
#include <hip/hip_runtime.h>
#include <cstdio>
#include <cstdint>

#define LAS __attribute__((address_space(3)))
#ifndef MK_ALIGN6
#define MK_ALIGN6 true
#endif
#ifndef MK_DSA_REP
#define MK_DSA_REP 0
#endif
#ifndef MK_SSQ_AUX
#define MK_SSQ_AUX 0
#endif
#ifndef MK_SSQ_ST_AUX
#define MK_SSQ_ST_AUX 0
#endif
typedef unsigned short bf16_t;
typedef short bf16x8 __attribute__((ext_vector_type(8)));
typedef short s16x4 __attribute__((ext_vector_type(4)));
typedef float f32x4 __attribute__((ext_vector_type(4)));
typedef float f32x2 __attribute__((ext_vector_type(2)));
typedef unsigned u32x4 __attribute__((ext_vector_type(4)));
typedef unsigned u32x2 __attribute__((ext_vector_type(2)));

constexpr int DM = 1024, NBATCH = 8, SEQ = 4096, NTOK = NBATCH * SEQ, NMEM = 256, MEMTOK = NBATCH * NMEM, DFF = 2816;
constexpr float EPS = 1e-6f;
constexpr int NWAVES = 8, NTHREADS = 512;

constexpr size_t MiB = 1u << 20;
constexpr size_t WS_CTL = 0, CTL_ZERO_BYTES = 65536;
constexpr size_t WS_W = 1 * MiB;
constexpr size_t W_EIN = 0, W_EOUT = 6 * MiB, W_GLU = 10 * MiB, W_OIN = 11 * MiB, W_OOUT = 27 * MiB, W_XQ = 31 * MiB, W_XKV = 35 * MiB, W_XO = 43 * MiB, W_UP = 47 * MiB, W_DN = 91 * MiB;
constexpr size_t WS_XB = 115 * MiB, WS_SSQ = 179 * MiB, WS_MEMB = 180 * MiB, WS_MEMRS = 184 * MiB, WS_MEMKV = 185 * MiB, WS_S5OP = 201 * MiB, WS_HALO = 211 * MiB, WS_R = 224 * MiB, WS_SSQ16 = 416 * MiB, WS_QSS = 418 * MiB, WS_MEMSS = 419 * MiB, WS_HALO2 = 420 * MiB, WS_END = 468 * MiB;
constexpr size_t S5OP_STRIDE = 160 * 1024, S5OP_PM = 16 * 1024, S5OP_QM = 80 * 1024, S5OP_A16 = 144 * 1024;
constexpr size_t HALO_FT = 0, HALO_FH = 12 * MiB, HALO_OT = 36 * MiB, HALO_OH = 40 * MiB;
constexpr size_t R_ACT = 0, R_Q = 0, R_KV = 32 * MiB, R_IK = 40 * MiB, R_IQ = 44 * MiB, R_IW = 60 * MiB, R_U = 61 * MiB, R_A2 = 93 * MiB, R_YG = 157 * MiB, R_MIX = 0, R_QX = 0, R_OX = 32 * MiB;
constexpr int CW_BAR = 4096;

constexpr int RING_BYTES = 131072, EPI_OFF = 131072, LDS_BYTES = 163840, LDSCTL_OFF = 143360;

__device__ __forceinline__ unsigned f2bf(float f) { unsigned u = __builtin_bit_cast(unsigned, f); return (u + 0x7fffu + ((u >> 16) & 1u)) >> 16; }
__device__ __forceinline__ unsigned pk2(float lo, float hi) { return f2bf(lo) | (f2bf(hi) << 16); }
__device__ __forceinline__ unsigned cvt_pk_bf16(float lo, float hi) { unsigned r; asm volatile("v_cvt_pk_bf16_f32 %0, %1, %2" : "=v"(r) : "v"(lo), "v"(hi)); return r; }
__device__ __forceinline__ float bf2f(unsigned short b) { return __builtin_bit_cast(float, (unsigned)b << 16); }
__device__ __forceinline__ float bflo(unsigned w) { return __builtin_bit_cast(float, w << 16); }
__device__ __forceinline__ float bfhi(unsigned w) { return __builtin_bit_cast(float, w & 0xffff0000u); }
__device__ __forceinline__ int fresh_tid() { int t = threadIdx.x; asm volatile("" : "+v"(t)); return t; }
#define LDS_WAIT() asm volatile("s_waitcnt lgkmcnt(0)" ::: "memory")
#define VM_WAIT() asm volatile("s_waitcnt vmcnt(0)" ::: "memory")
__device__ __forceinline__ float wave_sum(float v) {
#pragma unroll
    for (int o = 1; o < 64; o <<= 1) v += __shfl_xor(v, o);
    return v;
}
__device__ __forceinline__ float wave_sum_dpp(float v) {
    v += __builtin_bit_cast(float, __builtin_amdgcn_update_dpp(0, __builtin_bit_cast(int, v), 0x128, 0xf, 0xf, true));
    v += __builtin_bit_cast(float, __builtin_amdgcn_update_dpp(0, __builtin_bit_cast(int, v), 0x124, 0xf, 0xf, true));
    v += __builtin_bit_cast(float, __builtin_amdgcn_update_dpp(0, __builtin_bit_cast(int, v), 0x122, 0xf, 0xf, true));
    v += __builtin_bit_cast(float, __builtin_amdgcn_update_dpp(0, __builtin_bit_cast(int, v), 0x121, 0xf, 0xf, true));
    float a = v, b = v;
    asm("s_nop 1\n\tv_permlane32_swap_b32_e32 %0, %1\n\ts_nop 1\n\tv_add_f32_e32 %0, %0, %1\n\tv_mov_b32_e32 %1, %0\n\ts_nop 1\n\tv_permlane16_swap_b32_e32 %0, %1\n\ts_nop 1\n\tv_add_f32_e32 %0, %0, %1" : "+v"(a), "+v"(b));
    return a;
}
__device__ __forceinline__ float wave_max(float v) {
#pragma unroll
    for (int o = 1; o < 64; o <<= 1) v = fmaxf(v, __shfl_xor(v, o));
    return v;
}
__device__ __forceinline__ int wave_sum_i(int v) {
#pragma unroll
    for (int o = 1; o < 64; o <<= 1) v += __shfl_xor(v, o);
    return v;
}
__device__ __forceinline__ float silu_f(float x) { return x * __builtin_amdgcn_rcpf(1.f + __expf(-x)); }
__device__ __forceinline__ float sigmoid_f(float x) { return __builtin_amdgcn_rcpf(1.f + __expf(-x)); }
__device__ __forceinline__ float gelu_tanh_f(float y) { const float a = 0.7978845608f * (y + 0.044715f * y * y * y); const float t = 1.f - 2.f * __builtin_amdgcn_rcpf(__expf(2.f * a) + 1.f); return 0.5f * y * (1.f + t); }
__device__ __forceinline__ float rs_from_ssq(const float* ssq, int row) { const f32x4 s = *(const f32x4*)(ssq + 4 * (size_t)row); return rsqrtf(((s.x + s.y) + (s.z + s.w)) * (1.f / DM) + EPS); }
__device__ __forceinline__ bf16x8 as_bf16x8(u32x4 v) { return __builtin_bit_cast(bf16x8, v); }

namespace pg8 {
constexpr int BM = 256, BK = 64, HALF = 128, HTB = HALF * BK * 2, STAGE_BYTES = 8 * HTB, NXCD = 8, WGM = 8;
__host__ __device__ __forceinline__ int lds_byte(int r, int c) { const int st = (r >> 4) * 2 + (c >> 5), rr = r & 15, cc = c & 31, ob = rr * 64 + cc * 2; return st * 1024 + (ob ^ (((ob >> 9) & 1) << 5)); }
__host__ __device__ __forceinline__ void stage_rc(int b, int& R, int& C) { const int st = b / 1024, sb = b % 1024, swz = sb ^ (((sb >> 9) & 1) << 5); R = (st >> 1) * 16 + swz / 64; C = (st & 1) * 32 + (swz % 64) / 2; }
struct Unit { int pm, pn; };
struct Gemm { const bf16_t* A; const bf16_t* Bt; int lda, ldb, K; };
struct StaticOrder {
    int nM, nN, nwg, G, c;
    __device__ __forceinline__ void init(int M, int N, int G_, int c_) { nM = M / BM; nN = N / BM; nwg = nM * nN; G = G_; c = c_; }
    __device__ __forceinline__ bool next(int i, Unit& u) const {
        const long L = (long)i * G + c; if (L >= nwg) return false;
        int wgid = (int)L; { const int q = nwg / NXCD, r = nwg % NXCD, xcd = wgid % NXCD, off = wgid / NXCD; wgid = (xcd < r ? xcd * (q + 1) : r * (q + 1) + (xcd - r) * q) + off; }
        const int nig = WGM * nN, gid = wgid / nig, fm = gid * WGM, gsz = (nM - fm) < WGM ? (nM - fm) : WGM;
        u.pm = fm + ((wgid % nig) % gsz); u.pn = (wgid % nig) / gsz; return true;
    }
};
template <bool ALIGN_EPI = false, class Epi>
__device__ __forceinline__ void gemm_phase(LAS unsigned char* lds, const Gemm g, const StaticOrder& S, const Epi& E) {
    const int tid = fresh_tid(), wid = __builtin_amdgcn_readfirstlane(tid >> 6), lane = tid & 63, wr = wid >> 2, wc = wid & 3, fr = lane & 15, fq = lane >> 4;
    const int K = g.K, nt = K / BK;
    unsigned voffA[2], voffB[2];
#pragma unroll
    for (int i = 0; i < 2; ++i) { int R, C; stage_rc(tid * 16 + i * 8192, R, C); voffA[i] = (unsigned)(R * g.lda + C) * 2u; voffB[i] = (unsigned)(R * g.ldb + C) * 2u; }
    const size_t kstep = (size_t)(BK * 2);
    const size_t hstepA = (size_t)HALF * g.lda * 2, hstepB = (size_t)HALF * g.ldb * 2, tstepA = 2 * hstepA, tstepB = 2 * hstepB;
    const unsigned ldsw = (unsigned)wid * 1024u;
    const int aoff = lds_byte(wr * 64 + fr, fq * 8), boff = lds_byte(wc * 32 + fr, fq * 8);
#define PG8_SA(b, h) (((b) * 2 + (h)) * HTB)
#define PG8_SB(b, h) ((4 + (b) * 2 + (h)) * HTB)
#define PG8_STAGE(bufoff, gbase, voff) do { _Pragma("unroll") for (int _i = 0; _i < 2; ++_i) \
        __builtin_amdgcn_global_load_lds((const unsigned*)((const char*)(gbase) + (voff)[_i]), (LAS unsigned*)(lds + (bufoff) + ldsw + _i * 8192), 16, 0, 0); } while (0)
#define PG8_LDA(dst, b, h) do { _Pragma("unroll") for (int m = 0; m < 4; ++m) _Pragma("unroll") for (int k = 0; k < 2; ++k) dst[m][k] = *(const LAS bf16x8*)(lds + PG8_SA(b, h) + aoff + m * 2048 + k * 1024); } while (0)
#define PG8_LDB(dst, b, h) do { _Pragma("unroll") for (int n = 0; n < 2; ++n) _Pragma("unroll") for (int k = 0; k < 2; ++k) dst[n][k] = *(const LAS bf16x8*)(lds + PG8_SB(b, h) + boff + n * 2048 + k * 1024); } while (0)
#define PG8_MMA(ai, bj, At, Bt) do { __builtin_amdgcn_s_setprio(1); _Pragma("unroll") for (int m = 0; m < 4; ++m) _Pragma("unroll") for (int n = 0; n < 2; ++n) _Pragma("unroll") for (int k = 0; k < 2; ++k) \
        acc[ai][bj][m][n] = __builtin_amdgcn_mfma_f32_16x16x32_bf16(Bt[n][k], At[m][k], acc[ai][bj][m][n], 0, 0, 0); __builtin_amdgcn_s_setprio(0); } while (0)
#define PG8_WAIT_V(n) asm volatile("s_waitcnt vmcnt(" #n ")" ::: "memory")
#define PG8_WAIT_L(n) asm volatile("s_waitcnt lgkmcnt(" #n ")" ::: "memory")
#define PG8_BAR __builtin_amdgcn_s_barrier()
#define PG8_SCHED __builtin_amdgcn_sched_barrier(0)
    Unit cur, nxt; int ui = 0;
    if (!S.next(0, cur)) return;
    f32x4 acc[2][2][4][2];
#pragma unroll
    for (int a = 0; a < 2; ++a)
#pragma unroll
        for (int b = 0; b < 2; ++b)
#pragma unroll
            for (int m = 0; m < 4; ++m)
#pragma unroll
                for (int n = 0; n < 2; ++n) acc[a][b][m][n] = (f32x4){0.f, 0.f, 0.f, 0.f};
    bf16x8 At[4][2], B0[2][2], B1[2][2];
    const char* cA = (const char*)g.A + (size_t)cur.pm * tstepA; const char* cB = (const char*)g.Bt + (size_t)cur.pn * tstepB;
    PG8_STAGE(PG8_SB(0, 0), cB, voffB); PG8_STAGE(PG8_SB(0, 1), cB + hstepB, voffB); PG8_STAGE(PG8_SA(0, 0), cA, voffA); PG8_STAGE(PG8_SA(0, 1), cA + hstepA, voffA);
    if (wr == 1) PG8_BAR;
    PG8_WAIT_V(2); PG8_BAR;
    PG8_STAGE(PG8_SB(1, 0), cB + kstep, voffB); PG8_STAGE(PG8_SA(1, 0), cA + kstep, voffA); PG8_STAGE(PG8_SB(1, 1), cB + hstepB + kstep, voffB);
    PG8_WAIT_V(6); PG8_BAR;
    for (;;) {
        const bool has_next = S.next(ui + 1, nxt);
        const char* nA = has_next ? (const char*)g.A + (size_t)nxt.pm * tstepA : cA; const char* nB = has_next ? (const char*)g.Bt + (size_t)nxt.pn * tstepB : cB;
        for (int t = 0; t < nt; t += 2) {
            const bool last = (t == nt - 2);
            const char* a1 = cA + (size_t)(t + 1) * kstep;
            const char* a2 = last ? nA : cA + (size_t)(t + 2) * kstep; const char* b2 = last ? nB : cB + (size_t)(t + 2) * kstep;
            const char* a3 = a2 + kstep; const char* b3 = b2 + kstep;
            PG8_LDB(B0, 0, 0); PG8_LDB(B1, 0, 1); PG8_SCHED; PG8_LDA(At, 0, 0); PG8_STAGE(PG8_SA(1, 1), a1 + hstepA, voffA);
            PG8_WAIT_V(8); PG8_WAIT_L(0); PG8_BAR; PG8_MMA(0, 0, At, B0); PG8_MMA(0, 1, At, B1); PG8_BAR; PG8_SCHED;
            PG8_LDA(At, 0, 1); PG8_STAGE(PG8_SB(0, 0), b2, voffB); PG8_STAGE(PG8_SB(0, 1), b2 + hstepB, voffB); PG8_STAGE(PG8_SA(0, 0), a2, voffA);
            PG8_WAIT_V(8); PG8_WAIT_L(0); PG8_BAR; PG8_MMA(1, 0, At, B0); PG8_MMA(1, 1, At, B1); PG8_BAR; PG8_SCHED;
            PG8_LDB(B0, 1, 0); PG8_LDB(B1, 1, 1); PG8_SCHED; PG8_LDA(At, 1, 0); PG8_STAGE(PG8_SA(0, 1), a2 + hstepA, voffA);
            PG8_WAIT_V(8); PG8_WAIT_L(0); PG8_BAR; PG8_MMA(0, 0, At, B0); PG8_MMA(0, 1, At, B1); PG8_BAR; PG8_SCHED;
            PG8_LDA(At, 1, 1); PG8_STAGE(PG8_SB(1, 0), b3, voffB); PG8_STAGE(PG8_SB(1, 1), b3 + hstepB, voffB); PG8_STAGE(PG8_SA(1, 0), a3, voffA);
            PG8_WAIT_V(8); PG8_WAIT_L(0); PG8_BAR; PG8_MMA(1, 0, At, B0); PG8_MMA(1, 1, At, B1); PG8_BAR; PG8_SCHED;
        }
        if constexpr (ALIGN_EPI) { if (wr == 0) PG8_BAR; }
#ifdef MK_FENCE_EPI
        PG8_SCHED; asm volatile("s_waitcnt vmcnt(0) lgkmcnt(0)\n\ts_nop 15" ::: "memory"); PG8_SCHED;
#endif
        E(acc, cur, wr, wc, fr, fq);
#ifdef MK_FENCE_EPI
        PG8_SCHED; asm volatile("s_waitcnt vmcnt(0) lgkmcnt(0)\n\ts_nop 15" ::: "memory"); PG8_SCHED;
#endif
        if (!has_next) break;
#pragma unroll
        for (int a = 0; a < 2; ++a)
#pragma unroll
            for (int b = 0; b < 2; ++b)
#pragma unroll
                for (int m = 0; m < 4; ++m)
#pragma unroll
                    for (int n = 0; n < 2; ++n) acc[a][b][m][n] = (f32x4){0.f, 0.f, 0.f, 0.f};
        cur = nxt; cA = nA; cB = nB; ++ui;
        if constexpr (ALIGN_EPI) { if (wr == 1) PG8_BAR; }
    }
    PG8_WAIT_V(0);
    if constexpr (!ALIGN_EPI) { if (wr == 0) PG8_BAR; }
    PG8_BAR;
#undef PG8_SA
#undef PG8_SB
#undef PG8_STAGE
#undef PG8_LDA
#undef PG8_LDB
#undef PG8_MMA
#undef PG8_WAIT_V
#undef PG8_WAIT_L
#undef PG8_SCHED
}
}
#define WG_BAR() do { asm volatile("s_waitcnt lgkmcnt(0)" ::: "memory"); __builtin_amdgcn_s_barrier(); asm volatile("" ::: "memory"); } while (0)

#define XB_TMO      128
#define XB_XCNT(j)  (256  + 64 * (j))
#define XB_XSUB(j)  (1280 + 64 * (j))
#define XB_XGEN(j)  (2304 + 64 * (j))
#define XB_TOP      3328
#define XB_TOPGEN   3392
#define XCD_BAR_WORDS 3456
#define XB_SPIN_CAP (1u << 18)
__device__ __forceinline__ unsigned xb_ld(unsigned* p)              { return __hip_atomic_load(p, __ATOMIC_RELAXED, __HIP_MEMORY_SCOPE_AGENT); }
__device__ __forceinline__ unsigned xb_add(unsigned* p, unsigned v) { return __hip_atomic_fetch_add(p, v, __ATOMIC_RELAXED, __HIP_MEMORY_SCOPE_AGENT); }
__device__ __forceinline__ unsigned xb_xcc_id() { return (unsigned)__builtin_amdgcn_s_getreg((3 << 11) | 20) & 0xFu; }
#define XB_SPIN(cond, bar) do { unsigned _sp = 0; while (cond) { __builtin_amdgcn_s_sleep(1); \
    if ((++_sp & 255u) == 0u) { if (xb_ld(&(bar)[XB_TMO])) break; if (_sp > XB_SPIN_CAP) { atomicAdd(&(bar)[XB_TMO], 1u); break; } } } } while (0)
struct XcdBarrier { unsigned* bar; unsigned x; volatile LAS unsigned* st; };
__device__ __forceinline__ XcdBarrier xcd_barrier_post(unsigned* bar, volatile LAS unsigned* st) {
    XcdBarrier b; b.bar = bar; b.x = xb_xcc_id(); b.st = st;
    if (threadIdx.x == 0) (void)xb_add(&bar[XB_XCNT(b.x)], 1u);
    return b;
}
__device__ __forceinline__ void xcd_barrier_complete(unsigned* bar, unsigned x, unsigned& nloc, unsigned& nx) {
    const unsigned G = gridDim.x * gridDim.y * gridDim.z;
    unsigned sum, cnt, mine, sp = 0u;
    for (;;) {
        sum = 0u; cnt = 0u; mine = 0u;
#pragma unroll
        for (unsigned j = 0; j < 16; ++j) { const unsigned c = xb_ld(&bar[XB_XCNT(j)]); sum += c; cnt += (c > 0u) ? 1u : 0u; mine = (j == x) ? c : mine; }
        if (sum == G) break;
        __builtin_amdgcn_s_sleep(1);
        if ((++sp & 255u) == 0u) { if (xb_ld(&bar[XB_TMO])) break; if (sp > XB_SPIN_CAP) { atomicAdd(&bar[XB_TMO], 1u); break; } }
    }
    nloc = mine > 0u ? mine : 1u; nx = cnt > 0u ? cnt : 1u;
}
__device__ __forceinline__ void xcd_barrier(const XcdBarrier& b) {
    asm volatile("s_waitcnt vmcnt(0)" ::: "memory");
    __syncthreads();
    if (threadIdx.x == 0) {
        unsigned* bar = b.bar;
        __builtin_amdgcn_s_waitcnt(0);
        unsigned nloc = b.st[0], nx = b.st[1];
        if (nloc == 0u) { xcd_barrier_complete(bar, b.x, nloc, nx); b.st[0] = nloc; b.st[1] = nx; }
        const unsigned old = xb_add(&bar[XB_XSUB(b.x)], 1u);
        const unsigned gen = old / nloc;
        if (old + 1u == (gen + 1u) * nloc) {
            __builtin_amdgcn_fence(__ATOMIC_RELEASE, "agent");
            asm volatile("s_waitcnt vmcnt(0)" ::: "memory");
            const unsigned og = xb_add(&bar[XB_TOP], 1u);
            const unsigned tg = og / nx;
            if (og + 1u == (tg + 1u) * nx) xb_add(&bar[XB_TOPGEN], 1u);
            else XB_SPIN(xb_ld(&bar[XB_TOPGEN]) == tg, bar);
            __builtin_amdgcn_fence(__ATOMIC_ACQUIRE, "agent");
            xb_add(&bar[XB_XGEN(b.x)], 1u);
            asm volatile("s_waitcnt vmcnt(0)" ::: "memory");
        } else {
            XB_SPIN(xb_ld(&bar[XB_XGEN(b.x)]) == gen, bar);
            __builtin_amdgcn_fence(__ATOMIC_ACQUIRE, "agent");
            asm volatile("s_waitcnt vmcnt(0)" ::: "memory");
        }
    }
    __syncthreads();
}

enum MapId { MAP_STD = 0, MAP_EVEN_IN = 1, MAP_XQ = 2, MAP_XKV = 3, MAP_FFN_UP = 4, MAP_ODD_IN = 5 };
__device__ __forceinline__ int colmap(int mapid, int n) {
    const int pn = n >> 8, s = n & 255, bj = s >> 7, wc = (s >> 5) & 3, nn = (s >> 4) & 1, fq = (s >> 2) & 3, i = s & 3;
    const int d32 = 8 * fq + 4 * nn + i, hd = 32 * bj + d32;
    switch (mapid) {
    case MAP_STD: return 256 * pn + 128 * bj + 32 * wc + d32;
    case MAP_EVEN_IN:
        if (pn <= 1) return (4 * pn + wc) * 64 + hd;
        if (pn == 2) { if (wc == 0) return 512 + hd; if (wc == 1) return 576 + hd; if (wc == 2) return 896 + hd; return hd < 4 ? 960 + hd : -1; }
        if (pn == 3) return 640 + wc * 64 + hd;
        return 964 + 256 * (pn - 4) + 128 * bj + 32 * wc + d32;
    case MAP_XQ: return (2 * pn + (wc >> 1)) * 128 + 64 * (wc & 1) + hd;
    case MAP_XKV:
        if (pn <= 1) return (2 * pn + (wc >> 1)) * 128 + 64 * (wc & 1) + hd;
        return 512 + 256 * (pn - 2) + 128 * bj + 32 * wc + d32;
    case MAP_FFN_UP: { const int ch = 128 * pn + 32 * wc + d32; return bj ? DFF + ch : ch; }
    default: { const int ch = 64 * pn + 16 * wc + 4 * fq + i, q = 2 * bj + nn; return q == 3 ? -1 : q * 1024 + ch; }
    }
}
struct PrepJob { const float* W; const float* gain; bf16_t* dst; int K, N, npad, mapid; };
__device__ __forceinline__ void prep_item(const PrepJob& J, LAS float* scr, int item, int lane) {
    const int nblk = J.npad / 32, kb = item / nblk, nb = item % nblk, k0 = 64 * kb, n0 = 32 * nb;
    const int col = colmap(J.mapid, n0 + (lane & 31));
    float wv[32];
#pragma unroll
    for (int i = 0; i < 32; ++i) { const int kk = 2 * i + (lane >> 5); wv[i] = (col >= 0) ? J.W[(size_t)(k0 + kk) * J.N + col] : 0.f; }
#pragma unroll
    for (int i = 0; i < 32; ++i) { const int kk = 2 * i + (lane >> 5); float v = wv[i]; if (J.gain) v *= J.gain[k0 + kk]; scr[kk * 33 + (lane & 31)] = v; }
    LDS_WAIT();
    const int c = lane & 7;
#pragma unroll
    for (int j = 0; j < 4; ++j) { const int n = (lane >> 3) + 8 * j; const LAS float* s = scr + (8 * c) * 33 + n;
        u32x4 o; o.x = pk2(s[0 * 33], s[1 * 33]); o.y = pk2(s[2 * 33], s[3 * 33]); o.z = pk2(s[4 * 33], s[5 * 33]); o.w = pk2(s[6 * 33], s[7 * 33]);
        *(u32x4*)(J.dst + (size_t)(n0 + n) * J.K + k0 + 8 * c) = o; }
    LDS_WAIT();
}

struct Params { const float* in[33]; float* out; unsigned char* ws; int ph_lo, ph_hi; };
enum InIdx { I_X = 0, I_MEM, I_NORM_MIX, I_NORM_X, I_NORM_MEM, I_NORM_FFN, I_EW_IN, I_EW_OUT, I_AQN, I_AKN, I_LAM_RE, I_LAM_IM, I_LOGSTEP, I_B_RE, I_B_IM, I_C_RE, I_C_IM, I_S5D, I_WGLU, I_BGLU,
             I_OW_IN, I_OCONV_W, I_OCONV_B, I_OW_OUT, I_XWQ, I_XWKV, I_XWO, I_XQN, I_XKN, I_FWUP, I_FCONV_W, I_FCONV_B, I_FWDN };

__device__ __forceinline__ bool get_job(const Params& P, int job, PrepJob& J) {
    bf16_t* wb = (bf16_t*)(P.ws + WS_W);
    if (job < 6) { const int j = job & 1, k = job >> 1;
        if (k == 0) { J = PrepJob{P.in[I_EW_IN] + (size_t)j * DM * 1476, P.in[I_NORM_MIX] + (2 * j) * DM, (bf16_t*)((char*)wb + W_EIN + j * 3 * MiB), DM, 1476, 1536, MAP_EVEN_IN}; return true; }
        if (k == 1) { J = PrepJob{P.in[I_EW_OUT] + (size_t)j * DM * DM, nullptr, (bf16_t*)((char*)wb + W_EOUT + j * 2 * MiB), DM, DM, DM, MAP_STD}; return true; }
        J = PrepJob{P.in[I_WGLU] + (size_t)j * 512 * 512, nullptr, (bf16_t*)((char*)wb + W_GLU + j * (MiB / 2)), 512, 512, 512, MAP_STD}; return true; }
    job -= 6;
    if (job < 4) { const int j = job & 1, k = job >> 1;
        if (k == 0) { J = PrepJob{P.in[I_OW_IN] + (size_t)j * DM * 3072, P.in[I_NORM_MIX] + (2 * j + 1) * DM, (bf16_t*)((char*)wb + W_OIN + j * 8 * MiB), DM, 3072, 4096, MAP_ODD_IN}; return true; }
        J = PrepJob{P.in[I_OW_OUT] + (size_t)j * DM * DM, nullptr, (bf16_t*)((char*)wb + W_OOUT + j * 2 * MiB), DM, DM, DM, MAP_STD}; return true; }
    job -= 4;
    if (job < 20) { const int i = job & 3, k = job >> 2;
        if (k == 0) { J = PrepJob{P.in[I_XWQ] + (size_t)i * DM * 512, P.in[I_NORM_X] + i * DM, (bf16_t*)((char*)wb + W_XQ + i * MiB), DM, 512, 512, MAP_XQ}; return true; }
        if (k == 1) { J = PrepJob{P.in[I_XWKV] + (size_t)i * DM * 1024, P.in[I_NORM_MEM] + i * DM, (bf16_t*)((char*)wb + W_XKV + i * 2 * MiB), DM, 1024, 1024, MAP_XKV}; return true; }
        if (k == 2) { J = PrepJob{P.in[I_XWO] + (size_t)i * 512 * DM, nullptr, (bf16_t*)((char*)wb + W_XO + i * MiB), 512, DM, DM, MAP_STD}; return true; }
        if (k == 3) { J = PrepJob{P.in[I_FWUP] + (size_t)i * DM * 2 * DFF, P.in[I_NORM_FFN] + i * DM, (bf16_t*)((char*)wb + W_UP + i * 11 * MiB), DM, 2 * DFF, 2 * DFF, MAP_FFN_UP}; return true; }
        J = PrepJob{P.in[I_FWDN] + (size_t)i * DFF * DM, nullptr, (bf16_t*)((char*)wb + W_DN + i * (11 * MiB / 2)), DFF, DM, DM, MAP_STD}; return true; }
    return false;
}
constexpr int NJOBS = 30;

__device__ __forceinline__ f32x2 cmul(f32x2 a, f32x2 b) { return (f32x2){a.x * b.x - a.y * b.y, a.x * b.y + a.y * b.x}; }
__device__ __forceinline__ void s5_precompute(const Params& P, LAS unsigned char* lds, int task) {
    const int tid = fresh_tid(), jg = task;
    LAS f32x2* PW = (LAS f32x2*)lds;
    LAS f32x2* BB = PW + 17 * 64;
    LAS f32x2* CC = BB + 64 * 16;
    unsigned char* op = P.ws + WS_S5OP + (size_t)jg * S5OP_STRIDE;
    if (tid < 64) {
        const int p = tid;
        const float delta = expf(P.in[I_LOGSTEP][jg]);
        const float lre = P.in[I_LAM_RE][jg * 64 + p], lim = P.in[I_LAM_IM][jg * 64 + p];
        for (int n = 0; n <= 16; ++n) { const float mag = expf((float)n * lre * delta); float sn, cs; sincosf((float)n * lim * delta, &sn, &cs); PW[n * 64 + p] = (f32x2){mag * cs, mag * sn}; }
        const f32x2 lb = PW[64 + p]; const float nr = lb.x - 1.f, ni = lb.y, den = lre * lre + lim * lim;
        const f32x2 coef = (f32x2){(nr * lre + ni * lim) / den, (ni * lre - nr * lim) / den};
        for (int c = 0; c < 16; ++c) { const f32x2 b = (f32x2){P.in[I_B_RE][((size_t)jg * 64 + p) * 16 + c], P.in[I_B_IM][((size_t)jg * 64 + p) * 16 + c]}; BB[p * 16 + c] = cmul(coef, b); }
        for (int c = 0; c < 16; ++c) CC[c * 64 + p] = (f32x2){P.in[I_C_RE][((size_t)jg * 16 + c) * 64 + p], P.in[I_C_IM][((size_t)jg * 16 + c) * 64 + p]};
        ((f32x2*)(op + S5OP_A16))[p] = PW[16 * 64 + p];
    }
    __syncthreads();
    bf16_t* Km = (bf16_t*)op; bf16_t* Pm = (bf16_t*)(op + S5OP_PM); bf16_t* Qm = (bf16_t*)(op + S5OP_QM);
    for (int idx = tid; idx < 17 * 256; idx += NTHREADS) {
        const int dd = idx >> 8, c1 = (idx >> 4) & 15, c = idx & 15; float v = 0.f;
        if (dd > 0) { const int d = dd - 1; for (int p = 0; p < 64; ++p) { const f32x2 m = cmul(cmul(CC[c1 * 64 + p], PW[d * 64 + p]), BB[p * 16 + c]); v += m.x; } }
        Km[idx] = (bf16_t)f2bf(v);
    }
    for (int idx = tid; idx < 128 * 256; idx += NTHREADS) {
        const int row = idx >> 8, col = idx & 255, p = row >> 1, ri = row & 1, tau = col >> 4, c = col & 15;
        const f32x2 m = cmul(PW[(15 - tau) * 64 + p], BB[p * 16 + c]);
        Pm[((((row >> 4) * 8 + (col >> 5)) * 64 + ((col >> 3) & 3) * 16 + (row & 15)) << 3) + (col & 7)] = (bf16_t)f2bf(ri ? m.y : m.x);
    }
    for (int idx = tid; idx < 256 * 128; idx += NTHREADS) {
        const int row = idx >> 7, col = idx & 127, tau = row >> 4, c1 = row & 15, p = col >> 1, ri = col & 1;
        const f32x2 m = cmul(CC[c1 * 64 + p], PW[(tau + 1) * 64 + p]);
        Qm[((((row >> 4) * 4 + (col >> 5)) * 64 + ((col >> 3) & 3) * 16 + (row & 15)) << 3) + (col & 7)] = (bf16_t)f2bf(ri ? -m.y : m.x);
    }
    __syncthreads();
}

__device__ __forceinline__ void prologue(const Params& P, LAS unsigned char* lds, int gw, int NGW, int wave, int lane) {
    for (int task = blockIdx.x; task < 64; task += gridDim.x) s5_precompute(P, lds, task);
    LAS float* scr = (LAS float*)(lds + wave * 16384);
    {
        int base = 0;
        for (int job = 0; job < NJOBS; ++job) {
            PrepJob J; get_job(P, job, J);
            const int nitems = (J.npad / 32) * (J.K / 64);
            int first = gw - (base % NGW); if (first < 0) first += NGW;
            for (int it = first; it < nitems; it += NGW) prep_item(J, scr, it, lane);
            base += nitems;
        }
    }
    {
        const float* x = P.in[I_X]; bf16_t* xb = (bf16_t*)(P.ws + WS_XB); float* ssq = (float*)(P.ws + WS_SSQ16);
        const bool bymap = (gridDim.x == 256);
        const int lw = bymap ? ((int)(blockIdx.x >> 3) * NWAVES + wave) : gw, nlw = bymap ? 256 : NGW, mbase = bymap ? (int)(blockIdx.x & 7) * SEQ : 0, mend = bymap ? SEQ : NTOK;
        for (int m0 = lw; m0 < mend; m0 += 2 * nlw) {
            const int mA = mbase + m0, mB = mbase + ((m0 + nlw < mend) ? m0 + nlw : m0);
            const f32x4* xa = (const f32x4*)(x + (size_t)mA * DM) + lane; const f32x4* xbp = (const f32x4*)(x + (size_t)mB * DM) + lane;
            f32x4 va[4], vb[4];
#pragma unroll
            for (int j = 0; j < 4; ++j) { va[j] = xa[64 * j]; vb[j] = xbp[64 * j]; }
#pragma unroll
            for (int h = 0; h < 2; ++h) {
                const int m = h ? mB : mA; u32x2* bo = (u32x2*)(xb + (size_t)m * DM) + lane;
                float sq[4];
#pragma unroll
                for (int j = 0; j < 4; ++j) { const f32x4 v = h ? vb[j] : va[j]; bo[64 * j] = (u32x2){pk2(v.x, v.y), pk2(v.z, v.w)}; sq[j] = wave_sum_dpp((v.x * v.x + v.y * v.y) + (v.z * v.z + v.w * v.w)); }
                if (lane < 16) ssq[16 * (size_t)m + lane] = (lane & 3) ? 0.f : ((lane >> 2) == 0 ? sq[0] : (lane >> 2) == 1 ? sq[1] : (lane >> 2) == 2 ? sq[2] : sq[3]);
            }
        }
    }
    {
        const float* mem = P.in[I_MEM]; bf16_t* mb = (bf16_t*)(P.ws + WS_MEMB); float* mrs = (float*)(P.ws + WS_MEMRS);
        for (int m0 = gw; m0 < MEMTOK; m0 += 2 * NGW) {
            const int mA = m0, mB = (m0 + NGW < MEMTOK) ? m0 + NGW : m0;
            const f32x4* xa = (const f32x4*)(mem + (size_t)mA * DM) + lane; const f32x4* xbp = (const f32x4*)(mem + (size_t)mB * DM) + lane;
            f32x4 va[4], vb[4];
#pragma unroll
            for (int j = 0; j < 4; ++j) { va[j] = xa[64 * j]; vb[j] = xbp[64 * j]; }
#pragma unroll
            for (int h = 0; h < 2; ++h) {
                const int m = h ? mB : mA; u32x2* bo = (u32x2*)(mb + (size_t)m * DM) + lane;
                float s = 0.f;
#pragma unroll
                for (int j = 0; j < 4; ++j) { const f32x4 v = h ? vb[j] : va[j]; bo[64 * j] = (u32x2){pk2(v.x, v.y), pk2(v.z, v.w)}; s += (v.x * v.x + v.y * v.y) + (v.z * v.z + v.w * v.w); }
                s = wave_sum_dpp(s);
                if (lane == 0) mrs[m] = rsqrtf(s * (1.f / DM) + EPS);
            }
        }
    }
}

typedef const f32x4 (&AccRef)[2][2][4][2];
__device__ __forceinline__ u32x4 pack8(f32x4 a, f32x4 b) { u32x4 w; w.x = cvt_pk_bf16(a.x, a.y); w.y = cvt_pk_bf16(a.z, a.w); w.z = cvt_pk_bf16(b.x, b.y); w.w = cvt_pk_bf16(b.z, b.w); return w; }
typedef __amdgpu_buffer_rsrc_t rsrc_t;
__device__ __forceinline__ rsrc_t mkrsrc(const void* p) { return __builtin_amdgcn_make_buffer_rsrc((void*)p, 0, 0x7fffffff, 0x00020000); }
#define BLD128(r, vo, so) __builtin_amdgcn_raw_buffer_load_b128((r), (vo), (so), 0)
#define BLD64(r, vo, so) __builtin_amdgcn_raw_buffer_load_b64((r), (vo), (so), 0)
#define BST128(v, r, vo, so) __builtin_amdgcn_raw_buffer_store_b128((v), (r), (vo), (so), 0)
#define BST64(v, r, vo, so) __builtin_amdgcn_raw_buffer_store_b64((v), (r), (vo), (so), 0)
__device__ __forceinline__ f32x4 asf4(u32x4 v) { return __builtin_bit_cast(f32x4, v); }
__device__ __forceinline__ u32x4 asu4(f32x4 v) { return __builtin_bit_cast(u32x4, v); }
#define RFL(x) __builtin_amdgcn_readfirstlane(x)
__device__ __forceinline__ float rs_sum16(u32x4 a, u32x4 b, u32x4 c, u32x4 d) { const f32x4 s = (asf4(a) + asf4(b)) + (asf4(c) + asf4(d)); return rsqrtf(((s.x + s.y) + (s.z + s.w)) * (1.f / DM) + EPS); }
__device__ __forceinline__ LAS float* rs_stage(rsrc_t rq, LAS unsigned char* lds, int wr, int wc, int fr, int fq) {
    LAS float* sl = (LAS float*)(lds + EPI_OFF + (wr * 4 + wc) * 512);
    const int l = fq * 16 + fr;
    u32x4 t[2][4];
#pragma unroll
    for (int j = 0; j < 2; ++j) { const int rl = 128 * j + 64 * wr + l;
#pragma unroll
        for (int k = 0; k < 4; ++k) t[j][k] = BLD128(rq, rl * 64, 16 * k); }
#pragma unroll
    for (int j = 0; j < 2; ++j) sl[l + 64 * j] = rs_sum16(t[j][0], t[j][1], t[j][2], t[j][3]);
    LDS_WAIT();
    return sl;
}
__device__ __forceinline__ float xrow_sum(float v) {
    float a = v, b = v;
    asm("s_nop 1\n\tv_permlane32_swap_b32_e32 %0, %1\n\ts_nop 1\n\tv_add_f32_e32 %0, %0, %1\n\tv_mov_b32_e32 %1, %0\n\ts_nop 1\n\tv_permlane16_swap_b32_e32 %0, %1\n\ts_nop 1\n\tv_add_f32_e32 %0, %0, %1" : "+v"(a), "+v"(b));
    return a;
}
__device__ __forceinline__ float row_ror1(float v) { return __builtin_bit_cast(float, __builtin_amdgcn_update_dpp(0, __builtin_bit_cast(int, v), 0x121, 0xf, 0xf, true)); }
__device__ __forceinline__ float row_ror2(float v) { return __builtin_bit_cast(float, __builtin_amdgcn_update_dpp(0, __builtin_bit_cast(int, v), 0x122, 0xf, 0xf, true)); }
__device__ __forceinline__ float row_shr1(float v) { return __builtin_bit_cast(float, __builtin_amdgcn_update_dpp(0, __builtin_bit_cast(int, v), 0x111, 0xf, 0xf, true)); }
__device__ __forceinline__ float row_shr2(float v) { return __builtin_bit_cast(float, __builtin_amdgcn_update_dpp(0, __builtin_bit_cast(int, v), 0x112, 0xf, 0xf, true)); }
__device__ __forceinline__ f32x4 shr1_4(f32x4 v) { return (f32x4){row_shr1(v.x), row_shr1(v.y), row_shr1(v.z), row_shr1(v.w)}; }
__device__ __forceinline__ f32x4 shr2_4(f32x4 v) { return (f32x4){row_shr2(v.x), row_shr2(v.y), row_shr2(v.z), row_shr2(v.w)}; }
__device__ __forceinline__ void conv_taps(f32x4& c, f32x4 x, f32x4 w1, f32x4 w0) {
    asm("s_nop 1\n\t"
        "v_fmac_f32_dpp %0, %4, %8 row_shr:1 row_mask:0xf bank_mask:0xf\n\tv_fmac_f32_dpp %1, %5, %9 row_shr:1 row_mask:0xf bank_mask:0xf\n\t"
        "v_fmac_f32_dpp %2, %6, %10 row_shr:1 row_mask:0xf bank_mask:0xf\n\tv_fmac_f32_dpp %3, %7, %11 row_shr:1 row_mask:0xf bank_mask:0xf\n\t"
        "v_fmac_f32_dpp %0, %4, %12 row_shr:2 row_mask:0xf bank_mask:0xf\n\tv_fmac_f32_dpp %1, %5, %13 row_shr:2 row_mask:0xf bank_mask:0xf\n\t"
        "v_fmac_f32_dpp %2, %6, %14 row_shr:2 row_mask:0xf bank_mask:0xf\n\tv_fmac_f32_dpp %3, %7, %15 row_shr:2 row_mask:0xf bank_mask:0xf"
        : "+v"(c.x), "+v"(c.y), "+v"(c.z), "+v"(c.w)
        : "v"(x.x), "v"(x.y), "v"(x.z), "v"(x.w), "v"(w1.x), "v"(w1.y), "v"(w1.z), "v"(w1.w), "v"(w0.x), "v"(w0.y), "v"(w0.z), "v"(w0.w));
}
__device__ __forceinline__ void conv_taps_prev(f32x4& c, f32x4 xp, f32x4 w1a, f32x4 w0a) {
    asm("s_nop 1\n\t"
        "v_fmac_f32_dpp %0, %4, %8 row_ror:1 row_mask:0xf bank_mask:0xf\n\tv_fmac_f32_dpp %1, %5, %9 row_ror:1 row_mask:0xf bank_mask:0xf\n\t"
        "v_fmac_f32_dpp %2, %6, %10 row_ror:1 row_mask:0xf bank_mask:0xf\n\tv_fmac_f32_dpp %3, %7, %11 row_ror:1 row_mask:0xf bank_mask:0xf\n\t"
        "v_fmac_f32_dpp %0, %4, %12 row_ror:2 row_mask:0xf bank_mask:0xf\n\tv_fmac_f32_dpp %1, %5, %13 row_ror:2 row_mask:0xf bank_mask:0xf\n\t"
        "v_fmac_f32_dpp %2, %6, %14 row_ror:2 row_mask:0xf bank_mask:0xf\n\tv_fmac_f32_dpp %3, %7, %15 row_ror:2 row_mask:0xf bank_mask:0xf"
        : "+v"(c.x), "+v"(c.y), "+v"(c.z), "+v"(c.w)
        : "v"(xp.x), "v"(xp.y), "v"(xp.z), "v"(xp.w), "v"(w1a.x), "v"(w1a.y), "v"(w1a.z), "v"(w1a.w), "v"(w0a.x), "v"(w0a.y), "v"(w0a.z), "v"(w0a.w));
}
__device__ __forceinline__ f32x4 ror1_4(f32x4 v) { return (f32x4){row_ror1(v.x), row_ror1(v.y), row_ror1(v.z), row_ror1(v.w)}; }
__device__ __forceinline__ f32x4 ror2_4(f32x4 v) { return (f32x4){row_ror2(v.x), row_ror2(v.y), row_ror2(v.z), row_ror2(v.w)}; }

struct EpiResidual {
    float* XF; bf16_t* XB; float* SSQ; float sign;
    __device__ __forceinline__ void operator()(AccRef acc, const pg8::Unit& u, int wr, int wc, int fr, int fq) const {
        const int pm = RFL(u.pm), pn = RFL(u.pn);
        const rsrc_t rb = mkrsrc(XB + (size_t)pm * 256 * DM + pn * 256), rs = mkrsrc(SSQ + (size_t)pm * 256 * 16 + pn * 4 + wc);
        const bool fin = XF != nullptr;
        const rsrc_t rx = mkrsrc((fin ? XF : (float*)XB) + (size_t)pm * 256 * DM + pn * 256);
        const int vx = ((wr * 64 + fr) * DM + wc * 32 + 8 * fq) * 4, vb = vx >> 1, vs = (wr * 64 + fr) * 64;
        u32x4 xin[2][4][2];
#pragma unroll
        for (int ai = 0; ai < 2; ++ai)
#pragma unroll
            for (int m = 0; m < 4; ++m)
#pragma unroll
                for (int bj = 0; bj < 2; ++bj) xin[ai][m][bj] = BLD128(rb, vb, (((ai * 128 + m * 16) * DM + bj * 128) * 4) >> 1);
#pragma unroll
        for (int ai = 0; ai < 2; ++ai) {
#pragma unroll
            for (int m = 0; m < 4; ++m) {
                float s = 0.f;
#pragma unroll
                for (int bj = 0; bj < 2; ++bj) {
                    const int so = ((ai * 128 + m * 16) * DM + bj * 128) * 4;
                    const u32x4 xo = xin[ai][m][bj];
                    f32x4 a = (f32x4){bflo(xo.x), bfhi(xo.x), bflo(xo.y), bfhi(xo.y)}, b = (f32x4){bflo(xo.z), bfhi(xo.z), bflo(xo.w), bfhi(xo.w)};
#if MK_DUP
                    a += acc[ai][bj][m][0] * sign; b += acc[ai][bj][m][1] * sign;
#else
                    a += acc[ai][bj][m][0]; b += acc[ai][bj][m][1];
#endif
                    BST128(pack8(a, b), rb, vb, so >> 1);
                    if (fin) { BST128(asu4(a), rx, vx, so); BST128(asu4(b), rx, vx, so + 16); }
                    s += (a.x * a.x + a.y * a.y) + (a.z * a.z + a.w * a.w) + (b.x * b.x + b.y * b.y) + (b.z * b.z + b.w * b.w);
                }
                s = xrow_sum(s);
                if (fq == 0) __builtin_amdgcn_raw_buffer_store_b32(__builtin_bit_cast(unsigned, s), rs, vs, (ai * 128 + m * 16) * 64, 0);
            }
        }
    }
};

struct EpiEvenIn {
    const float* SSQ; const float* qg; const float* kg;
    bf16_t *Q, *KV, *IK, *IQ, *U; float* IW; LAS unsigned char* lds;
    __device__ __forceinline__ void operator()(AccRef acc, const pg8::Unit& u, int wr, int wc, int fr, int fq) const {
        const int pm = RFL(u.pm), pn = RFL(u.pn);
        int kind;
        bf16_t* dst; int rowstride, bjoff; const float* gain = qg; float post = 1.f;
        if (pn <= 1) { kind = 0; dst = Q + (4 * pn + wc) * 64; rowstride = 512; bjoff = 32; gain = qg; post = 0.125f * 1.4426950408889634f; }
        else if (pn == 2) {
            if (wc == 0) { kind = 0; dst = KV; rowstride = 128; bjoff = 32; gain = kg; }
            else if (wc == 1) { kind = 1; dst = KV + 64; rowstride = 128; bjoff = 32; }
            else if (wc == 2) { kind = 1; dst = IK; rowstride = 64; bjoff = 32; }
            else { kind = 2; dst = (bf16_t*)IW; rowstride = 8; bjoff = 0; }
        }
        else if (pn == 3) { kind = 1; dst = IQ + wc * 64; rowstride = 256; bjoff = 32; }
        else { kind = 3; dst = U + 256 * (pn - 4) + 32 * wc; rowstride = 512; bjoff = 128; }
        const rsrc_t rd = mkrsrc(dst + (size_t)pm * 256 * rowstride), rq = mkrsrc(SSQ + (size_t)pm * 256 * 16);
        const int vq = (wr * 64 + fr) * 64;
        int vd = ((wr * 64 + fr) * rowstride + 8 * fq) * 2;
        int rsb = rowstride * 2, bjb = bjoff * 2;
        if (pn == 2 && wc == 2) { vd = fq * 256 + fr * 16 + wr * 8192; bjb = 1024; }
        f32x4 gn[2][2];
#pragma unroll
        for (int bj = 0; bj < 2; ++bj) { gn[bj][0] = (f32x4){1.f, 1.f, 1.f, 1.f}; gn[bj][1] = gn[bj][0]; if (kind == 0) { gn[bj][0] = *(const f32x4*)(gain + 32 * bj + 8 * fq); gn[bj][1] = *(const f32x4*)(gain + 32 * bj + 8 * fq + 4); } }
        const LAS float* rsl = rs_stage(rq, lds, wr, wc, fr, fq);
#pragma unroll
        for (int ai = 0; ai < 2; ++ai) {
#pragma unroll
            for (int m = 0; m < 4; ++m) {
                float r = rsl[64 * ai + 16 * m + fr];
                if (kind == 0) {
                    float ss = 0.f;
#pragma unroll
                    for (int bj = 0; bj < 2; ++bj)
#pragma unroll
                        for (int n = 0; n < 2; ++n) { const f32x4 v = acc[ai][bj][m][n]; ss += (v.x * v.x + v.y * v.y) + (v.z * v.z + v.w * v.w); }
                    ss = xrow_sum(ss);
                    ss *= r * r;
                    r *= rsqrtf(ss * (1.f / 64.f) + EPS) * post;
                }
                if (kind == 2) {
                    if (fq == 0) BST128(asu4(acc[ai][0][m][0] * (r * 0.0625f)), rd, (wr * 64 + fr) * 16, (ai * 128 + m * 16) * 16);
                } else {
#pragma unroll
                    for (int bj = 0; bj < 2; ++bj) {
                        const f32x4 g0 = gn[bj][0], g1 = gn[bj][1];
                        BST128(pack8(acc[ai][bj][m][0] * r * g0, acc[ai][bj][m][1] * r * g1), rd, vd, (ai * 128 + m * 16) * rsb + bj * bjb);
                    }
                }
            }
        }
    }
};

template <int mode> struct EpiHead128 {
    const float* SSQ;
    const float* RS;
    bf16_t* dst; float* HSS; LAS unsigned char* lds;
    __device__ __forceinline__ void operator()(AccRef acc, const pg8::Unit& u, int wr, int wc, int fr, int fq) const {
        const int pm = RFL(u.pm), pn = RFL(u.pn);
        const int layer = (mode == 1) ? (pn >> 2) : 0, jt = (mode == 1) ? (pn & 3) : pn;
        const bool khead = (mode == 0) || (jt < 2);
        const rsrc_t rq = (mode == 0) ? mkrsrc(SSQ + (size_t)pm * 256 * 16) : mkrsrc(RS + (size_t)pm * 256);
        const int vq = (wr * 64 + fr) * 64, vr = (wr * 64 + fr) * 4;
        int rowstride, bjoff; bf16_t* d0; size_t hrow0;
        if (mode == 0) { rowstride = 512; bjoff = 32; d0 = dst + (size_t)pm * 256 * 512 + (2 * jt + (wc >> 1)) * 128 + 64 * (wc & 1); hrow0 = (size_t)pm * 256; }
        else if (jt < 2) { rowstride = 1024; bjoff = 32; d0 = dst + ((size_t)layer * MEMTOK + pm * 256) * 1024 + (2 * jt + (wc >> 1)) * 128 + 64 * (wc & 1); hrow0 = (size_t)layer * MEMTOK + pm * 256; }
        else { rowstride = 1024; bjoff = 128; d0 = dst + ((size_t)layer * MEMTOK + pm * 256) * 1024 + 512 + 256 * (jt - 2) + 32 * wc; hrow0 = 0; }
        const rsrc_t rd = mkrsrc(d0), rh = mkrsrc(HSS + hrow0 * 8 + (2 * (khead ? jt : 0) + (wc >> 1)) * 2 + (wc & 1));
        const int vd = ((wr * 64 + fr) * rowstride + 8 * fq) * 2, rsb = rowstride * 2, bjb = bjoff * 2, vh = (wr * 64 + fr) * 32;
        const LAS float* rsl = nullptr; if constexpr (mode == 0) rsl = rs_stage(rq, lds, wr, wc, fr, fq);
#pragma unroll
        for (int ai = 0; ai < 2; ++ai) {
            float rr[4];
            if constexpr (mode == 0) {
#pragma unroll
                for (int m = 0; m < 4; ++m) rr[m] = rsl[64 * ai + 16 * m + fr];
            } else {
#pragma unroll
                for (int m = 0; m < 4; ++m) rr[m] = __builtin_bit_cast(float, __builtin_amdgcn_raw_buffer_load_b32(rq, vr, (ai * 128 + m * 16) * 4, 0));
            }
#pragma unroll
            for (int m = 0; m < 4; ++m) {
                const float r = rr[m];
                if (khead) {
                    float ss = 0.f;
#pragma unroll
                    for (int bj = 0; bj < 2; ++bj)
#pragma unroll
                        for (int n = 0; n < 2; ++n) { const f32x4 v = acc[ai][bj][m][n]; ss += (v.x * v.x + v.y * v.y) + (v.z * v.z + v.w * v.w); }
                    ss = xrow_sum(ss);
                    if (fq == 0) __builtin_amdgcn_raw_buffer_store_b32(__builtin_bit_cast(unsigned, ss * r * r), rh, vh, (ai * 128 + m * 16) * 32, 0);
                }
#pragma unroll
                for (int bj = 0; bj < 2; ++bj) BST128(pack8(acc[ai][bj][m][0] * r, acc[ai][bj][m][1] * r), rd, vd, (ai * 128 + m * 16) * rsb + bj * bjb);
            }
        }
    }
};

struct EpiGlu {
    const bf16_t* YG; const float* bias; bf16_t* A2;
    __device__ __forceinline__ void operator()(AccRef acc, const pg8::Unit& u, int wr, int wc, int fr, int fq) const {
        const int pm = RFL(u.pm), pn = RFL(u.pn);
        const int col0 = pn * 256 + wc * 32 + 8 * fq;
        const rsrc_t ry = mkrsrc(YG + (size_t)pm * 256 * 512 + pn * 256), ro = mkrsrc(A2 + (size_t)pm * 256 * 1024 + 512 + pn * 256);
        const int vy = ((wr * 64 + fr) * 512 + wc * 32 + 8 * fq) * 2, vo = ((wr * 64 + fr) * 1024 + wc * 32 + 8 * fq) * 2;
        f32x4 bv[2][2];
#pragma unroll
        for (int bj = 0; bj < 2; ++bj) { bv[bj][0] = *(const f32x4*)(bias + col0 + bj * 128); bv[bj][1] = *(const f32x4*)(bias + col0 + bj * 128 + 4); }
#pragma unroll
        for (int ai = 0; ai < 2; ++ai) {
            u32x4 yin[4][2];
#pragma unroll
            for (int m = 0; m < 4; ++m)
#pragma unroll
                for (int bj = 0; bj < 2; ++bj) yin[m][bj] = BLD128(ry, vy, ((ai * 128 + m * 16) * 512 + bj * 128) * 2);
#pragma unroll
            for (int m = 0; m < 4; ++m) {
#pragma unroll
                for (int bj = 0; bj < 2; ++bj) {
                    const u32x4 y = yin[m][bj];
                    const f32x4 a = acc[ai][bj][m][0] + bv[bj][0], b = acc[ai][bj][m][1] + bv[bj][1];
                    f32x4 o0, o1;
                    o0.x = bflo(y.x) * sigmoid_f(a.x); o0.y = bfhi(y.x) * sigmoid_f(a.y); o0.z = bflo(y.y) * sigmoid_f(a.z); o0.w = bfhi(y.y) * sigmoid_f(a.w);
                    o1.x = bflo(y.z) * sigmoid_f(b.x); o1.y = bfhi(y.z) * sigmoid_f(b.y); o1.z = bflo(y.w) * sigmoid_f(b.z); o1.w = bfhi(y.w) * sigmoid_f(b.w);
                    BST128(pack8(o0, o1), ro, vo, ((ai * 128 + m * 16) * 1024 + bj * 128) * 2);
                }
            }
        }
    }
};

__device__ __forceinline__ f32x4 shfl4(f32x4 v, int src) { f32x4 r; r.x = __shfl(v.x, src); r.y = __shfl(v.y, src); r.z = __shfl(v.z, src); r.w = __shfl(v.w, src); return r; }
__device__ __forceinline__ f32x4 sel4(bool c, f32x4 a, f32x4 b) { return c ? a : b; }

struct EpiFfnUp {
    const float* SSQ; const float* cw; const float* cb;
    bf16_t* ACT; float* TAIL; float* HEAD; LAS unsigned char* lds;
    __device__ __forceinline__ void operator()(AccRef acc, const pg8::Unit& u, int wr, int wc, int fr, int fq) const {
        const int pm = RFL(u.pm), pn = RFL(u.pn);
        const int chl = 32 * wc + 8 * fq, ch0 = 128 * pn + chl;
        const size_t tix = (size_t)pm * 22 + pn;
        const rsrc_t rq = mkrsrc(SSQ + (size_t)pm * 256 * 16), ra = mkrsrc(ACT + (size_t)pm * 256 * DFF + 128 * pn);
        const int vq = (wr * 64 + fr) * 64, va = ((wr * 64 + fr) * DFF + chl) * 2;
        f32x4 w0v[2], w1v[2], w2v[2], bbv[2], w0a[2], w1a[2];
#pragma unroll
        for (int n = 0; n < 2; ++n) { w0v[n] = *(const f32x4*)(cw + ch0 + 4 * n); w1v[n] = *(const f32x4*)(cw + DFF + ch0 + 4 * n); w2v[n] = *(const f32x4*)(cw + 2 * DFF + ch0 + 4 * n); bbv[n] = *(const f32x4*)(cb + ch0 + 4 * n); }
        const LAS float* rsl = rs_stage(rq, lds, wr, wc, fr, fq);
        const f32x4 z4 = (f32x4){0.f, 0.f, 0.f, 0.f};
#pragma unroll
        for (int n = 0; n < 2; ++n) { w1a[n] = (fr == 0) ? w1v[n] : z4; w0a[n] = (fr < 2) ? w0v[n] : z4; }
#pragma unroll
        for (int ai = 0; ai < 2; ++ai) {
            float rr[4];
#pragma unroll
            for (int m = 0; m < 4; ++m) rr[m] = rsl[64 * ai + 16 * m + fr];
            f32x4 gp[2] = {z4, z4};
#pragma unroll
            for (int m = 0; m < 4; ++m) {
                const float r = rr[m];
                unsigned pk[4];
#pragma unroll
                for (int n = 0; n < 2; ++n) {
                    float* hd = HEAD + ((tix * 4 + 2 * ai + wr) * 4) * 128 + chl + 4 * n; float* tl = TAIL + ((tix * 4 + 2 * ai + wr) * 2) * 128 + chl + 4 * n;
                    const f32x4 g = acc[ai][0][m][n] * r, uu = acc[ai][1][m][n] * r;
                    f32x4 cg = w2v[n] * g + bbv[n];
                    conv_taps(cg, g, w1v[n], w0v[n]);
                    if (m > 0) conv_taps_prev(cg, gp[n], w1a[n], w0a[n]);
                    f32x4 o;
                    o.x = (cg.x * uu.x) * __builtin_amdgcn_rcpf(1.f + __builtin_amdgcn_exp2f(cg.x * -1.4426950408889634f));
                    o.y = (cg.y * uu.y) * __builtin_amdgcn_rcpf(1.f + __builtin_amdgcn_exp2f(cg.y * -1.4426950408889634f));
                    o.z = (cg.z * uu.z) * __builtin_amdgcn_rcpf(1.f + __builtin_amdgcn_exp2f(cg.z * -1.4426950408889634f));
                    o.w = (cg.w * uu.w) * __builtin_amdgcn_rcpf(1.f + __builtin_amdgcn_exp2f(cg.w * -1.4426950408889634f));
                    if (m == 0 && fr < 2) { *(f32x4*)(hd + fr * 128) = g; *(f32x4*)(hd + (2 + fr) * 128) = uu; }
                    if (m == 3 && fr >= 14) *(f32x4*)(tl + (fr - 14) * 128) = g;
                    pk[2 * n] = cvt_pk_bf16(o.x, o.y); pk[2 * n + 1] = cvt_pk_bf16(o.z, o.w);
                    gp[n] = g;
                }
                BST128(((u32x4){pk[0], pk[1], pk[2], pk[3]}), ra, va, ((ai * 128 + m * 16) * DFF) * 2);
            }
        }
    }
};

struct EpiOddIn {
    const float* SSQ; const float* cw; const float* cb;
    bf16_t* MIX; float* TAIL; float* HEAD; LAS unsigned char* lds;
    __device__ __forceinline__ void operator()(AccRef acc, const pg8::Unit& u, int wr, int wc, int fr, int fq) const {
        const int pm = RFL(u.pm), pn = RFL(u.pn);
        const int chl = 16 * wc + 4 * fq, ch0 = 64 * pn + chl;
        const size_t tix = (size_t)pm * 16 + pn;
        const rsrc_t rq = mkrsrc(SSQ + (size_t)pm * 256 * 16), ra = mkrsrc(MIX + (size_t)pm * 256 * DM + 64 * pn);
        const int vq = (wr * 64 + fr) * 64, va = ((wr * 64 + fr) * DM + chl) * 2;
        const f32x4 w0 = *(const f32x4*)(cw + ch0), w1 = *(const f32x4*)(cw + 1024 + ch0), w2 = *(const f32x4*)(cw + 2048 + ch0), bb = *(const f32x4*)(cb + ch0);
        const LAS float* rsl = rs_stage(rq, lds, wr, wc, fr, fq);
        const f32x4 z4 = (f32x4){0.f, 0.f, 0.f, 0.f};
        const f32x4 w1a = (fr == 0) ? w1 : z4, w0a = (fr < 2) ? w0 : z4;
#pragma unroll
        for (int ai = 0; ai < 2; ++ai) {
            float rr[4];
#pragma unroll
            for (int m = 0; m < 4; ++m) rr[m] = rsl[64 * ai + 16 * m + fr];
            float* hd = HEAD + ((tix * 4 + 2 * ai + wr) * 4) * 64 + chl; float* tl = TAIL + ((tix * 4 + 2 * ai + wr) * 2) * 64 + chl;
            f32x4 pprev = (f32x4){0.f, 0.f, 0.f, 0.f};
#pragma unroll
            for (int m = 0; m < 4; ++m) {
                const float r = rr[m];
                const f32x4 gb = acc[ai][0][m][0] * r, p = acc[ai][0][m][1] * acc[ai][1][m][0] * (r * r);
                f32x4 cv = w2 * p + bb;
                conv_taps(cv, p, w1, w0);
                if (m > 0) conv_taps_prev(cv, pprev, w1a, w0a);
                const f32x4 y = gb * cv;
                if (m == 0 && fr < 2) { *(f32x4*)(hd + fr * 64) = p; *(f32x4*)(hd + (2 + fr) * 64) = gb; }
                if (m == 3 && fr >= 14) *(f32x4*)(tl + (fr - 14) * 64) = p;
                BST64(((u32x2){cvt_pk_bf16(y.x, y.y), cvt_pk_bf16(y.z, y.w)}), ra, va, (ai * 128 + m * 16) * DM * 2);
                pprev = p;
            }
        }
    }
};


struct EpiNull {
    __device__ __forceinline__ void operator()(AccRef acc, const pg8::Unit& u, int wr, int wc, int fr, int fq) const {
#pragma unroll
        for (int ai = 0; ai < 2; ++ai)
#pragma unroll
            for (int bj = 0; bj < 2; ++bj)
#pragma unroll
                for (int m = 0; m < 4; ++m)
#pragma unroll
                    for (int n = 0; n < 2; ++n) asm volatile("" :: "v"(acc[ai][bj][m][n]));
    }
};

struct EpiPlain {
    bf16_t* O; int ldc;
    __device__ __forceinline__ void operator()(AccRef acc, const pg8::Unit& u, int wr, int wc, int fr, int fq) const {
        const int pm = RFL(u.pm), pn = RFL(u.pn);
        const rsrc_t rd = mkrsrc(O + (size_t)pm * 256 * ldc + pn * 256);
        const int vd = ((wr * 64 + fr) * ldc + wc * 32 + 8 * fq) * 2;
#pragma unroll
        for (int ai = 0; ai < 2; ++ai)
#pragma unroll
            for (int m = 0; m < 4; ++m)
#pragma unroll
                for (int bj = 0; bj < 2; ++bj) BST128(pack8(acc[ai][bj][m][0], acc[ai][bj][m][1]), rd, vd, ((ai * 128 + m * 16) * ldc + bj * 128) * 2);
    }
};

__device__ __forceinline__ void fixup_ffn(const Params& P, int layer, int gtid, int gthreads) {
    const float* TAIL = (const float*)(P.ws + WS_HALO2 + HALO_FT); const float* HEAD = (const float*)(P.ws + WS_HALO2 + HALO_FH);
    const float* cw = P.in[I_FCONV_W] + (size_t)layer * 3 * DFF; const float* cb = P.in[I_FCONV_B] + (size_t)layer * DFF; bf16_t* ACT = (bf16_t*)(P.ws + WS_R + R_ACT);
    constexpr int NIT = 128 * 22 * 4 * 2 * 32, NB = 3;
#pragma unroll 1
    for (int base = gtid; base < NIT; base += NB * gthreads) {
        f32x4 w0[NB], w1[NB], w2[NB], bb[NB], gm2[NB], gm1[NB], g0[NB], g1[NB], uu[NB]; bool ok[NB]; size_t dst[NB]; int rr[NB];
#pragma unroll
        for (int k = 0; k < NB; ++k) {
            const int idx = base + k * gthreads;
            const int ch = 4 * (idx & 31), r = (idx >> 5) & 1, q4 = (idx >> 6) & 3, t = idx >> 8, pn = t % 22, pm = t / 22;
            ok[k] = idx < NIT && !((pm & 15) == 0 && q4 == 0); rr[k] = r;
            if (ok[k]) {
                const size_t bcur = ((size_t)pm * 22 + pn) * 4 + q4, bprev = q4 ? bcur - 1 : ((size_t)(pm - 1) * 22 + pn) * 4 + 3;
                const float* Tl = TAIL + bprev * 256 + ch; const float* H = HEAD + bcur * 512 + ch; const int c = 128 * pn + ch;
                w0[k] = *(const f32x4*)(cw + c); w1[k] = *(const f32x4*)(cw + DFF + c); w2[k] = *(const f32x4*)(cw + 2 * DFF + c); bb[k] = *(const f32x4*)(cb + c);
                gm2[k] = *(const f32x4*)Tl; gm1[k] = *(const f32x4*)(Tl + 128); g0[k] = *(const f32x4*)H; g1[k] = *(const f32x4*)(H + 128); uu[k] = *(const f32x4*)(H + (2 + r) * 128);
                dst[k] = ((size_t)pm * 256 + q4 * 64 + r) * DFF + c;
            }
        }
#pragma unroll
        for (int k = 0; k < NB; ++k) if (ok[k]) {
            const f32x4 cg = rr[k] == 0 ? (w0[k] * gm2[k] + w1[k] * gm1[k] + w2[k] * g0[k] + bb[k]) : (w0[k] * gm1[k] + w1[k] * g0[k] + w2[k] * g1[k] + bb[k]);
            *(u32x2*)(ACT + dst[k]) = (u32x2){cvt_pk_bf16(silu_f(cg.x) * uu[k].x, silu_f(cg.y) * uu[k].y), cvt_pk_bf16(silu_f(cg.z) * uu[k].z, silu_f(cg.w) * uu[k].w)};
        }
    }
}
__device__ __forceinline__ void fixup_odd(const Params& P, int j, int gtid, int gthreads) {
    const float* TAIL = (const float*)(P.ws + WS_HALO2 + HALO_OT); const float* HEAD = (const float*)(P.ws + WS_HALO2 + HALO_OH);
    const float* cw = P.in[I_OCONV_W] + (size_t)j * 3 * 1024; const float* cb = P.in[I_OCONV_B] + (size_t)j * 1024; bf16_t* MIX = (bf16_t*)(P.ws + WS_R + R_MIX);
    constexpr int NIT = 128 * 16 * 4 * 2 * 16, NB = 2;
#pragma unroll 1
    for (int base = gtid; base < NIT; base += NB * gthreads) {
        f32x4 w0[NB], w1[NB], w2[NB], bb[NB], pm2[NB], pm1[NB], p0[NB], p1[NB], gb[NB]; bool ok[NB]; size_t dst[NB]; int rr[NB];
#pragma unroll
        for (int k = 0; k < NB; ++k) {
            const int idx = base + k * gthreads;
            const int ch = 4 * (idx & 15), r = (idx >> 4) & 1, q4 = (idx >> 5) & 3, t = idx >> 7, pn = t & 15, pm = t >> 4;
            ok[k] = idx < NIT && !((pm & 15) == 0 && q4 == 0); rr[k] = r;
            if (ok[k]) {
                const size_t bcur = ((size_t)pm * 16 + pn) * 4 + q4, bprev = q4 ? bcur - 1 : ((size_t)(pm - 1) * 16 + pn) * 4 + 3;
                const float* Tl = TAIL + bprev * 128 + ch; const float* H = HEAD + bcur * 256 + ch; const int c = 64 * pn + ch;
                w0[k] = *(const f32x4*)(cw + c); w1[k] = *(const f32x4*)(cw + 1024 + c); w2[k] = *(const f32x4*)(cw + 2048 + c); bb[k] = *(const f32x4*)(cb + c);
                pm2[k] = *(const f32x4*)Tl; pm1[k] = *(const f32x4*)(Tl + 64); p0[k] = *(const f32x4*)H; p1[k] = *(const f32x4*)(H + 64); gb[k] = *(const f32x4*)(H + (2 + r) * 64);
                dst[k] = ((size_t)pm * 256 + q4 * 64 + r) * DM + c;
            }
        }
#pragma unroll
        for (int k = 0; k < NB; ++k) if (ok[k]) {
            const f32x4 cv = rr[k] == 0 ? (w0[k] * pm2[k] + w1[k] * pm1[k] + w2[k] * p0[k] + bb[k]) : (w0[k] * pm1[k] + w1[k] * p0[k] + w2[k] * p1[k] + bb[k]);
            const f32x4 y = gb[k] * cv;
            *(u32x2*)(MIX + dst[k]) = (u32x2){cvt_pk_bf16(y.x, y.y), cvt_pk_bf16(y.z, y.w)};
        }
    }
}

#define MFMA16(a, b, c) __builtin_amdgcn_mfma_f32_16x16x32_bf16((a), (b), (c), 0, 0, 0)
constexpr int EH_STRIDE = 132;
__device__ __forceinline__ void s5_unit(const Params& P, LAS unsigned char* lds, int j, int b, int g, int wave, int lane) {
    const unsigned char* op = P.ws + WS_S5OP + (size_t)(j * 32 + g) * S5OP_STRIDE;
    const bf16_t* Km = (const bf16_t*)op; const bf16_t* Pm = (const bf16_t*)(op + S5OP_PM); const bf16_t* Qm = (const bf16_t*)(op + S5OP_QM); const f32x2* A16 = (const f32x2*)(op + S5OP_A16);
    const bf16_t* U = (const bf16_t*)(P.ws + WS_R + R_U); bf16_t* YG = (bf16_t*)(P.ws + WS_R + R_YG);
    const float* Dv = P.in[I_S5D] + (size_t)j * 512 + 16 * g;
    LAS float* EH = (LAS float*)lds;
    const int l15 = lane & 15, kb = lane >> 4;
    bf16x8 ub[2][8];
#pragma unroll
    for (int q = 0; q < 2; ++q) { const int chunk = 16 * (2 * wave + q) + l15;
#pragma unroll
        for (int ks = 0; ks < 8; ++ks) ub[q][ks] = *(const bf16x8*)(U + ((size_t)(b * SEQ + chunk * 16 + 2 * ks + (kb >> 1))) * 512 + 16 * g + 8 * (kb & 1)); }
#pragma unroll 2
    for (int mt = 0; mt < 8; ++mt) {
        f32x4 acc0 = (f32x4){0.f, 0.f, 0.f, 0.f}, acc1 = acc0;
#pragma unroll
        for (int ks = 0; ks < 8; ++ks) { const bf16x8 a = *(const bf16x8*)(Pm + (mt * 8 + ks) * 512 + 8 * lane); acc0 = MFMA16(a, ub[0][ks], acc0); acc1 = MFMA16(a, ub[1][ks], acc1); }
        *(LAS f32x4*)(EH + (16 * (2 * wave) + l15) * EH_STRIDE + 16 * mt + 4 * kb) = acc0;
        *(LAS f32x4*)(EH + (16 * (2 * wave + 1) + l15) * EH_STRIDE + 16 * mt + 4 * kb) = acc1;
    }
    __syncthreads();
    {
        const f32x2 a16 = A16[lane];
        LAS f32x2* HL = (LAS f32x2*)(lds + 256 * EH_STRIDE * 4);
        f32x2 h = (f32x2){0.f, 0.f};
#pragma unroll 4
        for (int k = 0; k < 32; ++k) {
            LAS f32x2* e = (LAS f32x2*)(EH + (32 * wave + k) * EH_STRIDE) + lane;
            const f32x2 ev = *e; *e = h;
            h = (f32x2){a16.x * h.x - a16.y * h.y + ev.x, a16.x * h.y + a16.y * h.x + ev.y};
        }
        HL[wave * 64 + lane] = h;
        f32x2 p32 = a16;
#pragma unroll
        for (int i = 0; i < 5; ++i) p32 = cmul(p32, p32);
        __syncthreads();
        f32x2 hin = (f32x2){0.f, 0.f};
        for (int v = 0; v < wave; ++v) { const f32x2 ev = HL[v * 64 + lane]; hin = (f32x2){p32.x * hin.x - p32.y * hin.y + ev.x, p32.x * hin.y + p32.y * hin.x + ev.y}; }
        if (wave > 0) {
            f32x2 t = hin;
#pragma unroll 4
            for (int k = 0; k < 32; ++k) {
                LAS f32x2* e = (LAS f32x2*)(EH + (32 * wave + k) * EH_STRIDE) + lane;
                const f32x2 ev = *e; *e = (f32x2){ev.x + t.x, ev.y + t.y};
                t = cmul(a16, t);
            }
        }
    }
    __syncthreads();
    {
        bf16x8 hb[2][4];
#pragma unroll
        for (int q = 0; q < 2; ++q) { const int chunk = 16 * (2 * wave + q) + l15;
#pragma unroll
            for (int ks = 0; ks < 4; ++ks) { const f32x4 h0 = *(const LAS f32x4*)(EH + chunk * EH_STRIDE + 32 * ks + 8 * kb), h1 = *(const LAS f32x4*)(EH + chunk * EH_STRIDE + 32 * ks + 8 * kb + 4); hb[q][ks] = as_bf16x8(pack8(h0, h1)); } }
        const f32x4 dv = *(const f32x4*)(Dv + 4 * kb);
#pragma unroll 2
        for (int mt = 0; mt < 16; ++mt) {
            f32x4 acc[2]; acc[0] = (f32x4){0.f, 0.f, 0.f, 0.f}; acc[1] = acc[0];
#pragma unroll
            for (int ks = 0; ks < 4; ++ks) { const bf16x8 a = *(const bf16x8*)(Qm + (mt * 4 + ks) * 512 + 8 * lane); acc[0] = MFMA16(a, hb[0][ks], acc[0]); acc[1] = MFMA16(a, hb[1][ks], acc[1]); }
#pragma unroll
            for (int ks = 0; ks < 8; ++ks) {
                if (2 * ks <= mt) { const int dd = mt - 2 * ks - (kb >> 1) + 1; const bf16x8 a = *(const bf16x8*)(Km + (dd * 16 + l15) * 16 + 8 * (kb & 1)); acc[0] = MFMA16(a, ub[0][ks], acc[0]); acc[1] = MFMA16(a, ub[1][ks], acc[1]); }
            }
#pragma unroll
            for (int q = 0; q < 2; ++q) {
                const int chunk = 16 * (2 * wave + q) + l15;
                const size_t off = ((size_t)(b * SEQ + chunk * 16 + mt)) * 512 + 16 * g + 4 * kb;
                const u32x2 uw = *(const u32x2*)(U + off);
                f32x4 y; y.x = acc[q].x + dv.x * bflo(uw.x); y.y = acc[q].y + dv.y * bfhi(uw.x); y.z = acc[q].z + dv.z * bflo(uw.y); y.w = acc[q].w + dv.w * bfhi(uw.y);
                *(u32x2*)(YG + off) = (u32x2){cvt_pk_bf16(gelu_tanh_f(y.x), gelu_tanh_f(y.y)), cvt_pk_bf16(gelu_tanh_f(y.z), gelu_tanh_f(y.w))};
            }
        }
    }
    __syncthreads();
}

constexpr int SROW = 8208;
constexpr int SEL_OFF = 16 * SROW;
__device__ __forceinline__ unsigned tr_pair_lo_hi(unsigned a0, unsigned a1, s16x4& lo, s16x4& hi) {
    asm volatile("ds_read_b64_tr_b16 %0, %2\n\tds_read_b64_tr_b16 %1, %3\n\ts_waitcnt lgkmcnt(0)" : "=&v"(lo), "=&v"(hi) : "v"(a0), "v"(a1) : "memory");
    return 0;
}
__device__ __forceinline__ void tr_quad(const unsigned (&a0)[4], const unsigned (&a1)[4], s16x4 (&lo)[4], s16x4 (&hi)[4]) {
    asm volatile("ds_read_b64_tr_b16 %0, %8\n\tds_read_b64_tr_b16 %1, %9\n\tds_read_b64_tr_b16 %2, %10\n\tds_read_b64_tr_b16 %3, %11\n\t"
                 "ds_read_b64_tr_b16 %4, %12\n\tds_read_b64_tr_b16 %5, %13\n\tds_read_b64_tr_b16 %6, %14\n\tds_read_b64_tr_b16 %7, %15\n\ts_waitcnt lgkmcnt(0)"
                 : "=&v"(lo[0]), "=&v"(lo[1]), "=&v"(lo[2]), "=&v"(lo[3]), "=&v"(hi[0]), "=&v"(hi[1]), "=&v"(hi[2]), "=&v"(hi[3])
                 : "v"(a0[0]), "v"(a0[1]), "v"(a0[2]), "v"(a0[3]), "v"(a1[0]), "v"(a1[1]), "v"(a1[2]), "v"(a1[3]) : "memory");
}
template <int OFF>
__device__ __forceinline__ void tr_quad_off(const unsigned (&a0)[4], const unsigned (&a1)[4], s16x4 (&lo)[4], s16x4 (&hi)[4]) {
    asm volatile("ds_read_b64_tr_b16 %0, %8 offset:%16\n\tds_read_b64_tr_b16 %1, %9 offset:%16\n\tds_read_b64_tr_b16 %2, %10 offset:%16\n\tds_read_b64_tr_b16 %3, %11 offset:%16\n\t"
                 "ds_read_b64_tr_b16 %4, %12 offset:%16\n\tds_read_b64_tr_b16 %5, %13 offset:%16\n\tds_read_b64_tr_b16 %6, %14 offset:%16\n\tds_read_b64_tr_b16 %7, %15 offset:%16\n\ts_waitcnt lgkmcnt(0)"
                 : "=&v"(lo[0]), "=&v"(lo[1]), "=&v"(lo[2]), "=&v"(lo[3]), "=&v"(hi[0]), "=&v"(hi[1]), "=&v"(hi[2]), "=&v"(hi[3])
                 : "v"(a0[0]), "v"(a0[1]), "v"(a0[2]), "v"(a0[3]), "v"(a1[0]), "v"(a1[1]), "v"(a1[2]), "v"(a1[3]), "n"(OFF) : "memory");
}
template <int OFF>
__device__ __forceinline__ void tr_issue_off(const unsigned (&a0)[4], const unsigned (&a1)[4], s16x4 (&lo)[4], s16x4 (&hi)[4]) {
    asm volatile("ds_read_b64_tr_b16 %0, %8 offset:%16\n\tds_read_b64_tr_b16 %1, %9 offset:%16\n\tds_read_b64_tr_b16 %2, %10 offset:%16\n\tds_read_b64_tr_b16 %3, %11 offset:%16\n\t"
                 "ds_read_b64_tr_b16 %4, %12 offset:%16\n\tds_read_b64_tr_b16 %5, %13 offset:%16\n\tds_read_b64_tr_b16 %6, %14 offset:%16\n\tds_read_b64_tr_b16 %7, %15 offset:%16"
                 : "=&v"(lo[0]), "=&v"(lo[1]), "=&v"(lo[2]), "=&v"(lo[3]), "=&v"(hi[0]), "=&v"(hi[1]), "=&v"(hi[2]), "=&v"(hi[3])
                 : "v"(a0[0]), "v"(a0[1]), "v"(a0[2]), "v"(a0[3]), "v"(a1[0]), "v"(a1[1]), "v"(a1[2]), "v"(a1[3]), "n"(OFF) : "memory");
}
__device__ __forceinline__ void tr_wait16(s16x4 (&l0)[4], s16x4 (&h0)[4], s16x4 (&l1)[4], s16x4 (&h1)[4]) {
    asm volatile("s_waitcnt lgkmcnt(0)" : "+v"(l0[0]), "+v"(l0[1]), "+v"(l0[2]), "+v"(l0[3]), "+v"(h0[0]), "+v"(h0[1]), "+v"(h0[2]), "+v"(h0[3]),
                 "+v"(l1[0]), "+v"(l1[1]), "+v"(l1[2]), "+v"(l1[3]), "+v"(h1[0]), "+v"(h1[1]), "+v"(h1[2]), "+v"(h1[3]) :: "memory");
}
__device__ __forceinline__ bf16x8 join8(s16x4 lo, s16x4 hi) { bf16x8 r; r[0] = lo[0]; r[1] = lo[1]; r[2] = lo[2]; r[3] = lo[3]; r[4] = hi[0]; r[5] = hi[1]; r[6] = hi[2]; r[7] = hi[3]; return r; }

struct Mask8 { unsigned long long m[8]; };
__device__ __forceinline__ Mask8 ge_masks8(unsigned t, unsigned k0, unsigned k1, unsigned k2, unsigned k3, unsigned k4, unsigned k5, unsigned k6, unsigned k7) {
    Mask8 r;
    asm("v_cmp_le_u32_e64 %0, %8, %9\n\tv_cmp_le_u32_e64 %1, %8, %10\n\tv_cmp_le_u32_e64 %2, %8, %11\n\tv_cmp_le_u32_e64 %3, %8, %12\n\t"
        "v_cmp_le_u32_e64 %4, %8, %13\n\tv_cmp_le_u32_e64 %5, %8, %14\n\tv_cmp_le_u32_e64 %6, %8, %15\n\tv_cmp_le_u32_e64 %7, %8, %16"
        : "=&s"(r.m[0]), "=&s"(r.m[1]), "=&s"(r.m[2]), "=&s"(r.m[3]), "=&s"(r.m[4]), "=&s"(r.m[5]), "=&s"(r.m[6]), "=&s"(r.m[7])
        : "s"(t), "v"(k0), "v"(k1), "v"(k2), "v"(k3), "v"(k4), "v"(k5), "v"(k6), "v"(k7));
    return r;
}
__device__ __forceinline__ int cnt_ge8(unsigned t, unsigned k0, unsigned k1, unsigned k2, unsigned k3, unsigned k4, unsigned k5, unsigned k6, unsigned k7) {
    const Mask8 r = ge_masks8(t, k0, k1, k2, k3, k4, k5, k6, k7);
    return (__popcll(r.m[0]) + __popcll(r.m[1])) + (__popcll(r.m[2]) + __popcll(r.m[3])) + (__popcll(r.m[4]) + __popcll(r.m[5])) + (__popcll(r.m[6]) + __popcll(r.m[7]));
}
__device__ __forceinline__ int mbcnt64(unsigned long long m, int base) { return __builtin_amdgcn_mbcnt_hi((unsigned)(m >> 32), __builtin_amdgcn_mbcnt_lo((unsigned)m, base)); }
__device__ __forceinline__ float relu_i(float x) { const int i = __builtin_bit_cast(int, x); return __builtin_bit_cast(float, i > 0 ? i : 0); }
typedef _Float16 f16x2 __attribute__((ext_vector_type(2)));
typedef short i16x2 __attribute__((ext_vector_type(2)));
__device__ __forceinline__ unsigned sortkey2(float a, float b) {
    const f16x2 h = (f16x2){(_Float16)a, (_Float16)b};
    const i16x2 m = __builtin_bit_cast(i16x2, h) >> 15;
    const unsigned u = __builtin_bit_cast(unsigned, h);
    return u ^ (__builtin_bit_cast(unsigned, m) | 0x80008000u);
}
__device__ __forceinline__ float xrow_max(float v) {
    float a = v, b = v;
    asm("s_nop 1\n\tv_permlane32_swap_b32_e32 %0, %1\n\ts_nop 1\n\tv_max_f32_e32 %0, %0, %1\n\tv_mov_b32_e32 %1, %0\n\ts_nop 1\n\tv_permlane16_swap_b32_e32 %0, %1\n\ts_nop 1\n\tv_max_f32_e32 %0, %0, %1" : "+v"(a), "+v"(b));
    return a;
}
__device__ __forceinline__ int cnt_ge4(unsigned t, unsigned k0, unsigned k1, unsigned k2, unsigned k3) {
    unsigned long long m0, m1, m2, m3;
    asm("v_cmp_le_u32_e64 %0, %4, %5\n\tv_cmp_le_u32_e64 %1, %4, %6\n\tv_cmp_le_u32_e64 %2, %4, %7\n\tv_cmp_le_u32_e64 %3, %4, %8"
        : "=&s"(m0), "=&s"(m1), "=&s"(m2), "=&s"(m3) : "s"(t), "v"(k0), "v"(k1), "v"(k2), "v"(k3));
    return (__popcll(m0) + __popcll(m1)) + (__popcll(m2) + __popcll(m3));
}
template <int NR, int SH>
__device__ __forceinline__ void dsa_pick(const unsigned (&kk)[NR], LAS unsigned short* sel, int lane, int cge0, unsigned floorT) {
    unsigned T = 0; int cge = cge0;
#pragma unroll 1
    for (int bit = 15; bit >= 0; --bit) {
        const unsigned trial = T | (1u << bit); int cnt = 0;
        if (trial <= floorT) { T = trial; cge = cge0; continue; }
#pragma unroll
        for (int i = 0; i < NR; i += 8) cnt += cnt_ge8(trial << SH, kk[i], kk[i + 1], kk[i + 2], kk[i + 3], kk[i + 4], kk[i + 5], kk[i + 6], kk[i + 7]);
        if (cnt >= 256) { T = trial; cge = cnt; }
    }
    const unsigned tge = T << SH, tgt = (SH && T >= 0xffffu) ? 0xffffffffu : ((T + 1u) << SH);
    int out_base = 0;
    if (cge == 256) {
#pragma unroll
        for (int i = 0; i < NR; i += 8) {
            const Mask8 ge = ge_masks8(tge, kk[i], kk[i + 1], kk[i + 2], kk[i + 3], kk[i + 4], kk[i + 5], kk[i + 6], kk[i + 7]);
#pragma unroll
            for (int j = 0; j < 8; ++j) {
                const unsigned long long tm = ge.m[j];
                const int pos = mbcnt64(tm, out_base);
                if (__builtin_amdgcn_inverse_ballot_w64(tm)) sel[pos] = (unsigned short)(SH ? (kk[i + j] & 0xffffu) : (unsigned)(64 * (i + j) + lane));
                out_base += __popcll(tm);
            }
        }
    } else {
        int room;
        { int cgt = 0;
#pragma unroll
          for (int i = 0; i < NR; i += 8) cgt += cnt_ge8(tgt, kk[i], kk[i + 1], kk[i + 2], kk[i + 3], kk[i + 4], kk[i + 5], kk[i + 6], kk[i + 7]);
          room = 256 - cgt; }
#pragma unroll
        for (int i = 0; i < NR; i += 8) {
            const Mask8 ge = ge_masks8(tge, kk[i], kk[i + 1], kk[i + 2], kk[i + 3], kk[i + 4], kk[i + 5], kk[i + 6], kk[i + 7]);
            const Mask8 gt = ge_masks8(tgt, kk[i], kk[i + 1], kk[i + 2], kk[i + 3], kk[i + 4], kk[i + 5], kk[i + 6], kk[i + 7]);
#pragma unroll
            for (int j = 0; j < 8; ++j) {
                unsigned long long tm = gt.m[j], eqm = ge.m[j] & ~gt.m[j];
                if (eqm != 0ull) {
                    const int ec = __popcll(eqm);
                    if (ec <= room) { tm |= eqm; room -= ec; }
                    else { while (room > 0) { const unsigned long long low = eqm & (0ull - eqm); tm |= low; eqm ^= low; --room; } }
                }
                const int pos = mbcnt64(tm, out_base);
                if (__builtin_amdgcn_inverse_ballot_w64(tm)) sel[pos] = (unsigned short)(SH ? (kk[i + j] & 0xffffu) : (unsigned)(64 * (i + j) + lane));
                out_base += __popcll(tm);
            }
        }
    }
}
template <int NR>
__device__ __forceinline__ void dsa_select(LAS unsigned char* lds, int q, int L, int lane) {
    const LAS unsigned short* srow = (const LAS unsigned short*)(lds + q * SROW);
    LAS unsigned short* sel = (LAS unsigned short*)(lds + SEL_OFF + q * 512);
    const int nreg = L >> 6;
    unsigned kk[NR];
#pragma unroll
    for (int i = 0; i < NR; ++i) kk[i] = (i < nreg) ? (unsigned)srow[64 * i + lane] : 0u;
    if constexpr (NR >= 32) {
        const int c0 = min(500, (448 * 512) / L + 8);
        unsigned Ts = 0;
#pragma unroll 1
        for (int bit = 15; bit >= 6; --bit) { const unsigned trial = Ts | (1u << bit);
            if (cnt_ge8(trial, kk[0], kk[NR / 8], kk[2 * NR / 8], kk[3 * NR / 8], kk[4 * NR / 8], kk[5 * NR / 8], kk[6 * NR / 8], kk[7 * NR / 8]) >= c0) Ts = trial; }
        int ncand = 0;
#pragma unroll
        for (int i = 0; i < NR; i += 8) ncand += cnt_ge8(Ts, kk[i], kk[i + 1], kk[i + 2], kk[i + 3], kk[i + 4], kk[i + 5], kk[i + 6], kk[i + 7]);
        if (Ts >= 1u && ncand >= 256 && ncand <= 2048) {
            LAS unsigned* cand = (LAS unsigned*)(lds + q * SROW);
            int base = 0;
#pragma unroll
            for (int i = 0; i < NR; i += 8) {
                const Mask8 ge = ge_masks8(Ts, kk[i], kk[i + 1], kk[i + 2], kk[i + 3], kk[i + 4], kk[i + 5], kk[i + 6], kk[i + 7]);
#pragma unroll
                for (int j = 0; j < 8; ++j) {
                    const unsigned long long tm = ge.m[j];
                    const int pos = mbcnt64(tm, base);
                    if (__builtin_amdgcn_inverse_ballot_w64(tm)) cand[pos] = (kk[i + j] << 16) | (unsigned)(64 * (i + j) + lane);
                    base += __popcll(tm);
                }
            }
            LDS_WAIT();
            if (ncand <= 512) {
                unsigned cc[8];
#pragma unroll
                for (int i = 0; i < 8; ++i) cc[i] = (64 * i + lane < ncand) ? cand[64 * i + lane] : 0u;
                dsa_pick<8, 16>(cc, sel, lane, ncand, Ts);
            } else if (ncand <= 1024) {
                unsigned cc[16];
#pragma unroll
                for (int i = 0; i < 16; ++i) cc[i] = (64 * i + lane < ncand) ? cand[64 * i + lane] : 0u;
                dsa_pick<16, 16>(cc, sel, lane, ncand, Ts);
            } else {
                unsigned cc[32];
#pragma unroll
                for (int i = 0; i < 32; ++i) cc[i] = (64 * i + lane < ncand) ? cand[64 * i + lane] : 0u;
                dsa_pick<32, 16>(cc, sel, lane, ncand, Ts);
            }
            return;
        }
    }
    dsa_pick<NR, 0>(kk, sel, lane, NR * 64, 0u);
}

__device__ __forceinline__ void dsa_unit(const Params& P, LAS unsigned char* lds, int b, int t0, int L, int wave, int lane, float negB) {
    const bf16_t* Q = (const bf16_t*)(P.ws + WS_R + R_Q); const bf16_t* KV = (const bf16_t*)(P.ws + WS_R + R_KV); const bf16_t* IK = (const bf16_t*)(P.ws + WS_R + R_IK);
    const bf16_t* IQ = (const bf16_t*)(P.ws + WS_R + R_IQ); const float* IW = (const float*)(P.ws + WS_R + R_IW); bf16_t* A2 = (bf16_t*)(P.ws + WS_R + R_A2);
    lane = fresh_tid() & 63;
    const int l15 = lane & 15, kb = lane >> 4;
    const size_t row0 = (size_t)b * SEQ + t0;
#pragma unroll 1
    for (int rep_ = 0; rep_ < ((MK_DSA_REP & 1) ? 2 : 1); ++rep_)
    if (L > 256) {
        bf16x8 iqf[4][2];
#pragma unroll
        for (int h = 0; h < 4; ++h)
#pragma unroll
            for (int ks = 0; ks < 2; ++ks) iqf[h][ks] = *(const bf16x8*)(IQ + (row0 + l15) * 256 + h * 64 + 32 * ks + 8 * kb);
        const f32x4 iw = *(const f32x4*)(IW + (row0 + l15) * 4);
        const int ntile = L >> 4;
        bf16x8 a0[4], a1[4], b0[4], b1[4];
        const bf16_t* ikb = IK + (size_t)b * SEQ * 64 + 8 * lane;
#define DSA_LOAD4(x0, x1, tb_) do { const int tb__ = ((tb_) < ntile) ? (tb_) : wave; _Pragma("unroll") for (int j = 0; j < 4; ++j) { const int t = (tb__ + 8 * j < ntile) ? tb__ + 8 * j : tb__; \
            const bf16_t* kp = ikb + (size_t)t * 1024; x0[j] = *(const bf16x8*)kp; x1[j] = *(const bf16x8*)(kp + 512); } } while (0)
#define DSA_SCORE4(x0, x1, tb_) do { _Pragma("unroll") for (int j = 0; j < 4; ++j) { const int t = (tb_) + 8 * j; if (t < ntile) { \
            f32x4 s = (f32x4){0.f, 0.f, 0.f, 0.f}; \
            _Pragma("unroll") for (int h = 0; h < 4; ++h) { f32x4 acc = (f32x4){0.f, 0.f, 0.f, 0.f}; acc = MFMA16(x0[j], iqf[h][0], acc); acc = MFMA16(x1[j], iqf[h][1], acc); const float w = iw[h]; \
                s.x += w * relu_i(acc.x); s.y += w * relu_i(acc.y); s.z += w * relu_i(acc.z); s.w += w * relu_i(acc.w); } \
            *(LAS u32x2*)(lds + l15 * SROW + 2 * (16 * t + 4 * kb)) = (u32x2){sortkey2(s.x, s.y), sortkey2(s.z, s.w)}; } } } while (0)
        DSA_LOAD4(a0, a1, wave);
#pragma unroll 1
        for (int t0 = wave; t0 < ntile; t0 += 64) {
            DSA_LOAD4(b0, b1, t0 + 32);
            DSA_SCORE4(a0, a1, t0);
            if (t0 + 32 >= ntile) break;
            DSA_LOAD4(a0, a1, t0 + 64);
            DSA_SCORE4(b0, b1, t0 + 32);
        }
#undef DSA_LOAD4
#undef DSA_SCORE4
    }
    __syncthreads();
    const int nsel = L < 256 ? L : 256;
#pragma unroll 1
    for (int rep_ = 0; rep_ < ((MK_DSA_REP & 2) ? 2 : 1); ++rep_)
#pragma unroll 1
    for (int qq = 0; qq < 2; ++qq) {
        const int q = 2 * wave + qq;
        LAS unsigned short* sel = (LAS unsigned short*)(lds + SEL_OFF + q * 512);
        if (L <= 256) {
#pragma unroll
            for (int i = 0; i < 4; ++i) { const int jx = 64 * i + lane; sel[jx] = (unsigned short)(jx < L ? jx : 0); }
        } else if (L <= 1024) dsa_select<16>(lds, q, L, lane);
        else if (L <= 2048) dsa_select<32>(lds, q, L, lane);
        else if (L <= 3072) dsa_select<48>(lds, q, L, lane);
        else dsa_select<64>(lds, q, L, lane);
    }
    LDS_WAIT();
    {
    const int lane = fresh_tid() & 63, l15 = lane & 15, kb = lane >> 4;
    LAS unsigned char* KBUF = lds + (2 * wave) * SROW; LAS unsigned char* VBUF = KBUF + 8192;
    const unsigned vb_addr = (unsigned)(uintptr_t)VBUF;
    const int qd = l15 >> 2, pp = lane & 3;
    const int nblk = nsel >> 6, ntot = 2 * nblk;
    const bf16_t* KVb = KV + (size_t)b * SEQ * 128;
    const __amdgpu_buffer_rsrc_t rkv = __builtin_amdgcn_make_buffer_rsrc((void*)KVb, 0, 0x7fffffff, 0x00020000);
    const unsigned klane0 = 16u * ((lane & 7) ^ (lane >> 4)), klane1 = 16u * ((lane & 7) ^ (4 + (lane >> 4)));
    const unsigned vlane = 128u + 16u * ((lane & 7) ^ (2 * kb));
    const LAS unsigned char* kfr0 = KBUF + 128 * l15 + 16 * ((0 + kb) ^ ((l15 >> 1) & 7));
    const LAS unsigned char* kfr1 = KBUF + 128 * l15 + 16 * ((4 + kb) ^ ((l15 >> 1) & 7));
    unsigned ta0[2][4], ta1[2][4];
#pragma unroll
    for (int s2 = 0; s2 < 2; ++s2) { const int r0 = 32 * s2 + 4 * kb + qd, r1 = r0 + 16;
#pragma unroll
        for (int mt = 0; mt < 4; ++mt) {
            ta0[s2][mt] = vb_addr + 128 * r0 + 16 * ((2 * mt + (pp >> 1)) ^ (2 * ((r0 >> 1) & 3))) + 8 * (pp & 1);
            ta1[s2][mt] = vb_addr + 128 * r1 + 16 * ((2 * mt + (pp >> 1)) ^ (2 * ((r1 >> 1) & 3))) + 8 * (pp & 1); } }
    const LAS unsigned short* selw = (const LAS unsigned short*)(lds + SEL_OFF + (2 * wave) * 512);
#define DSA_SELP(g_) (selw + (((g_) >= nblk) ? 256 + 64 * ((g_) - nblk) : 64 * (g_)))
#define DSA_DMAK(sv) do { _Pragma("unroll") for (int i = 0; i < 8; ++i) __builtin_amdgcn_raw_ptr_buffer_load_lds(rkv, (LAS void*)(KBUF + 1024 * i), 16, (int)(sv[i] * 256u + ((i & 1) ? klane1 : klane0)), 0, 0, 0); } while (0)
#define DSA_DMAV(sv) do { _Pragma("unroll") for (int i = 0; i < 8; ++i) __builtin_amdgcn_raw_ptr_buffer_load_lds(rkv, (LAS void*)(VBUF + 1024 * i), 16, (int)(sv[i] * 256u + vlane), 0, 0, 0); } while (0)
#define DSA_LOADQ(qx, qi_) do { const size_t row_ = row0 + 2 * wave + (qi_); _Pragma("unroll") for (int ks = 0; ks < 2; ++ks) { u32x4 z = (u32x4){0u, 0u, 0u, 0u}; if (l15 < 8) z = *(const u32x4*)(Q + row_ * 512 + l15 * 64 + 32 * ks + 8 * kb); qx[ks] = as_bf16x8(z); } } while (0)
#pragma unroll 1
    for (int rep_ = 0; rep_ < ((MK_DSA_REP & 4) ? 2 : 1); ++rep_) {
        bf16x8 qf[2], qfn[2];
        f32x4 o[4];
#pragma unroll
        for (int mt = 0; mt < 4; ++mt) o[mt] = (f32x4){0.f, 0.f, 0.f, 0.f};
        float lsum = 0.f;
        const f32x4 negB4 = (f32x4){negB, negB, negB, negB};
        DSA_LOADQ(qf, 0); DSA_LOADQ(qfn, 1);
        unsigned sv[8];
        { const LAS unsigned short* sp_ = DSA_SELP(0);
#pragma unroll
          for (int i = 0; i < 8; ++i) sv[i] = sp_[8 * i + (lane >> 3)]; }
        DSA_DMAK(sv); DSA_DMAV(sv);
#pragma unroll 1
        for (int g = 0; g < ntot; ++g) {
            const int qi = (g >= nblk) ? 1 : 0, blk = g - qi * nblk;
            const bool more1 = g + 1 < ntot, qlast = (blk == nblk - 1);
            asm volatile("s_waitcnt vmcnt(8)" ::: "memory");
            bf16x8 kc[4][2];
#pragma unroll
            for (int t = 0; t < 4; ++t) { kc[t][0] = *(const LAS bf16x8*)(kfr0 + 2048 * t); kc[t][1] = *(const LAS bf16x8*)(kfr1 + 2048 * t); }
            if (more1) { const LAS unsigned short* sp_ = DSA_SELP(g + 1);
#pragma unroll
                for (int i = 0; i < 8; ++i) sv[i] = sp_[8 * i + (lane >> 3)]; }
            asm volatile("s_waitcnt lgkmcnt(0)" ::: "memory");
            if (more1) DSA_DMAK(sv);
            f32x4 s[4];
#pragma unroll
            for (int t = 0; t < 4; ++t) { f32x4 acc = negB4; acc = MFMA16(kc[t][0], qf[0], acc); acc = MFMA16(kc[t][1], qf[1], acc); s[t] = acc; }
            if (more1) asm volatile("s_waitcnt vmcnt(8)" ::: "memory"); else asm volatile("s_waitcnt vmcnt(0)" ::: "memory");
            s16x4 lo0[4], hi0[4], lo1[4], hi1[4];
            tr_issue_off<0>(ta0[0], ta1[0], lo0, hi0); tr_issue_off<0>(ta0[1], ta1[1], lo1, hi1);
#pragma unroll
            for (int t = 0; t < 4; ++t) { s[t].x = __builtin_amdgcn_exp2f(s[t].x); s[t].y = __builtin_amdgcn_exp2f(s[t].y); s[t].z = __builtin_amdgcn_exp2f(s[t].z); s[t].w = __builtin_amdgcn_exp2f(s[t].w); lsum += (s[t].x + s[t].y) + (s[t].z + s[t].w); }
            tr_wait16(lo0, hi0, lo1, hi1);
            if (more1) DSA_DMAV(sv);
            { const bf16x8 pf = as_bf16x8(pack8(s[0], s[1]));
#pragma unroll
              for (int mt = 0; mt < 4; ++mt) o[mt] = MFMA16(join8(lo0[mt], hi0[mt]), pf, o[mt]); }
            { const bf16x8 pf = as_bf16x8(pack8(s[2], s[3]));
#pragma unroll
              for (int mt = 0; mt < 4; ++mt) o[mt] = MFMA16(join8(lo1[mt], hi1[mt]), pf, o[mt]); }
            if (qlast) {
                float ls = lsum; ls += __shfl_xor(ls, 16); ls += __shfl_xor(ls, 32);
                const float inv = 1.f / ls;
                const size_t row = row0 + 2 * wave + qi;
                if (l15 < 8) {
#pragma unroll
                    for (int mt = 0; mt < 4; ++mt) *(u32x2*)(A2 + row * 1024 + l15 * 64 + 16 * mt + 4 * kb) = (u32x2){cvt_pk_bf16(o[mt].x * inv, o[mt].y * inv), cvt_pk_bf16(o[mt].z * inv, o[mt].w * inv)};
                }
#pragma unroll
                for (int mt = 0; mt < 4; ++mt) o[mt] = (f32x4){0.f, 0.f, 0.f, 0.f};
                lsum = 0.f; qf[0] = qfn[0]; qf[1] = qfn[1];
            }
        }
        asm volatile("s_waitcnt vmcnt(0)" ::: "memory");
    }
#undef DSA_SELP
#undef DSA_DMAK
#undef DSA_DMAV
#undef DSA_LOADQ
    }
    __syncthreads();
}

__device__ __forceinline__ unsigned off_b(unsigned row, unsigned ch) { return 256u * row + 16u * (ch ^ (((row & 3) << 2) | ((row >> 2) & 3))); }
__device__ __forceinline__ void xattn_wg(const Params& P, LAS unsigned char* lds, int layer, int wg, int wave, int lane) {
    const bf16_t* MKV = (const bf16_t*)(P.ws + WS_MEMKV) + (size_t)layer * MEMTOK * 1024; const bf16_t* QX = (const bf16_t*)(P.ws + WS_R + R_QX); bf16_t* OX = (bf16_t*)(P.ws + WS_R + R_OX);
    const float* MSS = (const float*)(P.ws + WS_MEMSS) + (size_t)layer * MEMTOK * 8; const float* QSS = (const float*)(P.ws + WS_QSS);
    const float* gkn = P.in[I_XKN] + layer * 128; const float* gqn = P.in[I_XQN] + layer * 128;
    const int tid = wave * 64 + lane, l15 = lane & 15, kb = lane >> 4, qd = l15 >> 2, pp = lane & 3;
    f32x4 negB4;
    { const float gq = wave_max(fmaxf(fabsf(gqn[lane]), fabsf(gqn[lane + 64]))), gk = wave_max(fmaxf(fabsf(gkn[lane]), fabsf(gkn[lane + 64])));
      const float nb = -fminf(40.f, 128.f * 0.08838834764831845f * 1.4426950408889634f * 1.002f * gq * gk); negB4 = (f32x4){nb, nb, nb, nb}; }
    LAS unsigned char* KI = lds; LAS unsigned char* VI = lds + 65536;
    const unsigned vi_addr = (unsigned)(uintptr_t)VI;
    const int bh = (2 * wg) >> 4, b = bh >> 2, head = bh & 3;
#pragma unroll
    for (int i = 0; i < 8; ++i) {
        const int id = tid + 512 * i, rw = id >> 4, ch = id & 15;
        const bf16_t* src = MKV + ((size_t)b * NMEM + rw) * 1024 + head * 128 + 8 * ch;
        const f32x2 kp = *(const f32x2*)(MSS + ((size_t)b * NMEM + rw) * 8 + head * 2);
        const float rk = rsqrtf((kp.x + kp.y) * (1.f / 128.f) + EPS);
        const f32x4 ga = *(const f32x4*)(gkn + 8 * ch) * rk, gb = *(const f32x4*)(gkn + 8 * ch + 4) * rk;
        const u32x4 kr = *(const u32x4*)src;
        *(LAS u32x4*)(KI + off_b(rw, ch)) = pack8((f32x4){bflo(kr.x), bfhi(kr.x), bflo(kr.y), bfhi(kr.y)} * ga, (f32x4){bflo(kr.z), bfhi(kr.z), bflo(kr.w), bfhi(kr.w)} * gb);
        *(LAS u32x4*)(VI + off_b(rw, ch)) = *(const u32x4*)(src + 512);
    }
    __syncthreads();
    unsigned kadr[4], vadr0[2][2][4], vadr1[2][2][4];
#pragma unroll
    for (int ks = 0; ks < 4; ++ks) kadr[ks] = off_b(l15, 4 * ks + kb);
#pragma unroll
    for (int s2 = 0; s2 < 2; ++s2) { const unsigned r0 = 32 * s2 + 4 * kb + qd, r1 = r0 + 16;
#pragma unroll
        for (int mq = 0; mq < 2; ++mq)
#pragma unroll
            for (int k = 0; k < 4; ++k) { const int mt = 4 * mq + k; vadr0[s2][mq][k] = vi_addr + off_b(r0, 2 * mt + (pp >> 1)) + 8 * (pp & 1); vadr1[s2][mq][k] = vi_addr + off_b(r1, 2 * mt + (pp >> 1)) + 8 * (pp & 1); } }
#define XA_ROW(gi_) ((size_t)b * SEQ + ((2 * wg + ((gi_) >> 1)) & 15) * 256 + 16 * (2 * wave + ((gi_) & 1)) + l15)
#define XA_LOADQ(gi_) do { const size_t r_ = XA_ROW(gi_); qp = *(const f32x2*)(QSS + r_ * 8 + head * 2); _Pragma("unroll") for (int ks = 0; ks < 4; ++ks) qr[ks] = *(const u32x4*)(QX + r_ * 512 + head * 128 + 32 * ks + 8 * kb); } while (0)
    u32x4 qr[4]; f32x2 qp;
    XA_LOADQ(0);
#pragma unroll 1
    for (int gi = 0; gi < 4; ++gi) {
        {
            const size_t r = XA_ROW(gi);
            bf16x8 qf[4];
            {
                const float rn = rsqrtf((qp.x + qp.y) * (1.f / 128.f) + EPS) * (0.08838834764831845f * 1.4426950408889634f);
#pragma unroll
                for (int ks = 0; ks < 4; ++ks) {
                    const f32x4 ga = *(const f32x4*)(gqn + 32 * ks + 8 * kb) * rn, gb = *(const f32x4*)(gqn + 32 * ks + 8 * kb + 4) * rn;
                    qf[ks] = as_bf16x8(pack8((f32x4){bflo(qr[ks].x), bfhi(qr[ks].x), bflo(qr[ks].y), bfhi(qr[ks].y)} * ga, (f32x4){bflo(qr[ks].z), bfhi(qr[ks].z), bflo(qr[ks].w), bfhi(qr[ks].w)} * gb));
                }
            }
            if (gi < 3) XA_LOADQ(gi + 1);
            f32x4 o[8];
#pragma unroll
            for (int mt = 0; mt < 8; ++mt) o[mt] = (f32x4){0.f, 0.f, 0.f, 0.f};
            float lsum = 0.f;
#pragma unroll
            for (int blk = 0; blk < 4; ++blk) {
                f32x4 s[4];
#pragma unroll
                for (int t = 0; t < 4; ++t) {
                    f32x4 acc = negB4;
#pragma unroll
                    for (int ks = 0; ks < 4; ++ks) { const bf16x8 a = *(const LAS bf16x8*)(KI + kadr[ks] + 256 * (64 * blk + 16 * t)); acc = MFMA16(a, qf[ks], acc); }
                    s[t] = acc;
                }
#pragma unroll
                for (int t = 0; t < 4; ++t) { s[t].x = __builtin_amdgcn_exp2f(s[t].x); s[t].y = __builtin_amdgcn_exp2f(s[t].y); s[t].z = __builtin_amdgcn_exp2f(s[t].z); s[t].w = __builtin_amdgcn_exp2f(s[t].w); lsum += (s[t].x + s[t].y) + (s[t].z + s[t].w); }
#pragma unroll
                for (int s2 = 0; s2 < 2; ++s2) {
                    const bf16x8 pf = as_bf16x8(pack8(s[2 * s2], s[2 * s2 + 1]));
#pragma unroll
                    for (int mq = 0; mq < 2; ++mq) {
                        s16x4 lo[4], hi[4];
                        if (blk == 0) tr_quad_off<256 * (0 + 0)>(vadr0[s2][mq], vadr1[s2][mq], lo, hi);
                        if (blk == 1) tr_quad_off<256 * 64>(vadr0[s2][mq], vadr1[s2][mq], lo, hi);
                        if (blk == 2) tr_quad_off<256 * 128>(vadr0[s2][mq], vadr1[s2][mq], lo, hi);
                        if (blk == 3) tr_quad_off<256 * 192>(vadr0[s2][mq], vadr1[s2][mq], lo, hi);
#pragma unroll
                        for (int k = 0; k < 4; ++k) o[4 * mq + k] = MFMA16(join8(lo[k], hi[k]), pf, o[4 * mq + k]);
                    }
                }
            }
            lsum += __shfl_xor(lsum, 16); lsum += __shfl_xor(lsum, 32);
            const float inv = 1.f / lsum;
#pragma unroll
            for (int mt = 0; mt < 8; ++mt) *(u32x2*)(OX + r * 512 + head * 128 + 16 * mt + 4 * kb) = (u32x2){cvt_pk_bf16(o[mt].x * inv, o[mt].y * inv), cvt_pk_bf16(o[mt].z * inv, o[mt].w * inv)};
        }
    }
#undef XA_ROW
#undef XA_LOADQ
    __syncthreads();
}

#ifndef MK_MASK
#define MK_MASK 0xFFFFF
#endif
#define MKON(n) (((MK_MASK) >> (n)) & 1)
#ifndef MK_DUP
#define MK_DUP 0
#endif
#ifndef MK_DMASK
#define MK_DMASK 15
#endif
#ifndef MK_HI
#define MK_HI (1 << 20)
#endif
#define NREP(n) ((((MK_DUP) >> (n)) & 1) ? 2 : 1)
constexpr int LAST_PHASE = 2 + 16 * 3 + 9;
__global__ void __launch_bounds__(NTHREADS, 2) __attribute__((target("no-packed-fp32-ops"))) mk_fwd(Params P) {
    extern __shared__ __attribute__((aligned(16))) unsigned char lds_raw[];
    LAS unsigned char* lds = (LAS unsigned char*)lds_raw;
    const int tid = threadIdx.x, lane = tid & 63, wave = __builtin_amdgcn_readfirstlane(tid >> 6);
    const int G = gridDim.x, bx = blockIdx.x;
    const int NGW = G * NWAVES; (void)lane; (void)wave;
    volatile LAS unsigned* MISC = (volatile LAS unsigned*)(lds + LDSCTL_OFF);
    if (tid < 64) MISC[tid] = 0u;
    __syncthreads();
    unsigned* ctl = (unsigned*)(P.ws + WS_CTL);
    XcdBarrier bar = xcd_barrier_post(ctl + CW_BAR, MISC + 8);
    const int lo = P.ph_lo, hi = P.ph_hi;
#define IN(k) (lo <= (k) && (k) < hi)
#define FRESH const int ftid = fresh_tid(), flane = ftid & 63, fwave = __builtin_amdgcn_readfirstlane(ftid >> 6), fgw = bx * NWAVES + fwave; (void)fgw; (void)flane
#define SEAM(k) do { if ((k) < LAST_PHASE && (k) + 1 < hi) xcd_barrier(bar); } while (0)
    unsigned char* ws = P.ws;
    bf16_t* wb = (bf16_t*)(ws + WS_W);
    bf16_t* XB = (bf16_t*)(ws + WS_XB); float* SSQ = (float*)(ws + WS_SSQ16);

    if (MKON(0) && IN(0)) { FRESH; _Pragma("unroll 1") for (int rep = 0; rep < NREP(0); ++rep) prologue(P, lds, fgw, NGW, fwave, flane); SEAM(0);
#ifdef MK_BAR2
        { const unsigned long long t0 = __builtin_amdgcn_s_memrealtime(); while (__builtin_amdgcn_s_memrealtime() - t0 < 20000ull) __builtin_amdgcn_s_sleep(8); } xcd_barrier(bar); xcd_barrier(bar);
#endif
    }
    if (MKON(1) && IN(1)) {
        pg8::Gemm g{(const bf16_t*)(ws + WS_MEMB), (const bf16_t*)((char*)wb + W_XKV), DM, DM, DM}; pg8::StaticOrder S; S.init(MEMTOK, 4096, G, bx);
        EpiHead128<1> E{nullptr, (const float*)(ws + WS_MEMRS), (bf16_t*)(ws + WS_MEMKV), (float*)(ws + WS_MEMSS), lds};
        _Pragma("unroll 1") for (int rep = 0; rep < NREP(1); ++rep) pg8::gemm_phase<false>(lds, g, S, E); SEAM(1);
    }
#pragma unroll 1
    for (int layer = 0; layer < 4; ++layer) {
        const int pb = 2 + 16 * layer, j = layer >> 1;
        if ((layer & 1) == 0) {
            if (MKON(2) && IN(pb + 0)) {
                pg8::Gemm g{XB, (const bf16_t*)((char*)wb + W_EIN + j * 3 * MiB), DM, DM, DM}; pg8::StaticOrder S; S.init(NTOK, 1536, G, bx);
#ifdef MK_PLAIN_G1
                EpiPlain E{(bf16_t*)(ws + WS_R), 1536};
#else
                EpiEvenIn E{SSQ, P.in[I_AQN] + j * 64, P.in[I_AKN] + j * 64, (bf16_t*)(ws + WS_R + R_Q), (bf16_t*)(ws + WS_R + R_KV), (bf16_t*)(ws + WS_R + R_IK), (bf16_t*)(ws + WS_R + R_IQ), (bf16_t*)(ws + WS_R + R_U), (float*)(ws + WS_R + R_IW), lds};
#endif
                #ifdef MK_NOALIGN_G1
                pg8::gemm_phase<false>(lds, g, S, E); SEAM(pb + 0);
#else
                _Pragma("unroll 1") for (int rep = 0; rep < NREP(2); ++rep) pg8::gemm_phase<true>(lds, g, S, E); SEAM(pb + 0);
#endif
            }
            if (MKON(3) && IN(pb + 1)) {
                FRESH;
                _Pragma("unroll 1") for (int rep = 0; rep < NREP(15); ++rep)
                for (int task = bx; task < 256; task += G) s5_unit(P, lds, j, task & 7, task >> 3, fwave, flane);
                float negB;
                { const float gq = wave_max(fabsf(P.in[I_AQN][j * 64 + flane])), gk = wave_max(fabsf(P.in[I_AKN][j * 64 + flane]));
                  negB = -fminf(40.f, 64.f * 0.125f * 1.4426950408889634f * 1.002f * gq * gk); negB = __builtin_bit_cast(float, __builtin_amdgcn_readfirstlane(__builtin_bit_cast(int, negB))); }
                _Pragma("unroll 1") for (int rep = 0; rep < NREP(3); ++rep)
                for (int w2 = bx; w2 < 256; w2 += G) {
                    const int b = w2 & 7, r = w2 >> 3;
#pragma unroll 1
                    for (int k = 0; k < 8; ++k) { const int cc = (k < 4) ? r : 63 - r; dsa_unit(P, lds, b, 64 * cc + 16 * (k & 3), 64 * (cc + 1), fwave, flane, negB); }
                }
                SEAM(pb + 1);
            }
            if (MKON(4) && IN(pb + 2)) {
                pg8::Gemm g{(const bf16_t*)(ws + WS_R + R_YG), (const bf16_t*)((char*)wb + W_GLU + j * (MiB / 2)), 512, 512, 512}; pg8::StaticOrder S; S.init(NTOK, 512, G, bx);
                EpiGlu E{(const bf16_t*)(ws + WS_R + R_YG), P.in[I_BGLU] + j * 512, (bf16_t*)(ws + WS_R + R_A2)};
                _Pragma("unroll 1") for (int rep = 0; rep < NREP(4); ++rep) pg8::gemm_phase<false>(lds, g, S, E); SEAM(pb + 2);
            }
            if (MKON(5) && IN(pb + 3)) {
                pg8::Gemm g{(const bf16_t*)(ws + WS_R + R_A2), (const bf16_t*)((char*)wb + W_EOUT + j * 2 * MiB), DM, DM, DM}; pg8::StaticOrder S; S.init(NTOK, DM, G, bx);
                EpiResidual E{nullptr, XB, SSQ, 1.f};
                _Pragma("unroll 1") for (int rep = 0; rep < 2 * NREP(5) - 1; ++rep) { E.sign = (rep == 1) ? -1.f : 1.f; pg8::gemm_phase<false>(lds, g, S, E); } SEAM(pb + 3);
            }
        } else {
            if (MKON(6) && IN(pb + 0)) {
                pg8::Gemm g{XB, (const bf16_t*)((char*)wb + W_OIN + j * 8 * MiB), DM, DM, DM}; pg8::StaticOrder S; S.init(NTOK, 4096, G, bx);
                EpiOddIn E{SSQ, P.in[I_OCONV_W] + (size_t)j * 3 * 1024, P.in[I_OCONV_B] + (size_t)j * 1024, (bf16_t*)(ws + WS_R + R_MIX), (float*)(ws + WS_HALO2 + HALO_OT), (float*)(ws + WS_HALO2 + HALO_OH), lds};
                _Pragma("unroll 1") for (int rep = 0; rep < NREP(6); ++rep) pg8::gemm_phase<true>(lds, g, S, E); SEAM(pb + 0);
            }
            if (MKON(7) && IN(pb + 1)) { FRESH; fixup_odd(P, j, bx * NTHREADS + ftid, G * NTHREADS); SEAM(pb + 1); }
            if (MKON(8) && IN(pb + 2)) {
                pg8::Gemm g{(const bf16_t*)(ws + WS_R + R_MIX), (const bf16_t*)((char*)wb + W_OOUT + j * 2 * MiB), DM, DM, DM}; pg8::StaticOrder S; S.init(NTOK, DM, G, bx);
                EpiResidual E{nullptr, XB, SSQ, 1.f};
                _Pragma("unroll 1") for (int rep = 0; rep < 2 * NREP(8) - 1; ++rep) { E.sign = (rep == 1) ? -1.f : 1.f; pg8::gemm_phase<false>(lds, g, S, E); } SEAM(pb + 2);
            }
        }
        if (MKON(9) && IN(pb + 4)) {
            pg8::Gemm g{XB, (const bf16_t*)((char*)wb + W_XQ + layer * MiB), DM, DM, DM}; pg8::StaticOrder S; S.init(NTOK, 512, G, bx);
            EpiHead128<0> E{SSQ, nullptr, (bf16_t*)(ws + WS_R + R_QX), (float*)(ws + WS_QSS), lds};
            _Pragma("unroll 1") for (int rep = 0; rep < NREP(9); ++rep) pg8::gemm_phase<false>(lds, g, S, E); SEAM(pb + 4);
        }
        if (MKON(10) && IN(pb + 5)) { FRESH; _Pragma("unroll 1") for (int rep = 0; rep < NREP(10); ++rep) for (int w2 = bx; w2 < 256; w2 += G) xattn_wg(P, lds, layer, (((w2 & 7) * 4 + (w2 >> 6)) << 3) | ((w2 >> 3) & 7), fwave, flane); SEAM(pb + 5); }
        if (MKON(11) && IN(pb + 6)) {
            pg8::Gemm g{(const bf16_t*)(ws + WS_R + R_OX), (const bf16_t*)((char*)wb + W_XO + layer * MiB), 512, 512, 512}; pg8::StaticOrder S; S.init(NTOK, DM, G, bx);
            EpiResidual E{nullptr, XB, SSQ, 1.f};
            _Pragma("unroll 1") for (int rep = 0; rep < 2 * NREP(11) - 1; ++rep) { E.sign = (rep == 1) ? -1.f : 1.f; pg8::gemm_phase<false>(lds, g, S, E); } SEAM(pb + 6);
        }
        if (MKON(12) && IN(pb + 7)) {
            pg8::Gemm g{XB, (const bf16_t*)((char*)wb + W_UP + layer * 11 * MiB), DM, DM, DM}; pg8::StaticOrder S; S.init(NTOK, 2 * DFF, G, bx);
            EpiFfnUp E{SSQ, P.in[I_FCONV_W] + (size_t)layer * 3 * DFF, P.in[I_FCONV_B] + (size_t)layer * DFF, (bf16_t*)(ws + WS_R + R_ACT), (float*)(ws + WS_HALO2 + HALO_FT), (float*)(ws + WS_HALO2 + HALO_FH), lds};
            _Pragma("unroll 1") for (int rep = 0; rep < NREP(12); ++rep) pg8::gemm_phase<MK_ALIGN6>(lds, g, S, E);
#ifdef MK_NULL6
            { EpiNull EN; pg8::gemm_phase<false>(lds, g, S, EN); }
#endif
            SEAM(pb + 7);
        }
        if (MKON(13) && IN(pb + 8)) { FRESH; fixup_ffn(P, layer, bx * NTHREADS + ftid, G * NTHREADS); SEAM(pb + 8); }
        if (MKON(14) && IN(pb + 9)) {
            pg8::Gemm g{(const bf16_t*)(ws + WS_R + R_ACT), (const bf16_t*)((char*)wb + W_DN + layer * (11 * MiB / 2)), DFF, DFF, DFF}; pg8::StaticOrder S; S.init(NTOK, DM, G, bx);
            EpiResidual E{layer == 3 ? P.out : nullptr, XB, SSQ, 1.f};
            _Pragma("unroll 1") for (int rep = 0; rep < 2 * NREP(14) - 1; ++rep) { E.sign = (rep == 1) ? -1.f : 1.f; pg8::gemm_phase<false>(lds, g, S, E); } SEAM(pb + 9);
        }
    }
#ifdef MK_DUMP
    {
        xcd_barrier(bar);
        const bf16_t* s0; const bf16_t* s1; const bf16_t* s2; const bf16_t* s3; int n0, n1, n2, n3;
#if MK_DUMP == 1
        s0 = (const bf16_t*)(ws + WS_R + R_A2); n0 = 1024; s1 = s0; n1 = 0; s2 = s0; n2 = 0; s3 = s0; n3 = 0;
#elif MK_DUMP == 2
        s0 = (const bf16_t*)(ws + WS_R + R_YG); n0 = 512; s1 = (const bf16_t*)(ws + WS_R + R_U); n1 = 512; s2 = s0; n2 = 0; s3 = s0; n3 = 0;
#elif MK_DUMP == 8
        s0 = (const bf16_t*)(ws + WS_R + R_QX); n0 = 512; s1 = (const bf16_t*)(ws + WS_R + R_OX); n1 = 512; s2 = s0; n2 = 0; s3 = s0; n3 = 0;
#elif MK_DUMP == 4 || MK_DUMP == 6 || MK_DUMP == 7
        s0 = (const bf16_t*)(ws + WS_XB); n0 = 1024; s1 = s0; n1 = 0; s2 = s0; n2 = 0; s3 = s0; n3 = 0;
#else
        s0 = (const bf16_t*)(ws + WS_R + R_Q); n0 = 512; s1 = (const bf16_t*)(ws + WS_R + R_IQ); n1 = 256; s2 = (const bf16_t*)(ws + WS_R + R_KV); n2 = 128; s3 = (const bf16_t*)(ws + WS_R + R_IK); n3 = 64;
#endif
        for (size_t idx = (size_t)bx * NTHREADS + threadIdx.x; idx < (size_t)NTOK * 1024; idx += (size_t)G * NTHREADS) {
            const size_t row = idx >> 10; int c = (int)(idx & 1023); float v = 0.f;
            if (c < n0) { if (MK_DMASK & 1) v = bf2f(s0[row * n0 + c]); } else { c -= n0; if (c < n1) { if (MK_DMASK & 2) v = bf2f(s1[row * n1 + c]); } else { c -= n1; if (c < n2) { if (MK_DMASK & 4) v = bf2f(s2[row * n2 + c]); } else { c -= n2; if (c < n3) { if (MK_DMASK & 8) v = bf2f(s3[row * n3 + c]); } } } }
#ifdef MK_KEEP
            if (!(MK_KEEP)) v = 0.f;
#endif
#if MK_DUMP == 7
            v = bf2f(((const bf16_t*)(ws + WS_R))[row * 1536 + (idx & 1023)]);
#endif
#if MK_DUMP == 6
            if (row < 8192) v = bf2f(((const bf16_t*)(ws + WS_MEMKV))[row * 1024 + (idx & 1023)]);
#endif
#if MK_DUMP == 4
            if (row < 1536) v = bf2f(((const bf16_t*)((char*)wb + W_EIN))[row * 1024 + (idx & 1023)]);
            else if (row < 1536 + 8192) v = SSQ[(row - 1536) * 64 + (idx & 63)];
#endif
            P.out[idx] = v;
        }
    }
#endif
#undef IN
#undef SEAM
}

extern "C" void kernel_launch(void* const* d_in, const int* in_sizes, int n_in, void* d_out, int out_size, void* d_ws, size_t ws_size, hipStream_t stream) {
    static int grid = 0;
    if (grid == 0) {
        if (n_in != 33 || out_size != NTOK * DM || ws_size < WS_END) { fprintf(stderr, "kernel_launch: unexpected problem (n_in %d out %d ws %zu)\n", n_in, out_size, ws_size); grid = -1; return; }
        int dev = 0, cus = 0, per_cu = 0;
        if (hipGetDevice(&dev) != hipSuccess || hipDeviceGetAttribute(&cus, hipDeviceAttributeMultiprocessorCount, dev) != hipSuccess) { grid = -1; return; }
        if (hipFuncSetAttribute((const void*)mk_fwd, hipFuncAttributeMaxDynamicSharedMemorySize, LDS_BYTES) != hipSuccess) { fprintf(stderr, "kernel_launch: hipFuncSetAttribute failed\n"); grid = -1; return; }
        if (hipOccupancyMaxActiveBlocksPerMultiprocessor(&per_cu, (const void*)mk_fwd, NTHREADS, LDS_BYTES) != hipSuccess || per_cu < 1) { fprintf(stderr, "kernel_launch: occupancy query reports %d\n", per_cu); }
        (void)hipGetLastError();
        grid = cus < 256 ? cus : 256;
    }
    if (grid < 0) return;
    (void)hipMemsetAsync((char*)d_ws + WS_CTL, 0, CTL_ZERO_BYTES, stream);
    Params p{};
    for (int i = 0; i < 33; ++i) p.in[i] = (const float*)d_in[i];
    p.out = (float*)d_out; p.ws = (unsigned char*)d_ws;
#ifdef MK_PER_PHASE
    for (int ph = 0; ph <= LAST_PHASE; ++ph) { p.ph_lo = ph; p.ph_hi = ph + 1; hipLaunchKernelGGL(mk_fwd, dim3(grid), dim3(NTHREADS), LDS_BYTES, stream, p); }
#else
    p.ph_lo = 0; p.ph_hi = MK_HI;
    hipLaunchKernelGGL(mk_fwd, dim3(grid), dim3(NTHREADS), LDS_BYTES, stream, p);
#endif
}
```
